# Optimizing an MI355X kernel written in HIP

```python
import math
import jax, jax.numpy as jnp
from jax import lax
import numpy as np

D_MODEL = 1024
BATCH = 8
SEQ = 2048
DEPTH = 1
DEC_BATCH = 16
DEC_SEQ = 16
PAST_LEN = 2048

CHUNK = 64
EPS = 1e-6
LRU_WIDTH = 512
LRU_BLOCKS = 8
LRU_BLOCK_DIM = LRU_WIDTH // LRU_BLOCKS
CONV_W = 4
LRU_C = 8.0
N_HEADS = 8
N_KV_HEADS = 2
HEAD_DIM = 64
GQ = N_HEADS // N_KV_HEADS
ATTN_WIDTH = N_HEADS * HEAD_DIM
KV_WIDTH = N_KV_HEADS * HEAD_DIM
WINDOW = 128
WINDOW_CHUNKS = WINDOW // CHUNK
MIX_WIDTH = LRU_WIDTH + ATTN_WIDTH
IN_WIDTH = 2 * LRU_WIDTH + ATTN_WIDTH + 2 * KV_WIDTH
PEER_HEADS = 8
N_KEYS = 128
N_EXPERTS = N_KEYS * N_KEYS
PEER_TOPK = 16
D_QUERY = 256
D_HALF = D_QUERY // 2
PEER_BLOCK = 128

kernel_name = "hymba_rglru_swa_sink_peer_stream_step"


def rmsnorm(x, g):
    xf = x.astype(jnp.float32)
    xf = xf * lax.rsqrt(jnp.mean(xf * xf, axis=-1, keepdims=True) + EPS)
    return xf.astype(x.dtype) * g


def project_inputs(xn, w_in, q_g, k_g):
    B, T, _ = xn.shape
    z = xn @ w_in
    o1 = LRU_WIDTH
    o2 = o1 + LRU_WIDTH
    o3 = o2 + ATTN_WIDTH
    o4 = o3 + KV_WIDTH
    u = z[..., :o1]
    gate = z[..., o1:o2]
    q = rmsnorm(z[..., o2:o3].reshape(B, T, N_HEADS, HEAD_DIM), q_g)
    k = rmsnorm(z[..., o3:o4].reshape(B, T, N_KV_HEADS, HEAD_DIM), k_g)
    v = z[..., o4:].reshape(B, T, N_KV_HEADS, HEAD_DIM)
    return u, gate, q, k, v


def causal_conv(u, buf, w, b):
    T = u.shape[1]
    full = jnp.concatenate([buf, u], axis=1)
    out = b + sum(full[:, j:j + T] * w[j] for j in range(CONV_W))
    return out, full[:, -(CONV_W - 1):]


def rg_lru(xc, h0, wa, ba, wi, bi, lam):
    B, T, _ = xc.shape
    xb = xc.reshape(B, T, LRU_BLOCKS, LRU_BLOCK_DIM)
    r = jax.nn.sigmoid(jnp.einsum('btnd,nde->btne', xb, wa).reshape(B, T, LRU_WIDTH) + ba)
    ig = jax.nn.sigmoid(jnp.einsum('btnd,nde->btne', xb, wi).reshape(B, T, LRU_WIDTH) + bi)
    log_a = -LRU_C * r.astype(jnp.float32) * jax.nn.softplus(-lam.astype(jnp.float32))
    a = jnp.exp(log_a)
    drive = jnp.sqrt(-jnp.expm1(2.0 * log_a)) * (ig * xc).astype(jnp.float32)

    def combine(lhs, rhs):
        return (lhs[0] * rhs[0], rhs[0] * lhs[1] + rhs[1])

    a_cum, h = lax.associative_scan(combine, (a, drive), axis=1)
    h = h + a_cum * h0.astype(jnp.float32)[:, None, :]
    return h.astype(xc.dtype), h[:, -1].astype(h0.dtype)


def recurrent_group(u, gate, conv_buf, h0, conv_w, conv_b, wa, ba, wi, bi, lam):
    xc, new_buf = causal_conv(u, conv_buf, conv_w, conv_b)
    h, h_last = rg_lru(xc, h0, wa, ba, wi, bi, lam)
    return h * jax.nn.gelu(gate), new_buf, h_last


def sink_softmax(s, sink_b):
    m = jnp.maximum(jnp.max(s, axis=-1, keepdims=True), sink_b)
    p = jnp.exp(s - m)
    return p / (jnp.sum(p, axis=-1, keepdims=True) + jnp.exp(sink_b - m))


def attention_prompt(q, k, v, sinks):
    B, S = q.shape[:2]
    NC = S // CHUNK
    KB = (WINDOW_CHUNKS + 1) * CHUNK
    qc = q.reshape(B, NC, CHUNK, N_KV_HEADS, GQ, HEAD_DIM)

    def band(t):
        tc = t.reshape(B, NC, CHUNK, N_KV_HEADS, HEAD_DIM)
        tp = jnp.concatenate([jnp.zeros_like(tc[:, :WINDOW_CHUNKS]), tc], axis=1)
        return jnp.concatenate([tp[:, j:j + NC] for j in range(WINDOW_CHUNKS + 1)], axis=2)

    kb, vb = band(k), band(v)
    key_chunk = jnp.arange(NC)[:, None] - WINDOW_CHUNKS + jnp.arange(KB)[None, :] // CHUNK
    valid = (key_chunk >= 0)[None, :, None, None, None, :]
    s = jnp.einsum('bncgrd,bnkgd->bngrck', qc, kb).astype(jnp.float32) * (HEAD_DIM ** -0.5)
    s = jnp.where(valid, s, -jnp.inf)
    sink_b = sinks.astype(jnp.float32).reshape(N_KV_HEADS, GQ)[None, None, :, :, None, None]
    p = sink_softmax(s, sink_b).astype(v.dtype)
    o = jnp.einsum('bngrck,bnkgd->bncgrd', p, vb).reshape(B, S, ATTN_WIDTH)
    return o, k[:, -WINDOW:], v[:, -WINDOW:]


def attention_sample(q, k, v, cache_k, cache_v, sinks):
    B, T = q.shape[:2]
    kf = jnp.concatenate([cache_k, k], axis=1)
    vf = jnp.concatenate([cache_v, v], axis=1)
    qg = q.reshape(B, T, N_KV_HEADS, GQ, HEAD_DIM)
    s = jnp.einsum('btgrd,bkgd->bgrtk', qg, kf).astype(jnp.float32) * (HEAD_DIM ** -0.5)
    sink_b = sinks.astype(jnp.float32).reshape(N_KV_HEADS, GQ)[None, :, :, None, None]
    p = sink_softmax(s, sink_b).astype(v.dtype)
    o = jnp.einsum('bgrtk,bkgd->btgrd', p, vf).reshape(B, T, ATTN_WIDTH)
    return o, kf[:, -WINDOW:], vf[:, -WINDOW:]


def merge_groups(x, lru_out, attn_out, g_lru, g_attn, w_out):
    cat = jnp.concatenate([rmsnorm(lru_out, g_lru), rmsnorm(attn_out, g_attn)], axis=-1)
    return x + cat @ w_out


def peer(xn, w_query, sub_keys1, sub_keys2, expert_u, expert_v):
    T = xn.shape[0]
    q = (xn @ w_query).reshape(T, PEER_HEADS, 2, D_HALF)
    s1 = jnp.einsum('thd,kd->thk', q[:, :, 0], sub_keys1).astype(jnp.float32)
    s2 = jnp.einsum('thd,kd->thk', q[:, :, 1], sub_keys2).astype(jnp.float32)
    v1, i1 = lax.top_k(s1, PEER_TOPK)
    v2, i2 = lax.top_k(s2, PEER_TOPK)
    cand_s = (v1[..., :, None] + v2[..., None, :]).reshape(T, PEER_HEADS, PEER_TOPK * PEER_TOPK)
    cand_i = (i1[..., :, None] * N_KEYS + i2[..., None, :]).reshape(T, PEER_HEADS, PEER_TOPK * PEER_TOPK)
    top_s, top_pos = lax.top_k(cand_s, PEER_TOPK)
    idx = jnp.take_along_axis(cand_i, top_pos, axis=-1)
    gates = jax.nn.softmax(top_s, axis=-1)
    u = expert_u[idx]
    act = jax.nn.gelu(jnp.einsum('thkd,td->thk', u, xn).astype(jnp.float32))
    return jnp.einsum('thk,thkd->td', (gates * act).astype(xn.dtype), expert_v[idx])


def setup_inputs(seed: int = 0) -> dict:
    key = jax.random.key(seed)
    ks = jax.random.split(key, 32)
    f = jnp.float32
    nrm = lambda k, shape, sc: jax.random.normal(k, shape, f) * sc
    cache_win = min(WINDOW, PAST_LEN)
    a8 = jax.random.uniform(ks[12], (DEPTH, LRU_WIDTH), f, minval=0.9, maxval=0.999)
    a_base = a8 ** (1.0 / LRU_C)
    lam = jnp.log(a_base) - jnp.log1p(-a_base)
    return {
        "x_prompt": nrm(ks[0], (BATCH, SEQ, D_MODEL), 1.0),
        "x_sample": nrm(ks[1], (DEC_BATCH, DEC_SEQ, D_MODEL), 1.0),
        "cache_attn_k": nrm(ks[2], (DEPTH, DEC_BATCH, cache_win, N_KV_HEADS, HEAD_DIM), 1.0),
        "cache_attn_v": nrm(ks[3], (DEPTH, DEC_BATCH, cache_win, N_KV_HEADS, HEAD_DIM), 1.0),
        "state_conv": nrm(ks[4], (DEPTH, DEC_BATCH, CONV_W - 1, LRU_WIDTH), 1.0),
        "state_lru": nrm(ks[5], (DEPTH, DEC_BATCH, LRU_WIDTH), 0.5),
        "ln1_g": 1.0 + nrm(ks[6], (DEPTH, D_MODEL), 0.02),
        "w_in": nrm(ks[7], (DEPTH, D_MODEL, IN_WIDTH), D_MODEL ** -0.5),
        "conv_w": nrm(ks[8], (DEPTH, CONV_W, LRU_WIDTH), CONV_W ** -0.5),
        "conv_b": nrm(ks[9], (DEPTH, LRU_WIDTH), 0.01),
        "lru_wa": nrm(ks[10], (DEPTH, LRU_BLOCKS, LRU_BLOCK_DIM, LRU_BLOCK_DIM), LRU_BLOCK_DIM ** -0.5),
        "lru_ba": nrm(ks[11], (DEPTH, LRU_WIDTH), 0.01),
        "lru_wi": nrm(ks[13], (DEPTH, LRU_BLOCKS, LRU_BLOCK_DIM, LRU_BLOCK_DIM), LRU_BLOCK_DIM ** -0.5),
        "lru_bi": nrm(ks[14], (DEPTH, LRU_WIDTH), 0.01),
        "lru_lambda": lam,
        "q_norm_g": 1.0 + nrm(ks[15], (DEPTH, HEAD_DIM), 0.02),
        "k_norm_g": 1.0 + nrm(ks[16], (DEPTH, HEAD_DIM), 0.02),
        "attn_sinks": nrm(ks[17], (DEPTH, N_HEADS), 0.5),
        "g_lru_out": 1.0 + nrm(ks[18], (DEPTH, LRU_WIDTH), 0.02),
        "g_attn_out": 1.0 + nrm(ks[19], (DEPTH, ATTN_WIDTH), 0.02),
        "w_out": nrm(ks[20], (DEPTH, MIX_WIDTH, D_MODEL), MIX_WIDTH ** -0.5),
        "ln2_g": 1.0 + nrm(ks[21], (DEPTH, D_MODEL), 0.02),
        "peer_w_query": nrm(ks[22], (DEPTH, D_MODEL, PEER_HEADS * D_QUERY), D_MODEL ** -0.5),
        "peer_sub_keys1": nrm(ks[23], (DEPTH, N_KEYS, D_HALF), D_HALF ** -0.5),
        "peer_sub_keys2": nrm(ks[24], (DEPTH, N_KEYS, D_HALF), D_HALF ** -0.5),
        "peer_u": nrm(ks[25], (DEPTH, N_EXPERTS, D_MODEL), D_MODEL ** -0.5),
        "peer_v": nrm(ks[26], (DEPTH, N_EXPERTS, D_MODEL), 0.1),
    }


def reference(x_prompt, x_sample, cache_attn_k, cache_attn_v, state_conv, state_lru,
              ln1_g, w_in, conv_w, conv_b, lru_wa, lru_ba, lru_wi, lru_bi, lru_lambda,
              q_norm_g, k_norm_g, attn_sinks, g_lru_out, g_attn_out, w_out, ln2_g,
              peer_w_query, peer_sub_keys1, peer_sub_keys2, peer_u, peer_v):
    y_p, y_s = x_prompt, x_sample
    Bp, Sp = y_p.shape[:2]
    Bs, Ts = y_s.shape[:2]
    nk_p, nv_p, nc_p, nh_p = [], [], [], []
    nk_s, nv_s, nc_s, nh_s = [], [], [], []
    for l in range(DEPTH):
        lru_args = (conv_w[l], conv_b[l], lru_wa[l], lru_ba[l], lru_wi[l], lru_bi[l], lru_lambda[l])
        peer_args = (peer_w_query[l], peer_sub_keys1[l], peer_sub_keys2[l], peer_u[l], peer_v[l])

        u, gate, q, k, v = project_inputs(rmsnorm(y_p, ln1_g[l]), w_in[l], q_norm_g[l], k_norm_g[l])
        zero_buf = jnp.zeros((Bp, CONV_W - 1, LRU_WIDTH), y_p.dtype)
        zero_h = jnp.zeros((Bp, LRU_WIDTH), y_p.dtype)
        lru_out, cbuf, h_last = recurrent_group(u, gate, zero_buf, zero_h, *lru_args)
        attn_out, kbuf, vbuf = attention_prompt(q, k, v, attn_sinks[l])
        y_p = merge_groups(y_p, lru_out, attn_out, g_lru_out[l], g_attn_out[l], w_out[l])
        xn2 = rmsnorm(y_p, ln2_g[l]).reshape(-1, PEER_BLOCK, D_MODEL)
        ffn = lax.map(lambda blk: peer(blk, *peer_args), xn2)
        y_p = y_p + ffn.reshape(Bp, Sp, D_MODEL)
        nk_p.append(kbuf); nv_p.append(vbuf); nc_p.append(cbuf); nh_p.append(h_last)

        u, gate, q, k, v = project_inputs(rmsnorm(y_s, ln1_g[l]), w_in[l], q_norm_g[l], k_norm_g[l])
        lru_out, cbuf, h_last = recurrent_group(u, gate, state_conv[l], state_lru[l], *lru_args)
        attn_out, kbuf, vbuf = attention_sample(q, k, v, cache_attn_k[l], cache_attn_v[l], attn_sinks[l])
        y_s = merge_groups(y_s, lru_out, attn_out, g_lru_out[l], g_attn_out[l], w_out[l])
        xn2 = rmsnorm(y_s, ln2_g[l]).reshape(Bs * Ts, D_MODEL)
        y_s = y_s + peer(xn2, *peer_args).reshape(Bs, Ts, D_MODEL)
        nk_s.append(kbuf); nv_s.append(vbuf); nc_s.append(cbuf); nh_s.append(h_last)

    return (y_p, y_s,
            jnp.stack(nk_p), jnp.stack(nv_p), jnp.stack(nc_p), jnp.stack(nh_p),
            jnp.stack(nk_s), jnp.stack(nv_s), jnp.stack(nc_s), jnp.stack(nh_s))
```

```cpp
#include <hip/hip_runtime.h>
#include <hip/hip_cooperative_groups.h>
#include <cstdio>
namespace cg = cooperative_groups;

#define DI __device__ __forceinline__
typedef __bf16 bf2_t __attribute__((ext_vector_type(2)));
typedef float fl2_t __attribute__((ext_vector_type(2)));
typedef short bf16x8 __attribute__((ext_vector_type(8)));
typedef float f32x16 __attribute__((ext_vector_type(16)));
typedef unsigned short u16;
typedef unsigned u32x4 __attribute__((ext_vector_type(4)));
#define MFMA32(a, b, c) __builtin_amdgcn_mfma_f32_32x32x16_bf16((a), (b), (c), 0, 0, 0)

constexpr int TP = 16384, TS = 256, TT = 16640;
constexpr float EPS = 1e-6f;

constexpr size_t O_Y = 0;
constexpr size_t O_KP = 17039360, O_VP = 17170432, O_CONVP = 17301504, O_LRUP = 17313792;
constexpr size_t O_KS = 17317888, O_VS = 17580032, O_CONVS = 17842176, O_LRUS = 17866752;

constexpr size_t al(size_t x) { return (x + 255) & ~size_t(255); }
constexpr size_t W_WTIN = 0;
constexpr size_t W_WTOUT = W_WTIN + al(1792ull * 1024 * 2);
constexpr size_t W_WTQ = W_WTOUT + al(1024ull * 1024 * 2);
constexpr size_t W_K1B = W_WTQ + al(2048ull * 1024 * 2);
constexpr size_t W_K2B = W_K1B + al(128 * 128 * 2);
constexpr size_t W_WAT = W_K2B + al(128 * 128 * 2);
constexpr size_t W_WIT = W_WAT + al(8 * 64 * 64 * 2);
constexpr size_t W_C8 = W_WIT + al(8 * 64 * 64 * 2);
constexpr size_t W_UB = W_C8 + al(512 * 4);
constexpr size_t W_VB = W_UB + al(16384ull * 1024 * 2);
constexpr size_t W_RB = W_VB + al(16384ull * 1024 * 2);
constexpr size_t W_XB = W_RB;
constexpr size_t W_CAT = W_RB;
constexpr size_t W_SIDX = W_RB;
constexpr size_t W_SGATE = W_RB + al(TT * 128ull * 4);
constexpr size_t W_RC = W_RB + al(TT * 1024ull * 2);
constexpr size_t W_U = W_RC;
constexpr size_t W_GG = W_RC + TT * 512ull * 2;
constexpr size_t W_HB = W_RC;
constexpr size_t W_Q = W_RC + al(TT * 1024ull * 2);
constexpr size_t W_KP = W_Q + al(TT * 512ull * 2);
constexpr size_t W_KS = W_KP + al(TP * 128ull * 2);
constexpr size_t W_VTP = W_KS + al(16 * 192 * 128 * 2);
constexpr size_t W_VTS = W_VTP + al(8 * 128 * 2048ull * 2);
constexpr size_t W_SUMA = W_VTS + al(16 * 128 * 192 * 2);
constexpr size_t W_SUMH = W_SUMA + al(512 * 512 * 4);
constexpr size_t W_RS1 = W_SUMH + al(512 * 512 * 4);
constexpr size_t W_SSQL = W_RS1 + al(TT * 4);
constexpr size_t W_SSQA = W_SSQL + al(TT * 4 * 4);
constexpr size_t W_SSQ2 = W_SSQA + al(TT * 8 * 4);
constexpr size_t W_PQ = W_SSQ2 + al(TT * 16 * 4);
constexpr size_t W_END = W_PQ + al(TT * 2048ull * 2);

struct Params {
  const float *x_p, *x_s, *cache_k, *cache_v, *state_conv, *state_lru, *ln1_g, *w_in, *conv_w, *conv_b,
      *lru_wa, *lru_ba, *lru_wi, *lru_bi, *lru_lambda, *q_g, *k_g, *sinks, *g_lru, *g_attn, *w_out, *ln2_g,
      *w_query, *sk1, *sk2, *peer_u, *peer_v;
  float* out;
  char* ws;
};

DI unsigned pk2(float a, float b) {
  fl2_t f = {a, b};
  return __builtin_bit_cast(unsigned, __builtin_convertvector(f, bf2_t));
}
DI float bf_lo(unsigned u) { return __uint_as_float(u << 16); }
DI float bf_hi(unsigned u) { return __uint_as_float(u & 0xffff0000u); }
DI float bf1(u16 v) { return __uint_as_float(((unsigned)v) << 16); }
DI float sigmoidf_(float x) { return 1.0f / (1.0f + __expf(-x)); }
DI float gelu_(float x) {
  float z = 0.7978845608028654f * (x + 0.044715f * x * x * x);
  return x / (1.0f + __expf(-2.0f * z));
}
DI int crow(int r, int h) { return (r & 3) + 8 * (r >> 2) + 4 * h; }

DI void transpose_tile(const float* __restrict__ src, int ld_src, u16* __restrict__ dst, int ld_dst, int k0, int n0,
                       const float* __restrict__ gain, float* tile) {
  const int tid = threadIdx.x;
  const int c = tid & 63, r0 = tid >> 6;
  __syncthreads();
#pragma unroll 4
  for (int rr = 0; rr < 16; ++rr) {
    int r = rr * 4 + r0;
    float v = src[(size_t)(k0 + r) * ld_src + n0 + c];
    if (gain) v *= gain[k0 + r];
    tile[r * 65 + c] = v;
  }
  __syncthreads();
  const int n = tid >> 2, kq = (tid & 3) * 16;
  unsigned pk[8];
#pragma unroll
  for (int i = 0; i < 8; ++i) pk[i] = pk2(tile[(kq + 2 * i) * 65 + n], tile[(kq + 2 * i + 1) * 65 + n]);
  uint4* d = (uint4*)(dst + (size_t)(n0 + n) * ld_dst + k0 + kq);
  d[0] = make_uint4(pk[0], pk[1], pk[2], pk[3]);
  d[1] = make_uint4(pk[4], pk[5], pk[6], pk[7]);
}

DI void phase0(const Params& p, char* smem) {
  const int nb = gridDim.x, bid = blockIdx.x, tid = threadIdx.x;
  char* ws = p.ws;
  float* tile = (float*)smem;
  for (int it = bid; it < 1232; it += nb) {
    if (it < 448) {
      int kt = it / 28, nt = it % 28;
      transpose_tile(p.w_in, 1792, (u16*)(ws + W_WTIN), 1024, kt * 64, nt * 64, p.ln1_g, tile);
    } else if (it < 704) {
      int j = it - 448;
      int kt = j >> 4, nt = j & 15;
      const float* gain = (kt < 8) ? p.g_lru : (p.g_attn - 512);
      transpose_tile(p.w_out, 1024, (u16*)(ws + W_WTOUT), 1024, kt * 64, nt * 64, gain, tile);
    } else if (it < 1216) {
      int j = it - 704;
      int kt = j >> 5, nt = j & 31;
      transpose_tile(p.w_query, 2048, (u16*)(ws + W_WTQ), 1024, kt * 64, nt * 64, p.ln2_g, tile);
    } else {
      int j = it - 1216;
      int n = j & 7;
      if (j < 8) transpose_tile(p.lru_wa + n * 4096, 64, (u16*)(ws + W_WAT) + n * 4096, 64, 0, 0, nullptr, tile);
      else transpose_tile(p.lru_wi + n * 4096, 64, (u16*)(ws + W_WIT) + n * 4096, 64, 0, 0, nullptr, tile);
    }
  }
  const size_t gt = (size_t)bid * 256 + tid, gstride = (size_t)nb * 256;
  {
    const float4* g2 = (const float4*)p.ln2_g;
    for (size_t i = gt; i < 16384ull * 128; i += gstride) {
      const float4* su = (const float4*)p.peer_u + i * 2;
      float4 a = su[0], b = su[1];
      int cg8 = (int)(i & 127) * 2;
      float4 ga = g2[cg8], gb = g2[cg8 + 1];
      uint4 o = make_uint4(pk2(a.x * ga.x, a.y * ga.y), pk2(a.z * ga.z, a.w * ga.w), pk2(b.x * gb.x, b.y * gb.y),
                           pk2(b.z * gb.z, b.w * gb.w));
      ((uint4*)(ws + W_UB))[i] = o;
      const float4* sv = (const float4*)p.peer_v + i * 2;
      float4 c = sv[0], d = sv[1];
      uint4 o2 = make_uint4(pk2(c.x, c.y), pk2(c.z, c.w), pk2(d.x, d.y), pk2(d.z, d.w));
      ((uint4*)(ws + W_VB))[i] = o2;
    }
  }
  for (size_t i = gt; i < 4096; i += gstride) {
    const float* s = (i < 2048) ? p.sk1 : p.sk2;
    size_t j = (i & 2047);
    const float4* sp = (const float4*)s + j * 2;
    float4 a = sp[0], b = sp[1];
    uint4 o = make_uint4(pk2(a.x, a.y), pk2(a.z, a.w), pk2(b.x, b.y), pk2(b.z, b.w));
    ((uint4*)(ws + ((i < 2048) ? W_K1B : W_K2B)))[j] = o;
  }
  for (size_t i = gt; i < 512; i += gstride) {
    float l = p.lru_lambda[i];
    float sp = (l < -15.f) ? -l : log1pf(expf(-l));
    ((float*)(ws + W_C8))[i] = -8.0f * sp;
  }
  for (size_t i = gt; i < 16 * 128 * 16; i += gstride) {
    int b = (int)(i >> 11), rem = (int)(i & 2047);
    int t = rem >> 4, c8i = rem & 15;
    const float4* sk = (const float4*)(p.cache_k + ((size_t)(b * 128 + t) * 128 + c8i * 8));
    float4 a = sk[0], bb = sk[1];
    uint4 o = make_uint4(pk2(a.x, a.y), pk2(a.z, a.w), pk2(bb.x, bb.y), pk2(bb.z, bb.w));
    *(uint4*)(ws + W_KS + ((size_t)(b * 192 + t) * 128 + c8i * 8) * 2) = o;
    const float4* sv = (const float4*)(p.cache_v + ((size_t)(b * 128 + t) * 128 + c8i * 8));
    float4 va = sv[0], vb = sv[1];
    if (t >= 16) {
      float4* dk = (float4*)(p.out + O_KS + ((size_t)(b * 128 + t - 16) * 128 + c8i * 8));
      dk[0] = a; dk[1] = bb;
      float4* dv = (float4*)(p.out + O_VS + ((size_t)(b * 128 + t - 16) * 128 + c8i * 8));
      dv[0] = va; dv[1] = vb;
    }
    u16* vt = (u16*)(ws + W_VTS) + (size_t)b * 128 * 192;
    float vv[8] = {va.x, va.y, va.z, va.w, vb.x, vb.y, vb.z, vb.w};
#pragma unroll
    for (int q = 0; q < 8; ++q) vt[(size_t)(c8i * 8 + q) * 192 + t] = (u16)(pk2(vv[q], 0.f) & 0xffffu);
  }
  for (size_t i = gt; i < 16 * 48 * 128; i += gstride) {
    int b = (int)(i / (48 * 128)), rem = (int)(i % (48 * 128));
    ((u16*)(ws + W_KS))[(size_t)(b * 192 + 144) * 128 + rem] = 0;
    int ch = rem / 48, tt = rem % 48;
    ((u16*)(ws + W_VTS))[(size_t)(b * 128 + ch) * 192 + 144 + tt] = 0;
  }
  {
    const int lane = tid & 63;
    const int gw = bid * 4 + (tid >> 6), nw = nb * 4;
    for (int m = gw; m < TT; m += nw) {
      const float* xr = (m < TP) ? (p.x_p + (size_t)m * 1024) : (p.x_s + (size_t)(m - TP) * 1024);
      const float4* xp = (const float4*)xr;
      float ss = 0.f;
      uint4* dst = (uint4*)(ws + W_XB + (size_t)m * 2048);
#pragma unroll
      for (int q = 0; q < 2; ++q) {
        float4 a = xp[q * 128 + lane * 2], b = xp[q * 128 + lane * 2 + 1];
        ss += a.x * a.x + a.y * a.y + a.z * a.z + a.w * a.w + b.x * b.x + b.y * b.y + b.z * b.z + b.w * b.w;
        dst[q * 64 + lane] = make_uint4(pk2(a.x, a.y), pk2(a.z, a.w), pk2(b.x, b.y), pk2(b.z, b.w));
      }
#pragma unroll
      for (int s = 32; s >= 1; s >>= 1) ss += __shfl_xor(ss, s);
      if (lane == 0) ((float*)(ws + W_RS1))[m] = rsqrtf(ss * (1.0f / 1024.0f) + EPS);
    }
  }
}

template <int MODE>
DI void gemm_tile(const Params& p, int mt, int nt, char* smem) {
  constexpr int LROW = 144;
  char* ws = p.ws;
  const char* Wt = ws + (MODE == 1 ? W_WTIN : (MODE == 2 ? W_WTOUT : W_WTQ));
  const char* X = ws + (MODE == 1 ? W_XB : (MODE == 2 ? W_CAT : W_HB));
  char* sW = smem;
  char* sX = smem + 128 * LROW;
  const int tid = threadIdx.x, lane = tid & 63, w = tid >> 6, wn = w & 1, wm = w >> 1;
  const int tl = lane & 31, h = lane >> 5;
  const char* gW = Wt + (size_t)(nt * 128) * 2048;
  const char* gX = X + (size_t)(mt * 128) * 2048;
  u32x4 rW[4], rX[4];
  f32x16 acc[2][2];
#pragma unroll
  for (int i = 0; i < 2; ++i)
#pragma unroll
    for (int j = 0; j < 2; ++j)
#pragma unroll
      for (int r = 0; r < 16; ++r) acc[i][j][r] = 0.f;

  const int m_lane[2] = {mt * 128 + wm * 64 + tl, mt * 128 + wm * 64 + 32 + tl};
  float ratio[2] = {1.f, 1.f}, fscale[2] = {1.f, 1.f};
  if (MODE == 2) {
#pragma unroll
    for (int j = 0; j < 2; ++j) {
      const float4 sl = *(const float4*)(ws + W_SSQL + (size_t)m_lane[j] * 16);
      const float4 sa0 = *(const float4*)(ws + W_SSQA + (size_t)m_lane[j] * 32);
      const float4 sa1 = *(const float4*)(ws + W_SSQA + (size_t)m_lane[j] * 32 + 16);
      float rsl = rsqrtf((sl.x + sl.y + sl.z + sl.w) * (1.0f / 512.0f) + EPS);
      float rsa = rsqrtf((sa0.x + sa0.y + sa0.z + sa0.w + sa1.x + sa1.y + sa1.z + sa1.w) * (1.0f / 512.0f) + EPS);
      ratio[j] = rsl / rsa;
      fscale[j] = rsa;
    }
  } else if (MODE == 1) {
#pragma unroll
    for (int j = 0; j < 2; ++j) fscale[j] = ((const float*)(ws + W_RS1))[m_lane[j]];
  } else {
#pragma unroll
    for (int j = 0; j < 2; ++j) {
      const float4* sp = (const float4*)(ws + W_SSQ2 + (size_t)m_lane[j] * 64);
      float4 a = sp[0], b = sp[1], c = sp[2], d = sp[3];
      float s = a.x + a.y + a.z + a.w + b.x + b.y + b.z + b.w + c.x + c.y + c.z + c.w + d.x + d.y + d.z + d.w;
      fscale[j] = rsqrtf(s * (1.0f / 1024.0f) + EPS);
    }
  }

#pragma unroll
  for (int i = 0; i < 4; ++i) {
    int c = tid + 256 * i, row = c >> 3, kc = c & 7;
    rW[i] = *(const u32x4*)(gW + (size_t)row * 2048 + kc * 16);
    rX[i] = *(const u32x4*)(gX + (size_t)row * 2048 + kc * 16);
  }
  for (int ks = 0; ks < 16; ++ks) {
    __syncthreads();
#pragma unroll
    for (int i = 0; i < 4; ++i) {
      int c = tid + 256 * i, row = c >> 3, kc = c & 7;
      *(u32x4*)(sW + row * LROW + kc * 16) = rW[i];
      *(u32x4*)(sX + row * LROW + kc * 16) = rX[i];
    }
    __syncthreads();
    if (ks + 1 < 16) {
#pragma unroll
      for (int i = 0; i < 4; ++i) {
        int c = tid + 256 * i, row = c >> 3, kc = c & 7;
        rW[i] = *(const u32x4*)(gW + (size_t)row * 2048 + (ks + 1) * 128 + kc * 16);
        rX[i] = *(const u32x4*)(gX + (size_t)row * 2048 + (ks + 1) * 128 + kc * 16);
      }
    }
    if (MODE == 2 && ks == 8) {
#pragma unroll
      for (int i = 0; i < 2; ++i)
#pragma unroll
        for (int j = 0; j < 2; ++j)
#pragma unroll
          for (int r = 0; r < 16; ++r) acc[i][j][r] *= ratio[j];
    }
#pragma unroll
    for (int kk = 0; kk < 4; ++kk) {
      bf16x8 a[2], b[2];
#pragma unroll
      for (int i = 0; i < 2; ++i) a[i] = *(const bf16x8*)(sW + (wn * 64 + i * 32 + tl) * LROW + kk * 32 + h * 16);
#pragma unroll
      for (int j = 0; j < 2; ++j) b[j] = *(const bf16x8*)(sX + (wm * 64 + j * 32 + tl) * LROW + kk * 32 + h * 16);
#pragma unroll
      for (int i = 0; i < 2; ++i)
#pragma unroll
        for (int j = 0; j < 2; ++j) acc[i][j] = MFMA32(a[i], b[j], acc[i][j]);
    }
  }

  const int ncol0 = nt * 128 + wn * 64;
  if (MODE == 1) {
    if (ncol0 < 512) {
#pragma unroll
      for (int j = 0; j < 2; ++j) {
        const int m = m_lane[j];
        float* convdst = nullptr;
        if (m < TP) {
          int t = m & 2047;
          if (t >= 2045) convdst = p.out + O_CONVP + (size_t)((m >> 11) * 3 + (t - 2045)) * 512;
        } else {
          int ms = m - TP, t = ms & 15;
          if (t >= 13) convdst = p.out + O_CONVS + (size_t)((ms >> 4) * 3 + (t - 13)) * 512;
        }
        u16* ub = (u16*)(ws + W_U) + (size_t)m * 512;
#pragma unroll
        for (int i = 0; i < 2; ++i)
#pragma unroll
          for (int g = 0; g < 4; ++g) {
            int n = ncol0 + i * 32 + 8 * g + 4 * h;
            float v0 = acc[i][j][4 * g] * fscale[j], v1 = acc[i][j][4 * g + 1] * fscale[j],
                  v2 = acc[i][j][4 * g + 2] * fscale[j], v3 = acc[i][j][4 * g + 3] * fscale[j];
            *(uint2*)(ub + n) = make_uint2(pk2(v0, v1), pk2(v2, v3));
            if (convdst) *(float4*)(convdst + n) = make_float4(v0, v1, v2, v3);
          }
      }
    } else if (ncol0 < 1024) {
#pragma unroll
      for (int j = 0; j < 2; ++j) {
        u16* gb = (u16*)(ws + W_GG) + (size_t)m_lane[j] * 512;
#pragma unroll
        for (int i = 0; i < 2; ++i)
#pragma unroll
          for (int g = 0; g < 4; ++g) {
            int n = ncol0 - 512 + i * 32 + 8 * g + 4 * h;
            float v0 = gelu_(acc[i][j][4 * g] * fscale[j]), v1 = gelu_(acc[i][j][4 * g + 1] * fscale[j]),
                  v2 = gelu_(acc[i][j][4 * g + 2] * fscale[j]), v3 = gelu_(acc[i][j][4 * g + 3] * fscale[j]);
            *(uint2*)(gb + n) = make_uint2(pk2(v0, v1), pk2(v2, v3));
          }
      }
    } else if (ncol0 < 1664) {
      const bool isq = ncol0 < 1536;
      const float* gain = isq ? p.q_g : p.k_g;
      const float post = isq ? 0.125f : 1.0f;
#pragma unroll
      for (int j = 0; j < 2; ++j) {
        const int m = m_lane[j];
        float ss = 0.f;
#pragma unroll
        for (int i = 0; i < 2; ++i)
#pragma unroll
          for (int r = 0; r < 16; ++r) {
            float v = acc[i][j][r] * fscale[j];
            ss += v * v;
          }
        ss += __shfl_xor(ss, 32);
        const float sc = fscale[j] * rsqrtf(ss * (1.0f / 64.0f) + EPS) * post;
        u16* dst;
        float* fdst = nullptr;
        int nloc0;
        if (isq) {
          nloc0 = ncol0 - 1024;
          dst = (u16*)(ws + W_Q) + (size_t)m * 512 + nloc0;
        } else {
          nloc0 = ncol0 - 1536;
          if (m < TP) {
            dst = (u16*)(ws + W_KP) + (size_t)m * 128 + nloc0;
            int t = m & 2047;
            if (t >= 1920) fdst = p.out + O_KP + (size_t)((m >> 11) * 128 + (t - 1920)) * 128 + nloc0;
          } else {
            int ms = m - TP, b = ms >> 4, t = ms & 15;
            dst = (u16*)(ws + W_KS) + (size_t)(b * 192 + 128 + t) * 128 + nloc0;
            fdst = p.out + O_KS + (size_t)(b * 128 + 112 + t) * 128 + nloc0;
          }
        }
#pragma unroll
        for (int i = 0; i < 2; ++i)
#pragma unroll
          for (int g = 0; g < 4; ++g) {
            int d = i * 32 + 8 * g + 4 * h;
            const float4 gn = *(const float4*)(gain + d);
            float v0 = acc[i][j][4 * g] * sc * gn.x, v1 = acc[i][j][4 * g + 1] * sc * gn.y,
                  v2 = acc[i][j][4 * g + 2] * sc * gn.z, v3 = acc[i][j][4 * g + 3] * sc * gn.w;
            *(uint2*)(dst + d) = make_uint2(pk2(v0, v1), pk2(v2, v3));
            if (fdst) *(float4*)(fdst + d) = make_float4(v0, v1, v2, v3);
          }
      }
    } else {
#pragma unroll
      for (int j = 0; j < 2; ++j) {
        const int m = m_lane[j];
        u16* vt;
        size_t vstride;
        float* fdst = nullptr;
        const int ch0 = ncol0 - 1664;
        if (m < TP) {
          int b = m >> 11, t = m & 2047;
          vt = (u16*)(ws + W_VTP) + (size_t)b * 128 * 2048 + t;
          vstride = 2048;
          if (t >= 1920) fdst = p.out + O_VP + (size_t)(b * 128 + (t - 1920)) * 128;
        } else {
          int ms = m - TP, b = ms >> 4, t = ms & 15;
          vt = (u16*)(ws + W_VTS) + (size_t)b * 128 * 192 + 128 + t;
          vstride = 192;
          fdst = p.out + O_VS + (size_t)(b * 128 + 112 + t) * 128;
        }
#pragma unroll
        for (int i = 0; i < 2; ++i)
#pragma unroll
          for (int g = 0; g < 4; ++g) {
            int ch = ch0 + i * 32 + 8 * g + 4 * h;
            float v0 = acc[i][j][4 * g] * fscale[j], v1 = acc[i][j][4 * g + 1] * fscale[j],
                  v2 = acc[i][j][4 * g + 2] * fscale[j], v3 = acc[i][j][4 * g + 3] * fscale[j];
            unsigned p01 = pk2(v0, v1), p23 = pk2(v2, v3);
            vt[(size_t)(ch + 0) * vstride] = (u16)(p01 & 0xffffu);
            vt[(size_t)(ch + 1) * vstride] = (u16)(p01 >> 16);
            vt[(size_t)(ch + 2) * vstride] = (u16)(p23 & 0xffffu);
            vt[(size_t)(ch + 3) * vstride] = (u16)(p23 >> 16);
            if (fdst) *(float4*)(fdst + ch) = make_float4(v0, v1, v2, v3);
          }
      }
    }
  } else if (MODE == 2) {
#pragma unroll
    for (int j = 0; j < 2; ++j) {
      const int m = m_lane[j];
      const float* xr = (m < TP) ? (p.x_p + (size_t)m * 1024) : (p.x_s + (size_t)(m - TP) * 1024);
      float* yr = p.out + O_Y + (size_t)m * 1024;
      u16* hb = (u16*)(ws + W_HB) + (size_t)m * 1024;
      float ss = 0.f;
#pragma unroll
      for (int i = 0; i < 2; ++i)
#pragma unroll
        for (int g = 0; g < 4; ++g) {
          int n = ncol0 + i * 32 + 8 * g + 4 * h;
          const float4 xv = *(const float4*)(xr + n);
          float v0 = xv.x + acc[i][j][4 * g] * fscale[j], v1 = xv.y + acc[i][j][4 * g + 1] * fscale[j],
                v2 = xv.z + acc[i][j][4 * g + 2] * fscale[j], v3 = xv.w + acc[i][j][4 * g + 3] * fscale[j];
          *(float4*)(yr + n) = make_float4(v0, v1, v2, v3);
          *(uint2*)(hb + n) = make_uint2(pk2(v0, v1), pk2(v2, v3));
          ss += v0 * v0 + v1 * v1 + v2 * v2 + v3 * v3;
        }
      ss += __shfl_xor(ss, 32);
      if (h == 0) ((float*)(ws + W_SSQ2))[(size_t)m * 16 + nt * 2 + wn] = ss;
    }
  } else {
#pragma unroll
    for (int j = 0; j < 2; ++j) {
      u16* pq = (u16*)(ws + W_PQ) + (size_t)m_lane[j] * 2048;
#pragma unroll
      for (int i = 0; i < 2; ++i)
#pragma unroll
        for (int g = 0; g < 4; ++g) {
          int n = ncol0 + i * 32 + 8 * g + 4 * h;
          float v0 = acc[i][j][4 * g] * fscale[j], v1 = acc[i][j][4 * g + 1] * fscale[j],
                v2 = acc[i][j][4 * g + 2] * fscale[j], v3 = acc[i][j][4 * g + 3] * fscale[j];
          *(uint2*)(pq + n) = make_uint2(pk2(v0, v1), pk2(v2, v3));
        }
    }
  }
}

template <int FINAL>
DI void lru_item(const Params& p, int item, char* smem) {
  char* ws = p.ws;
  const bool samp = item >= 512;
  int b, c, m0, nvalid;
  if (!samp) { b = item >> 6; c = item & 63; m0 = b * 2048 + c * 32; nvalid = 32; }
  else { b = item - 512; c = 0; m0 = TP + b * 16; nvalid = 16; }
  const int tid = threadIdx.x, lane = tid & 63, w = tid >> 6, tl = lane & 31, h = lane >> 5;
  u16* XC = (u16*)smem;
  float* hin = (float*)(smem + 32 * 1040);
  __syncthreads();
  {
    const int ch = 2 * tid;
    const float2 w0 = *(const float2*)(p.conv_w + ch), w1 = *(const float2*)(p.conv_w + 512 + ch),
                 w2 = *(const float2*)(p.conv_w + 1024 + ch), w3 = *(const float2*)(p.conv_w + 1536 + ch),
                 cb = *(const float2*)(p.conv_b + ch);
    float2 r0 = {0.f, 0.f}, r1 = {0.f, 0.f}, r2 = {0.f, 0.f};
    const u16* ub = (const u16*)(ws + W_U);
    if (!samp) {
      if (c > 0) {
        unsigned a0 = *(const unsigned*)(ub + (size_t)(m0 - 3) * 512 + ch), a1 = *(const unsigned*)(ub + (size_t)(m0 - 2) * 512 + ch),
                 a2 = *(const unsigned*)(ub + (size_t)(m0 - 1) * 512 + ch);
        r0 = {bf_lo(a0), bf_hi(a0)}; r1 = {bf_lo(a1), bf_hi(a1)}; r2 = {bf_lo(a2), bf_hi(a2)};
      }
    } else {
      const float* sc = p.state_conv + (size_t)b * 3 * 512 + ch;
      r0 = *(const float2*)(sc); r1 = *(const float2*)(sc + 512); r2 = *(const float2*)(sc + 1024);
    }
#pragma unroll 8
    for (int t = 0; t < 32; ++t) {
      float2 cur = {0.f, 0.f};
      if (t < nvalid) {
        unsigned a = *(const unsigned*)(ub + (size_t)(m0 + t) * 512 + ch);
        cur = {bf_lo(a), bf_hi(a)};
      }
      float x0 = cb.x + w0.x * r0.x + w1.x * r1.x + w2.x * r2.x + w3.x * cur.x;
      float x1 = cb.y + w0.y * r0.y + w1.y * r1.y + w2.y * r2.y + w3.y * cur.y;
      *(unsigned*)(XC + t * 520 + ch) = pk2(x0, x1);
      r0 = r1; r1 = r2; r2 = cur;
    }
    if (FINAL) {
      float2 hh;
      if (samp) hh = *(const float2*)(p.state_lru + (size_t)b * 512 + ch);
      else {
        hh = {0.f, 0.f};
        const float* sA = (const float*)(ws + W_SUMA) + (size_t)(b * 64) * 512 + ch;
        const float* sH = (const float*)(ws + W_SUMH) + (size_t)(b * 64) * 512 + ch;
        int cc = 0;
        for (; cc + 4 <= c; cc += 4) {
          float2 A0 = *(const float2*)(sA + (size_t)(cc + 0) * 512), H0 = *(const float2*)(sH + (size_t)(cc + 0) * 512);
          float2 A1 = *(const float2*)(sA + (size_t)(cc + 1) * 512), H1 = *(const float2*)(sH + (size_t)(cc + 1) * 512);
          float2 A2 = *(const float2*)(sA + (size_t)(cc + 2) * 512), H2 = *(const float2*)(sH + (size_t)(cc + 2) * 512);
          float2 A3 = *(const float2*)(sA + (size_t)(cc + 3) * 512), H3 = *(const float2*)(sH + (size_t)(cc + 3) * 512);
          hh.x = A0.x * hh.x + H0.x; hh.y = A0.y * hh.y + H0.y;
          hh.x = A1.x * hh.x + H1.x; hh.y = A1.y * hh.y + H1.y;
          hh.x = A2.x * hh.x + H2.x; hh.y = A2.y * hh.y + H2.y;
          hh.x = A3.x * hh.x + H3.x; hh.y = A3.y * hh.y + H3.y;
        }
        for (; cc < c; ++cc) {
          float2 A0 = *(const float2*)(sA + (size_t)cc * 512), H0 = *(const float2*)(sH + (size_t)cc * 512);
          hh.x = A0.x * hh.x + H0.x; hh.y = A0.y * hh.y + H0.y;
        }
      }
      hin[ch] = hh.x; hin[ch + 1] = hh.y;
    }
  }
  __syncthreads();
  const u16* WaT = (const u16*)(ws + W_WAT);
  const u16* WiT = (const u16*)(ws + W_WIT);
  const float* c8 = (const float*)(ws + W_C8);
  const int m = m0 + tl;
  const bool valid = tl < nvalid;
  float ssq = 0.f;
#pragma unroll 1
  for (int nbk = 0; nbk < 2; ++nbk) {
    const int n = 2 * w + nbk;
    f32x16 accA[2], accI[2];
#pragma unroll
    for (int i = 0; i < 2; ++i)
#pragma unroll
      for (int r = 0; r < 16; ++r) { accA[i][r] = 0.f; accI[i][r] = 0.f; }
#pragma unroll
    for (int kk = 0; kk < 4; ++kk) {
      const bf16x8 bx = *(const bf16x8*)((const char*)XC + tl * 1040 + (n * 64 + kk * 16 + h * 8) * 2);
#pragma unroll
      for (int i = 0; i < 2; ++i) {
        const bf16x8 aa = *(const bf16x8*)(WaT + (size_t)(n * 64 + i * 32 + tl) * 64 + kk * 16 + h * 8);
        const bf16x8 ai = *(const bf16x8*)(WiT + (size_t)(n * 64 + i * 32 + tl) * 64 + kk * 16 + h * 8);
        accA[i] = MFMA32(aa, bx, accA[i]);
        accI[i] = MFMA32(ai, bx, accI[i]);
      }
    }
#pragma unroll
    for (int i = 0; i < 2; ++i)
#pragma unroll
      for (int g = 0; g < 4; ++g) {
        const int ch = n * 64 + i * 32 + 8 * g + 4 * h;
        const float4 ba4 = *(const float4*)(p.lru_ba + ch), bi4 = *(const float4*)(p.lru_bi + ch), c84 = *(const float4*)(c8 + ch);
        const float bav[4] = {ba4.x, ba4.y, ba4.z, ba4.w}, biv[4] = {bi4.x, bi4.y, bi4.z, bi4.w}, c8v[4] = {c84.x, c84.y, c84.z, c84.w};
        const uint2 xcp = *(const uint2*)(XC + tl * 520 + ch);
        const float xcv[4] = {bf_lo(xcp.x), bf_hi(xcp.x), bf_lo(xcp.y), bf_hi(xcp.y)};
        float hv[4];
#pragma unroll
        for (int q = 0; q < 4; ++q) {
          const int r = 4 * g + q;
          float rr = sigmoidf_(accA[i][r] + bav[q]);
          float ii = sigmoidf_(accI[i][r] + biv[q]);
          float la = c8v[q] * rr;
          float A = __expf(la);
          float x2 = 2.0f * la;
          float em = -x2 * (1.0f + x2 * (0.5f + x2 * (0.16666667f + x2 * (0.041666668f + x2 * (0.0083333333f + x2 * 0.0013888889f)))));
          float H = sqrtf(fmaxf(em, 0.f)) * ii * xcv[q];
#pragma unroll
          for (int dlt = 1; dlt < 32; dlt <<= 1) {
            float Ap = __shfl_up(A, dlt, 32), Hp = __shfl_up(H, dlt, 32);
            if (tl >= dlt) { H = A * Hp + H; A = A * Ap; }
          }
          if (!FINAL) {
            if (tl == 31) {
              ((float*)(ws + W_SUMA))[(size_t)(b * 64 + c) * 512 + ch + q] = A;
              ((float*)(ws + W_SUMH))[(size_t)(b * 64 + c) * 512 + ch + q] = H;
            }
          } else {
            hv[q] = H + A * hin[ch + q];
          }
        }
        if (FINAL) {
          if (tl == nvalid - 1 && (samp || c == 63)) {
            float* dst = p.out + (samp ? O_LRUS : O_LRUP) + (size_t)b * 512 + ch;
            *(float4*)dst = make_float4(hv[0], hv[1], hv[2], hv[3]);
          }
          if (valid) {
            const uint2 gp = *(const uint2*)((const u16*)(ws + W_GG) + (size_t)m * 512 + ch);
            float o0 = hv[0] * bf_lo(gp.x), o1 = hv[1] * bf_hi(gp.x), o2 = hv[2] * bf_lo(gp.y), o3 = hv[3] * bf_hi(gp.y);
            ssq += o0 * o0 + o1 * o1 + o2 * o2 + o3 * o3;
            *(uint2*)((u16*)(ws + W_CAT) + (size_t)m * 1024 + ch) = make_uint2(pk2(o0, o1), pk2(o2, o3));
          }
        }
      }
  }
  if (FINAL) {
    ssq += __shfl_xor(ssq, 32);
    if (valid && h == 0) ((float*)(ws + W_SSQL))[(size_t)m * 4 + w] = ssq;
  }
}

DI void attn_item(const Params& p, int item, char* smem) {
  char* ws = p.ws;
  const int tid = threadIdx.x, lane = tid & 63, w = tid >> 6, tl = lane & 31, h = lane >> 5;
  const bool samp = item >= 512;
  int b, c, g;
  const u16* Kb; const u16* Vt; int vstride, kc_lo, kc_hi, nkeys, mq0; bool qvalid;
  if (!samp) {
    b = item >> 6; c = (item >> 1) & 31; g = item & 1;
    Kb = (const u16*)(ws + W_KP) + (size_t)b * 2048 * 128;
    Vt = (const u16*)(ws + W_VTP) + (size_t)b * 128 * 2048;
    vstride = 2048; kc_lo = (c >= 2) ? c - 2 : 0; kc_hi = c; nkeys = 1 << 30;
    mq0 = b * 2048 + c * 64 + tl; qvalid = true;
  } else {
    int it = item - 512; b = it >> 1; g = it & 1; c = 0;
    Kb = (const u16*)(ws + W_KS) + (size_t)b * 192 * 128;
    Vt = (const u16*)(ws + W_VTS) + (size_t)b * 128 * 192;
    vstride = 192; kc_lo = 0; kc_hi = 2; nkeys = 144;
    mq0 = TP + b * 16 + (tl & 15); qvalid = tl < 16;
  }
  const int hq = g * 4 + w;
  const float sink = p.sinks[hq];
  char* sV = smem;
  const int nj = samp ? 1 : 2;
#pragma unroll 1
  for (int j = 0; j < nj; ++j) {
    const int mqj = mq0 + j * 32;
    bf16x8 bq[4];
#pragma unroll
    for (int kk = 0; kk < 4; ++kk)
      bq[kk] = *(const bf16x8*)((const u16*)(ws + W_Q) + (size_t)mqj * 512 + hq * 64 + kk * 16 + h * 8);
    float mrun = sink, lrun = 1.f;
    f32x16 O[2];
#pragma unroll
    for (int i = 0; i < 2; ++i)
#pragma unroll
      for (int r = 0; r < 16; ++r) O[i][r] = 0.f;
#pragma unroll 1
    for (int kc = kc_lo; kc <= kc_hi; ++kc) {
      __syncthreads();
#pragma unroll
      for (int i = 0; i < 2; ++i) {
        int idx = tid + 256 * i, d = idx >> 3, part = idx & 7;
        *(u32x4*)(sV + d * 144 + part * 16) = *(const u32x4*)(Vt + (size_t)(g * 64 + d) * vstride + kc * 64 + part * 8);
      }
      f32x16 S[2];
#pragma unroll
      for (int i = 0; i < 2; ++i)
#pragma unroll
        for (int r = 0; r < 16; ++r) S[i][r] = 0.f;
#pragma unroll
      for (int kk = 0; kk < 4; ++kk)
#pragma unroll
        for (int kt = 0; kt < 2; ++kt) {
          const bf16x8 ak = *(const bf16x8*)(Kb + (size_t)(kc * 64 + kt * 32 + tl) * 128 + g * 64 + kk * 16 + h * 8);
          S[kt] = MFMA32(ak, bq[kk], S[kt]);
        }
      if (samp) {
#pragma unroll
        for (int kt = 0; kt < 2; ++kt)
#pragma unroll
          for (int r = 0; r < 16; ++r) {
            int key = kc * 64 + kt * 32 + crow(r, h);
            if (key >= nkeys) S[kt][r] = -INFINITY;
          }
      }
      {
        float mx = -INFINITY;
#pragma unroll
        for (int kt = 0; kt < 2; ++kt)
#pragma unroll
          for (int r = 0; r < 16; ++r) mx = fmaxf(mx, S[kt][r]);
        mx = fmaxf(mx, __shfl_xor(mx, 32));
        const float mnew = fmaxf(mrun, mx);
        const float alpha = __expf(mrun - mnew);
        float ps = 0.f;
#pragma unroll
        for (int kt = 0; kt < 2; ++kt)
#pragma unroll
          for (int r = 0; r < 16; ++r) {
            float pv = __expf(S[kt][r] - mnew);
            S[kt][r] = pv;
            ps += pv;
          }
        ps += __shfl_xor(ps, 32);
        lrun = lrun * alpha + ps;
        mrun = mnew;
#pragma unroll
        for (int dt = 0; dt < 2; ++dt)
#pragma unroll
          for (int r = 0; r < 16; ++r) O[dt][r] *= alpha;
      }
      __syncthreads();
#pragma unroll
      for (int kt = 0; kt < 2; ++kt)
#pragma unroll
        for (int s2 = 0; s2 < 2; ++s2) {
          u32x4 pp;
          pp[0] = pk2(S[kt][8 * s2 + 0], S[kt][8 * s2 + 1]);
          pp[1] = pk2(S[kt][8 * s2 + 2], S[kt][8 * s2 + 3]);
          pp[2] = pk2(S[kt][8 * s2 + 4], S[kt][8 * s2 + 5]);
          pp[3] = pk2(S[kt][8 * s2 + 6], S[kt][8 * s2 + 7]);
          const bf16x8 bp = __builtin_bit_cast(bf16x8, pp);
#pragma unroll
          for (int dt = 0; dt < 2; ++dt) {
            const int d = dt * 32 + tl;
            const uint2 lo = *(const uint2*)(sV + d * 144 + (kt * 32 + 16 * s2 + 4 * h) * 2);
            const uint2 hi = *(const uint2*)(sV + d * 144 + (kt * 32 + 16 * s2 + 8 + 4 * h) * 2);
            u32x4 av4;
            av4[0] = lo.x; av4[1] = lo.y; av4[2] = hi.x; av4[3] = hi.y;
            O[dt] = MFMA32(__builtin_bit_cast(bf16x8, av4), bp, O[dt]);
          }
        }
    }
    const float inv = 1.0f / lrun;
    float ss = 0.f;
    u16* dst = (u16*)(ws + W_CAT) + (size_t)mqj * 1024 + 512 + hq * 64;
#pragma unroll
    for (int dt = 0; dt < 2; ++dt)
#pragma unroll
      for (int g4 = 0; g4 < 4; ++g4) {
        int d = dt * 32 + 8 * g4 + 4 * h;
        float v0 = O[dt][4 * g4] * inv, v1 = O[dt][4 * g4 + 1] * inv, v2 = O[dt][4 * g4 + 2] * inv, v3 = O[dt][4 * g4 + 3] * inv;
        ss += v0 * v0 + v1 * v1 + v2 * v2 + v3 * v3;
        if (qvalid) *(uint2*)(dst + d) = make_uint2(pk2(v0, v1), pk2(v2, v3));
      }
    ss += __shfl_xor(ss, 32);
    if (qvalid && h == 0) ((float*)(ws + W_SSQA))[(size_t)mqj * 8 + hq] = ss;
  }
}

DI unsigned f2ord(float f) { unsigned u = __float_as_uint(f); return u ^ ((unsigned)((int)u >> 31) | 0x80000000u); }
DI float ord2f(unsigned u) { return __uint_as_float((u & 0x80000000u) ? (u ^ 0x80000000u) : ~u); }
DI void cas_desc(unsigned& a, unsigned& b) { unsigned mx = a > b ? a : b, mn = a > b ? b : a; a = mx; b = mn; }
DI void sort16_desc(unsigned (&v)[16]) {
#pragma unroll
  for (int k = 2; k <= 16; k <<= 1)
#pragma unroll
    for (int j = k >> 1; j > 0; j >>= 1)
#pragma unroll
      for (int i = 0; i < 16; ++i) {
        int l = i ^ j;
        if (l > i) {
          if ((i & k) == 0) cas_desc(v[i], v[l]); else cas_desc(v[l], v[i]);
        }
      }
}
DI void merge16_desc(unsigned (&v)[16]) {
#pragma unroll
  for (int j = 8; j > 0; j >>= 1)
#pragma unroll
    for (int i = 0; i < 16; ++i) {
      int l = i ^ j;
      if (l > i) cas_desc(v[i], v[l]);
    }
}
DI void merge_top16(unsigned (&a)[16], unsigned (&b)[16]) {
#pragma unroll
  for (int i = 0; i < 16; ++i) a[i] = a[i] > b[15 - i] ? a[i] : b[15 - i];
  merge16_desc(a);
}

struct CandTab { int i[64]; int j[64]; int n; };
constexpr CandTab make_tab() {
  CandTab t{};
  int n = 0;
  for (int i = 0; i < 16; ++i)
    for (int j = 0; j < 16; ++j)
      if ((i + 1) * (j + 1) <= 16) { t.i[n] = i; t.j[n] = j; ++n; }
  t.n = n;
  return t;
}

DI void route_item(const Params& p, int item, char* smem) {
  char* ws = p.ws;
  const int tid = threadIdx.x, lane = tid & 63, w = tid >> 6, tl = lane & 31, h = lane >> 5;
  const int tt = item >> 3, hd = item & 7;
  const int m0 = tt * 64;
  const int half = w >> 1, tq = w & 1;
  const int m = m0 + tq * 32 + tl;
  unsigned* L = (unsigned*)smem;
  __syncthreads();
  {
    const u16* Kb = (const u16*)(ws + (half ? W_K2B : W_K1B));
    const u16* pq = (const u16*)(ws + W_PQ) + (size_t)m * 2048 + hd * 256 + half * 128;
    f32x16 acc[4];
#pragma unroll
    for (int kt = 0; kt < 4; ++kt)
#pragma unroll
      for (int r = 0; r < 16; ++r) acc[kt][r] = 0.f;
#pragma unroll
    for (int kk = 0; kk < 8; ++kk) {
      const bf16x8 bqv = *(const bf16x8*)(pq + kk * 16 + h * 8);
#pragma unroll
      for (int kt = 0; kt < 4; ++kt) {
        const bf16x8 ak = *(const bf16x8*)(Kb + (size_t)(kt * 32 + tl) * 128 + kk * 16 + h * 8);
        acc[kt] = MFMA32(ak, bqv, acc[kt]);
      }
    }
    unsigned top[16], tmp[16];
#pragma unroll
    for (int r = 0; r < 16; ++r) top[r] = (f2ord(acc[0][r]) & ~127u) | (unsigned)(127 - (0 * 32 + crow(r, h)));
    sort16_desc(top);
#pragma unroll
    for (int kt = 1; kt < 4; ++kt) {
#pragma unroll
      for (int r = 0; r < 16; ++r) tmp[r] = (f2ord(acc[kt][r]) & ~127u) | (unsigned)(127 - (kt * 32 + crow(r, h)));
      sort16_desc(tmp);
      merge_top16(top, tmp);
    }
#pragma unroll
    for (int i = 0; i < 16; ++i) tmp[i] = __shfl_xor(top[i], 32);
    merge_top16(top, tmp);
    if (h == 0) {
      uint4* dst = (uint4*)(L + (half * 64 + tq * 32 + tl) * 16);
      dst[0] = make_uint4(top[0], top[1], top[2], top[3]);
      dst[1] = make_uint4(top[4], top[5], top[6], top[7]);
      dst[2] = make_uint4(top[8], top[9], top[10], top[11]);
      dst[3] = make_uint4(top[12], top[13], top[14], top[15]);
    }
  }
  __syncthreads();
  if (tid < 64) {
    constexpr CandTab CT = make_tab();
    const int tok = tid;
    unsigned l1[16], l2[16];
    {
      const uint4* s1 = (const uint4*)(L + tok * 16);
      const uint4* s2 = (const uint4*)(L + (64 + tok) * 16);
#pragma unroll
      for (int q = 0; q < 4; ++q) {
        uint4 a = s1[q], b = s2[q];
        l1[4 * q] = a.x; l1[4 * q + 1] = a.y; l1[4 * q + 2] = a.z; l1[4 * q + 3] = a.w;
        l2[4 * q] = b.x; l2[4 * q + 1] = b.y; l2[4 * q + 2] = b.z; l2[4 * q + 3] = b.w;
      }
    }
    float f1[16], f2[16];
#pragma unroll
    for (int i = 0; i < 16; ++i) { f1[i] = ord2f(l1[i] & ~127u); f2[i] = ord2f(l2[i] & ~127u); }
    unsigned top[16], tmp[16];
#pragma unroll
    for (int grp = 0; grp < 4; ++grp) {
#pragma unroll
      for (int q = 0; q < 16; ++q) {
        const int cidx = grp * 16 + q;
        unsigned key = 0;
        if (cidx < CT.n) {
          const int ci = CT.i[cidx], cj = CT.j[cidx];
          key = (f2ord(f1[ci] + f2[cj]) & ~255u) | (unsigned)(255 - (ci * 16 + cj));
        }
        if (grp == 0) top[q] = key; else tmp[q] = key;
      }
      if (grp == 0) sort16_desc(top);
      else { sort16_desc(tmp); merge_top16(top, tmp); }
    }
    float sv[16]; int ex[16];
    float smax = -INFINITY;
#pragma unroll
    for (int q = 0; q < 16; ++q) {
      const int code = 255 - (int)(top[q] & 255u);
      const int ci = code >> 4, cj = code & 15;
      const unsigned a = L[tok * 16 + ci], bb = L[(64 + tok) * 16 + cj];
      const int i1 = 127 - (int)(a & 127u), i2 = 127 - (int)(bb & 127u);
      sv[q] = ord2f(a & ~127u) + ord2f(bb & ~127u);
      ex[q] = i1 * 128 + i2;
      smax = fmaxf(smax, sv[q]);
    }
    float sum = 0.f;
#pragma unroll
    for (int q = 0; q < 16; ++q) { sv[q] = __expf(sv[q] - smax); sum += sv[q]; }
    const float inv = 1.0f / sum;
    const int mm = m0 + tok;
    int4* di = (int4*)((int*)(ws + W_SIDX) + (size_t)mm * 128 + hd * 16);
    float4* dg = (float4*)((float*)(ws + W_SGATE) + (size_t)mm * 128 + hd * 16);
#pragma unroll
    for (int q = 0; q < 4; ++q) {
      di[q] = make_int4(ex[4 * q], ex[4 * q + 1], ex[4 * q + 2], ex[4 * q + 3]);
      dg[q] = make_float4(sv[4 * q] * inv, sv[4 * q + 1] * inv, sv[4 * q + 2] * inv, sv[4 * q + 3] * inv);
    }
  }
}

DI float dot2bf(unsigned a, unsigned b, float c) {
  return __builtin_amdgcn_fdot2_f32_bf16(__builtin_bit_cast(bf2_t, a), __builtin_bit_cast(bf2_t, b), c, false);
}
DI void peer_gather(const Params& p) {
  char* ws = p.ws;
  const int lane = threadIdx.x & 63, w = threadIdx.x >> 6;
  const int gw = blockIdx.x * 4 + w, nw = gridDim.x * 4;
  const char* UB = ws + W_UB;
  const char* VB = ws + W_VB;
  for (int m = gw; m < TT; m += nw) {
    const uint4* hp = (const uint4*)(ws + W_HB + (size_t)m * 2048);
    const uint4 h0 = hp[lane], h1 = hp[64 + lane];
    float ss = ((const float*)(ws + W_SSQ2))[(size_t)m * 16 + (lane & 15)];
    ss += __shfl_xor(ss, 8); ss += __shfl_xor(ss, 4); ss += __shfl_xor(ss, 2); ss += __shfl_xor(ss, 1);
    const float rs2 = rsqrtf(ss * (1.0f / 1024.0f) + EPS);
    const int* sidx = (const int*)(ws + W_SIDX) + (size_t)m * 128;
    const float* sg = (const float*)(ws + W_SGATE) + (size_t)m * 128;
    const int idx[2] = {sidx[lane], sidx[64 + lane]};
    const float gt[2] = {sg[lane], sg[64 + lane]};
    float wv[2];
#pragma unroll
    for (int bt = 0; bt < 2; ++bt) {
      float pacc[64];
#pragma unroll
      for (int e0 = 0; e0 < 64; e0 += 8) {
        uint4 ra[8], rb[8];
#pragma unroll
        for (int u = 0; u < 8; ++u) {
          const int row = __builtin_amdgcn_readlane(idx[bt], e0 + u);
          const uint4* rp = (const uint4*)(UB + (size_t)row * 2048);
          ra[u] = rp[lane];
          rb[u] = rp[64 + lane];
        }
#pragma unroll
        for (int u = 0; u < 8; ++u) {
          float a0 = 0.f, a1 = 0.f;
          a0 = dot2bf(ra[u].x, h0.x, a0); a1 = dot2bf(ra[u].y, h0.y, a1);
          a0 = dot2bf(ra[u].z, h0.z, a0); a1 = dot2bf(ra[u].w, h0.w, a1);
          a0 = dot2bf(rb[u].x, h1.x, a0); a1 = dot2bf(rb[u].y, h1.y, a1);
          a0 = dot2bf(rb[u].z, h1.z, a0); a1 = dot2bf(rb[u].w, h1.w, a1);
          pacc[e0 + u] = a0 + a1;
        }
      }
#pragma unroll
      for (int s = 32; s >= 1; s >>= 1) {
        const bool upper = (lane & s) != 0;
#pragma unroll
        for (int i = 0; i < s; ++i) {
          const float send = upper ? pacc[i] : pacc[i + s];
          const float keep = upper ? pacc[i + s] : pacc[i];
          pacc[i] = keep + __shfl_xor(send, s);
        }
      }
      wv[bt] = gelu_(pacc[0] * rs2) * gt[bt];
    }
    float o[16];
#pragma unroll
    for (int q = 0; q < 16; ++q) o[q] = 0.f;
#pragma unroll
    for (int bt = 0; bt < 2; ++bt) {
#pragma unroll 1
      for (int e0 = 0; e0 < 64; e0 += 8) {
        uint4 ra[8], rb[8];
#pragma unroll
        for (int u = 0; u < 8; ++u) {
          const int row = __builtin_amdgcn_readlane(idx[bt], e0 + u);
          const uint4* rp = (const uint4*)(VB + (size_t)row * 2048);
          ra[u] = rp[lane];
          rb[u] = rp[64 + lane];
        }
#pragma unroll
        for (int u = 0; u < 8; ++u) {
          const float wj = __uint_as_float(__builtin_amdgcn_readlane(__float_as_uint(wv[bt]), e0 + u));
          o[0] += wj * bf_lo(ra[u].x); o[1] += wj * bf_hi(ra[u].x); o[2] += wj * bf_lo(ra[u].y); o[3] += wj * bf_hi(ra[u].y);
          o[4] += wj * bf_lo(ra[u].z); o[5] += wj * bf_hi(ra[u].z); o[6] += wj * bf_lo(ra[u].w); o[7] += wj * bf_hi(ra[u].w);
          o[8] += wj * bf_lo(rb[u].x); o[9] += wj * bf_hi(rb[u].x); o[10] += wj * bf_lo(rb[u].y); o[11] += wj * bf_hi(rb[u].y);
          o[12] += wj * bf_lo(rb[u].z); o[13] += wj * bf_hi(rb[u].z); o[14] += wj * bf_lo(rb[u].w); o[15] += wj * bf_hi(rb[u].w);
        }
      }
    }
    float4* y0 = (float4*)(p.out + O_Y + (size_t)m * 1024 + lane * 8);
    float4* y1 = (float4*)(p.out + O_Y + (size_t)m * 1024 + 512 + lane * 8);
    float4 a = y0[0], b = y0[1], c = y1[0], d = y1[1];
    a.x += o[0]; a.y += o[1]; a.z += o[2]; a.w += o[3];
    b.x += o[4]; b.y += o[5]; b.z += o[6]; b.w += o[7];
    c.x += o[8]; c.y += o[9]; c.z += o[10]; c.w += o[11];
    d.x += o[12]; d.y += o[13]; d.z += o[14]; d.w += o[15];
    y0[0] = a; y0[1] = b; y1[0] = c; y1[1] = d;
  }
}

__global__ void __launch_bounds__(256, 2) hymba_mega(Params p) {
  __shared__ __attribute__((aligned(16))) char smem[36864];
  cg::grid_group grid = cg::this_grid();
  const int nb = gridDim.x, bid = blockIdx.x;
  phase0(p, smem);
  grid.sync();
  for (int t = bid; t < 130 * 14; t += nb) gemm_tile<1>(p, t / 14, t % 14, smem);
  grid.sync();
  for (int it = bid; it < 512; it += nb) lru_item<0>(p, it, smem);
  grid.sync();
  for (int it = bid; it < 528 + 544; it += nb) {
    if (it < 528) lru_item<1>(p, it, smem);
    else attn_item(p, it - 528, smem);
  }
  grid.sync();
  for (int t = bid; t < 130 * 8; t += nb) gemm_tile<2>(p, t >> 3, t & 7, smem);
  grid.sync();
  for (int t = bid; t < 130 * 16; t += nb) gemm_tile<3>(p, t >> 4, t & 15, smem);
  grid.sync();
  for (int it = bid; it < 260 * 8; it += nb) route_item(p, it, smem);
  grid.sync();
  peer_gather(p);
}

extern "C" void kernel_launch(void* const* d_in, const int* in_sizes, int n_in, void* d_out, int out_size, void* d_ws,
                              size_t ws_size, hipStream_t stream) {
  static int grid_blocks = 0;
  if (!grid_blocks) {
    int dev = 0, cus = 0, per_cu = 0;
    (void)hipGetDevice(&dev);
    (void)hipDeviceGetAttribute(&cus, hipDeviceAttributeMultiprocessorCount, dev);
    (void)hipOccupancyMaxActiveBlocksPerMultiprocessor(&per_cu, hymba_mega, 256, 0);
    if (per_cu > 2) per_cu = 2;
    if (per_cu < 1) per_cu = 1;
    grid_blocks = cus * per_cu;
  }
  if (ws_size < W_END) fprintf(stderr, "workspace too small: %zu < %zu\n", ws_size, (size_t)W_END);
  Params p{};
  const float** pp = (const float**)&p;
  for (int i = 0; i < 27; ++i) pp[i] = (const float*)d_in[i];
  p.out = (float*)d_out;
  p.ws = (char*)d_ws;
  void* args[] = {&p};
  hipError_t e = hipLaunchCooperativeKernel((void*)hymba_mega, dim3(grid_blocks), dim3(256), args, 0, stream);
  if (e != hipSuccess) fprintf(stderr, "cooperative launch failed: %s (grid %d)\n", hipGetErrorString(e), grid_blocks);
}
```

```cpp
#include <hip/hip_runtime.h>
#include <hip/hip_cooperative_groups.h>
#include <cstdio>
namespace cg = cooperative_groups;

#define DI __device__ __forceinline__
typedef __bf16 bf2_t __attribute__((ext_vector_type(2)));
typedef float fl2_t __attribute__((ext_vector_type(2)));
typedef short bf16x8 __attribute__((ext_vector_type(8)));
typedef float f32x16 __attribute__((ext_vector_type(16)));
typedef unsigned short u16;
typedef unsigned u32x4 __attribute__((ext_vector_type(4)));
#define MFMA32(a, b, c) __builtin_amdgcn_mfma_f32_32x32x16_bf16((a), (b), (c), 0, 0, 0)

constexpr int TP = 16384, TS = 256, TT = 16640;
constexpr float EPS = 1e-6f;

constexpr size_t O_Y = 0;
constexpr size_t O_KP = 17039360, O_VP = 17170432, O_CONVP = 17301504, O_LRUP = 17313792;
constexpr size_t O_KS = 17317888, O_VS = 17580032, O_CONVS = 17842176, O_LRUS = 17866752;

constexpr size_t al(size_t x) { return (x + 255) & ~size_t(255); }
constexpr size_t W_WTIN = 0;
constexpr size_t W_WTOUT = W_WTIN + al(1792ull * 1024 * 2);
constexpr size_t W_WTQ = W_WTOUT + al(1024ull * 1024 * 2);
constexpr size_t W_K1B = W_WTQ + al(2048ull * 1024 * 2);
constexpr size_t W_K2B = W_K1B + al(128 * 128 * 2);
constexpr size_t W_WAT = W_K2B + al(128 * 128 * 2);
constexpr size_t W_WIT = W_WAT + al(8 * 64 * 64 * 2);
constexpr size_t W_C8 = W_WIT + al(8 * 64 * 64 * 2);
constexpr size_t W_UB = W_C8 + al(512 * 4);
constexpr size_t W_VB = W_UB + al(16384ull * 1024 * 2);
constexpr size_t W_RB = W_VB + al(16384ull * 1024 * 2);
constexpr size_t W_XB = W_RB;
constexpr size_t W_CAT = W_RB;
constexpr size_t W_SIDX = W_RB;
constexpr size_t W_SGATE = W_RB + al(TT * 128ull * 4);
constexpr size_t W_RC = W_RB + al(TT * 1024ull * 2);
constexpr size_t W_U = W_RC;
constexpr size_t W_GG = W_RC + TT * 512ull * 2;
constexpr size_t W_HB = W_RC;
constexpr size_t W_Q = W_RC + al(TT * 1024ull * 2);
constexpr size_t W_KP = W_Q + al(TT * 512ull * 2);
constexpr size_t W_KS = W_KP + al(TP * 128ull * 2);
constexpr size_t W_VTP = W_KS + al(16 * 192 * 128 * 2);
constexpr size_t W_VTS = W_VTP + al(8 * 128 * 2048ull * 2);
constexpr size_t W_SUMA = W_VTS + al(16 * 128 * 192 * 2);
constexpr size_t W_SUMH = W_SUMA + al(512 * 512 * 4);
constexpr size_t W_RS1 = W_SUMH + al(512 * 512 * 4);
constexpr size_t W_SSQL = W_RS1 + al(TT * 4);
constexpr size_t W_SSQA = W_SSQL + al(TT * 4 * 4);
constexpr size_t W_SSQ2 = W_SSQA + al(TT * 8 * 4);
constexpr size_t W_PQ = W_SSQ2 + al(TT * 16 * 4);
constexpr size_t W_BAR = W_PQ + al(TT * 2048ull * 2);
constexpr size_t W_END = W_BAR + al(3456 * 4);

struct Params {
  const float *x_p, *x_s, *cache_k, *cache_v, *state_conv, *state_lru, *ln1_g, *w_in, *conv_w, *conv_b,
      *lru_wa, *lru_ba, *lru_wi, *lru_bi, *lru_lambda, *q_g, *k_g, *sinks, *g_lru, *g_attn, *w_out, *ln2_g,
      *w_query, *sk1, *sk2, *peer_u, *peer_v;
  float* out;
  char* ws;
};

DI unsigned pk2(float a, float b) {
  fl2_t f = {a, b};
  return __builtin_bit_cast(unsigned, __builtin_convertvector(f, bf2_t));
}
DI float bf_lo(unsigned u) { return __uint_as_float(u << 16); }
DI float bf_hi(unsigned u) { return __uint_as_float(u & 0xffff0000u); }
DI float bf1(u16 v) { return __uint_as_float(((unsigned)v) << 16); }
DI float sigmoidf_(float x) { return 1.0f / (1.0f + __expf(-x)); }
DI float gelu_(float x) {
  float z = 0.7978845608028654f * (x + 0.044715f * x * x * x);
  return x / (1.0f + __expf(-2.0f * z));
}
DI int crow(int r, int h) { return (r & 3) + 8 * (r >> 2) + 4 * h; }

DI void transpose_tile(const float* __restrict__ src, int ld_src, u16* __restrict__ dst, int ld_dst, int k0, int n0,
                       const float* __restrict__ gain, float* tile) {
  const int tid = threadIdx.x;
  const int c = tid & 63, r0 = tid >> 6;
  __syncthreads();
#pragma unroll 4
  for (int rr = 0; rr < 16; ++rr) {
    int r = rr * 4 + r0;
    float v = src[(size_t)(k0 + r) * ld_src + n0 + c];
    if (gain) v *= gain[k0 + r];
    tile[r * 65 + c] = v;
  }
  __syncthreads();
  const int n = tid >> 2, kq = (tid & 3) * 16;
  unsigned pk[8];
#pragma unroll
  for (int i = 0; i < 8; ++i) pk[i] = pk2(tile[(kq + 2 * i) * 65 + n], tile[(kq + 2 * i + 1) * 65 + n]);
  uint4* d = (uint4*)(dst + (size_t)(n0 + n) * ld_dst + k0 + kq);
  d[0] = make_uint4(pk[0], pk[1], pk[2], pk[3]);
  d[1] = make_uint4(pk[4], pk[5], pk[6], pk[7]);
}

DI void phase0(const Params& p, char* smem) {
  const int nb = gridDim.x, bid = blockIdx.x, tid = threadIdx.x;
  char* ws = p.ws;
  float* tile = (float*)smem;
  for (int it = bid; it < 1232; it += nb) {
    if (it < 448) {
      int kt = it / 28, nt = it % 28;
      transpose_tile(p.w_in, 1792, (u16*)(ws + W_WTIN), 1024, kt * 64, nt * 64, p.ln1_g, tile);
    } else if (it < 704) {
      int j = it - 448;
      int kt = j >> 4, nt = j & 15;
      const float* gain = (kt < 8) ? p.g_lru : (p.g_attn - 512);
      transpose_tile(p.w_out, 1024, (u16*)(ws + W_WTOUT), 1024, kt * 64, nt * 64, gain, tile);
    } else if (it < 1216) {
      int j = it - 704;
      int kt = j >> 5, nt = j & 31;
      transpose_tile(p.w_query, 2048, (u16*)(ws + W_WTQ), 1024, kt * 64, nt * 64, p.ln2_g, tile);
    } else {
      int j = it - 1216;
      int n = j & 7;
      if (j < 8) transpose_tile(p.lru_wa + n * 4096, 64, (u16*)(ws + W_WAT) + n * 4096, 64, 0, 0, nullptr, tile);
      else transpose_tile(p.lru_wi + n * 4096, 64, (u16*)(ws + W_WIT) + n * 4096, 64, 0, 0, nullptr, tile);
    }
  }
  const size_t gt = (size_t)bid * 256 + tid, gstride = (size_t)nb * 256;
  {
    const float4* g2 = (const float4*)p.ln2_g;
    for (size_t i = gt; i < 16384ull * 128; i += gstride) {
      const float4* su = (const float4*)p.peer_u + i * 2;
      float4 a = su[0], b = su[1];
      int cg8 = (int)(i & 127) * 2;
      float4 ga = g2[cg8], gb = g2[cg8 + 1];
      uint4 o = make_uint4(pk2(a.x * ga.x, a.y * ga.y), pk2(a.z * ga.z, a.w * ga.w), pk2(b.x * gb.x, b.y * gb.y),
                           pk2(b.z * gb.z, b.w * gb.w));
      ((uint4*)(ws + W_UB))[i] = o;
      const float4* sv = (const float4*)p.peer_v + i * 2;
      float4 c = sv[0], d = sv[1];
      uint4 o2 = make_uint4(pk2(c.x, c.y), pk2(c.z, c.w), pk2(d.x, d.y), pk2(d.z, d.w));
      ((uint4*)(ws + W_VB))[i] = o2;
    }
  }
  for (size_t i = gt; i < 4096; i += gstride) {
    const float* s = (i < 2048) ? p.sk1 : p.sk2;
    size_t j = (i & 2047);
    const float4* sp = (const float4*)s + j * 2;
    float4 a = sp[0], b = sp[1];
    uint4 o = make_uint4(pk2(a.x, a.y), pk2(a.z, a.w), pk2(b.x, b.y), pk2(b.z, b.w));
    ((uint4*)(ws + ((i < 2048) ? W_K1B : W_K2B)))[j] = o;
  }
  for (size_t i = gt; i < 512; i += gstride) {
    float l = p.lru_lambda[i];
    float sp = (l < -15.f) ? -l : log1pf(expf(-l));
    ((float*)(ws + W_C8))[i] = -8.0f * sp;
  }
  for (size_t i = gt; i < 16 * 128 * 16; i += gstride) {
    int b = (int)(i >> 11), rem = (int)(i & 2047);
    int t = rem >> 4, c8i = rem & 15;
    const float4* sk = (const float4*)(p.cache_k + ((size_t)(b * 128 + t) * 128 + c8i * 8));
    float4 a = sk[0], bb = sk[1];
    uint4 o = make_uint4(pk2(a.x, a.y), pk2(a.z, a.w), pk2(bb.x, bb.y), pk2(bb.z, bb.w));
    *(uint4*)(ws + W_KS + ((size_t)(b * 192 + t) * 128 + c8i * 8) * 2) = o;
    const float4* sv = (const float4*)(p.cache_v + ((size_t)(b * 128 + t) * 128 + c8i * 8));
    float4 va = sv[0], vb = sv[1];
    if (t >= 16) {
      float4* dk = (float4*)(p.out + O_KS + ((size_t)(b * 128 + t - 16) * 128 + c8i * 8));
      dk[0] = a; dk[1] = bb;
      float4* dv = (float4*)(p.out + O_VS + ((size_t)(b * 128 + t - 16) * 128 + c8i * 8));
      dv[0] = va; dv[1] = vb;
    }
    u16* vt = (u16*)(ws + W_VTS) + (size_t)b * 128 * 192;
    float vv[8] = {va.x, va.y, va.z, va.w, vb.x, vb.y, vb.z, vb.w};
#pragma unroll
    for (int q = 0; q < 8; ++q) vt[(size_t)(c8i * 8 + q) * 192 + t] = (u16)(pk2(vv[q], 0.f) & 0xffffu);
  }
  for (size_t i = gt; i < 16 * 48 * 128; i += gstride) {
    int b = (int)(i / (48 * 128)), rem = (int)(i % (48 * 128));
    ((u16*)(ws + W_KS))[(size_t)(b * 192 + 144) * 128 + rem] = 0;
    int ch = rem / 48, tt = rem % 48;
    ((u16*)(ws + W_VTS))[(size_t)(b * 128 + ch) * 192 + 144 + tt] = 0;
  }
  {
    const int lane = tid & 63;
    const int gw = bid * 4 + (tid >> 6), nw = nb * 4;
    for (int m = gw; m < TT; m += nw) {
      const float* xr = (m < TP) ? (p.x_p + (size_t)m * 1024) : (p.x_s + (size_t)(m - TP) * 1024);
      const float4* xp = (const float4*)xr;
      float ss = 0.f;
      uint4* dst = (uint4*)(ws + W_XB + (size_t)m * 2048);
#pragma unroll
      for (int q = 0; q < 2; ++q) {
        float4 a = xp[q * 128 + lane * 2], b = xp[q * 128 + lane * 2 + 1];
        ss += a.x * a.x + a.y * a.y + a.z * a.z + a.w * a.w + b.x * b.x + b.y * b.y + b.z * b.z + b.w * b.w;
        dst[q * 64 + lane] = make_uint4(pk2(a.x, a.y), pk2(a.z, a.w), pk2(b.x, b.y), pk2(b.z, b.w));
      }
#pragma unroll
      for (int s = 32; s >= 1; s >>= 1) ss += __shfl_xor(ss, s);
      if (lane == 0) ((float*)(ws + W_RS1))[m] = rsqrtf(ss * (1.0f / 1024.0f) + EPS);
    }
  }
}

template <int MODE>
DI void gemm_tile(const Params& p, int mt, int nt, char* smem) {
  constexpr int LROW = 144;
  char* ws = p.ws;
  const char* Wt = ws + (MODE == 1 ? W_WTIN : (MODE == 2 ? W_WTOUT : W_WTQ));
  const char* X = ws + (MODE == 1 ? W_XB : (MODE == 2 ? W_CAT : W_HB));
  char* sW = smem;
  char* sX = smem + 128 * LROW;
  const int tid = threadIdx.x, lane = tid & 63, w = tid >> 6, wn = w & 1, wm = w >> 1;
  const int tl = lane & 31, h = lane >> 5;
  const char* gW = Wt + (size_t)(nt * 128) * 2048;
  const char* gX = X + (size_t)(mt * 128) * 2048;
  u32x4 rW[4], rX[4];
  f32x16 acc[2][2];
#pragma unroll
  for (int i = 0; i < 2; ++i)
#pragma unroll
    for (int j = 0; j < 2; ++j)
#pragma unroll
      for (int r = 0; r < 16; ++r) acc[i][j][r] = 0.f;

  const int m_lane[2] = {mt * 128 + wm * 64 + tl, mt * 128 + wm * 64 + 32 + tl};
  float ratio[2] = {1.f, 1.f}, fscale[2] = {1.f, 1.f};
  if (MODE == 2) {
#pragma unroll
    for (int j = 0; j < 2; ++j) {
      const float4 sl = *(const float4*)(ws + W_SSQL + (size_t)m_lane[j] * 16);
      const float4 sa0 = *(const float4*)(ws + W_SSQA + (size_t)m_lane[j] * 32);
      const float4 sa1 = *(const float4*)(ws + W_SSQA + (size_t)m_lane[j] * 32 + 16);
      float rsl = rsqrtf((sl.x + sl.y + sl.z + sl.w) * (1.0f / 512.0f) + EPS);
      float rsa = rsqrtf((sa0.x + sa0.y + sa0.z + sa0.w + sa1.x + sa1.y + sa1.z + sa1.w) * (1.0f / 512.0f) + EPS);
      ratio[j] = rsl / rsa;
      fscale[j] = rsa;
    }
  } else if (MODE == 1) {
#pragma unroll
    for (int j = 0; j < 2; ++j) fscale[j] = ((const float*)(ws + W_RS1))[m_lane[j]];
  } else {
#pragma unroll
    for (int j = 0; j < 2; ++j) {
      const float4* sp = (const float4*)(ws + W_SSQ2 + (size_t)m_lane[j] * 64);
      float4 a = sp[0], b = sp[1], c = sp[2], d = sp[3];
      float s = a.x + a.y + a.z + a.w + b.x + b.y + b.z + b.w + c.x + c.y + c.z + c.w + d.x + d.y + d.z + d.w;
      fscale[j] = rsqrtf(s * (1.0f / 1024.0f) + EPS);
    }
  }

#pragma unroll
  for (int i = 0; i < 4; ++i) {
    int c = tid + 256 * i, row = c >> 3, kc = c & 7;
    rW[i] = *(const u32x4*)(gW + (size_t)row * 2048 + kc * 16);
    rX[i] = *(const u32x4*)(gX + (size_t)row * 2048 + kc * 16);
  }
  for (int ks = 0; ks < 16; ++ks) {
    __syncthreads();
#pragma unroll
    for (int i = 0; i < 4; ++i) {
      int c = tid + 256 * i, row = c >> 3, kc = c & 7;
      *(u32x4*)(sW + row * LROW + kc * 16) = rW[i];
      *(u32x4*)(sX + row * LROW + kc * 16) = rX[i];
    }
    __syncthreads();
    if (ks + 1 < 16) {
#pragma unroll
      for (int i = 0; i < 4; ++i) {
        int c = tid + 256 * i, row = c >> 3, kc = c & 7;
        rW[i] = *(const u32x4*)(gW + (size_t)row * 2048 + (ks + 1) * 128 + kc * 16);
        rX[i] = *(const u32x4*)(gX + (size_t)row * 2048 + (ks + 1) * 128 + kc * 16);
      }
    }
    if (MODE == 2 && ks == 8) {
#pragma unroll
      for (int i = 0; i < 2; ++i)
#pragma unroll
        for (int j = 0; j < 2; ++j)
#pragma unroll
          for (int r = 0; r < 16; ++r) acc[i][j][r] *= ratio[j];
    }
#pragma unroll
    for (int kk = 0; kk < 4; ++kk) {
      bf16x8 a[2], b[2];
#pragma unroll
      for (int i = 0; i < 2; ++i) a[i] = *(const bf16x8*)(sW + (wn * 64 + i * 32 + tl) * LROW + kk * 32 + h * 16);
#pragma unroll
      for (int j = 0; j < 2; ++j) b[j] = *(const bf16x8*)(sX + (wm * 64 + j * 32 + tl) * LROW + kk * 32 + h * 16);
#pragma unroll
      for (int i = 0; i < 2; ++i)
#pragma unroll
        for (int j = 0; j < 2; ++j) acc[i][j] = MFMA32(a[i], b[j], acc[i][j]);
    }
  }

  const int ncol0 = nt * 128 + wn * 64;
  if (MODE == 1) {
    if (ncol0 < 512) {
#pragma unroll
      for (int j = 0; j < 2; ++j) {
        const int m = m_lane[j];
        float* convdst = nullptr;
        if (m < TP) {
          int t = m & 2047;
          if (t >= 2045) convdst = p.out + O_CONVP + (size_t)((m >> 11) * 3 + (t - 2045)) * 512;
        } else {
          int ms = m - TP, t = ms & 15;
          if (t >= 13) convdst = p.out + O_CONVS + (size_t)((ms >> 4) * 3 + (t - 13)) * 512;
        }
        u16* ub = (u16*)(ws + W_U) + (size_t)m * 512;
#pragma unroll
        for (int i = 0; i < 2; ++i)
#pragma unroll
          for (int g = 0; g < 4; ++g) {
            int n = ncol0 + i * 32 + 8 * g + 4 * h;
            float v0 = acc[i][j][4 * g] * fscale[j], v1 = acc[i][j][4 * g + 1] * fscale[j],
                  v2 = acc[i][j][4 * g + 2] * fscale[j], v3 = acc[i][j][4 * g + 3] * fscale[j];
            *(uint2*)(ub + n) = make_uint2(pk2(v0, v1), pk2(v2, v3));
            if (convdst) *(float4*)(convdst + n) = make_float4(v0, v1, v2, v3);
          }
      }
    } else if (ncol0 < 1024) {
#pragma unroll
      for (int j = 0; j < 2; ++j) {
        u16* gb = (u16*)(ws + W_GG) + (size_t)m_lane[j] * 512;
#pragma unroll
        for (int i = 0; i < 2; ++i)
#pragma unroll
          for (int g = 0; g < 4; ++g) {
            int n = ncol0 - 512 + i * 32 + 8 * g + 4 * h;
            float v0 = gelu_(acc[i][j][4 * g] * fscale[j]), v1 = gelu_(acc[i][j][4 * g + 1] * fscale[j]),
                  v2 = gelu_(acc[i][j][4 * g + 2] * fscale[j]), v3 = gelu_(acc[i][j][4 * g + 3] * fscale[j]);
            *(uint2*)(gb + n) = make_uint2(pk2(v0, v1), pk2(v2, v3));
          }
      }
    } else if (ncol0 < 1664) {
      const bool isq = ncol0 < 1536;
      const float* gain = isq ? p.q_g : p.k_g;
      const float post = isq ? 0.125f : 1.0f;
#pragma unroll
      for (int j = 0; j < 2; ++j) {
        const int m = m_lane[j];
        float ss = 0.f;
#pragma unroll
        for (int i = 0; i < 2; ++i)
#pragma unroll
          for (int r = 0; r < 16; ++r) {
            float v = acc[i][j][r] * fscale[j];
            ss += v * v;
          }
        ss += __shfl_xor(ss, 32);
        const float sc = fscale[j] * rsqrtf(ss * (1.0f / 64.0f) + EPS) * post;
        u16* dst;
        float* fdst = nullptr;
        int nloc0;
        if (isq) {
          nloc0 = ncol0 - 1024;
          dst = (u16*)(ws + W_Q) + (size_t)m * 512 + nloc0;
        } else {
          nloc0 = ncol0 - 1536;
          if (m < TP) {
            dst = (u16*)(ws + W_KP) + (size_t)m * 128 + nloc0;
            int t = m & 2047;
            if (t >= 1920) fdst = p.out + O_KP + (size_t)((m >> 11) * 128 + (t - 1920)) * 128 + nloc0;
          } else {
            int ms = m - TP, b = ms >> 4, t = ms & 15;
            dst = (u16*)(ws + W_KS) + (size_t)(b * 192 + 128 + t) * 128 + nloc0;
            fdst = p.out + O_KS + (size_t)(b * 128 + 112 + t) * 128 + nloc0;
          }
        }
#pragma unroll
        for (int i = 0; i < 2; ++i)
#pragma unroll
          for (int g = 0; g < 4; ++g) {
            int d = i * 32 + 8 * g + 4 * h;
            const float4 gn = *(const float4*)(gain + d);
            float v0 = acc[i][j][4 * g] * sc * gn.x, v1 = acc[i][j][4 * g + 1] * sc * gn.y,
                  v2 = acc[i][j][4 * g + 2] * sc * gn.z, v3 = acc[i][j][4 * g + 3] * sc * gn.w;
            *(uint2*)(dst + d) = make_uint2(pk2(v0, v1), pk2(v2, v3));
            if (fdst) *(float4*)(fdst + d) = make_float4(v0, v1, v2, v3);
          }
      }
    } else {
#pragma unroll
      for (int j = 0; j < 2; ++j) {
        const int m = m_lane[j];
        u16* vt;
        size_t vstride;
        float* fdst = nullptr;
        const int ch0 = ncol0 - 1664;
        if (m < TP) {
          int b = m >> 11, t = m & 2047;
          vt = (u16*)(ws + W_VTP) + (size_t)b * 128 * 2048 + t;
          vstride = 2048;
          if (t >= 1920) fdst = p.out + O_VP + (size_t)(b * 128 + (t - 1920)) * 128;
        } else {
          int ms = m - TP, b = ms >> 4, t = ms & 15;
          vt = (u16*)(ws + W_VTS) + (size_t)b * 128 * 192 + 128 + t;
          vstride = 192;
          fdst = p.out + O_VS + (size_t)(b * 128 + 112 + t) * 128;
        }
#pragma unroll
        for (int i = 0; i < 2; ++i)
#pragma unroll
          for (int g = 0; g < 4; ++g) {
            int ch = ch0 + i * 32 + 8 * g + 4 * h;
            float v0 = acc[i][j][4 * g] * fscale[j], v1 = acc[i][j][4 * g + 1] * fscale[j],
                  v2 = acc[i][j][4 * g + 2] * fscale[j], v3 = acc[i][j][4 * g + 3] * fscale[j];
            unsigned p01 = pk2(v0, v1), p23 = pk2(v2, v3);
            vt[(size_t)(ch + 0) * vstride] = (u16)(p01 & 0xffffu);
            vt[(size_t)(ch + 1) * vstride] = (u16)(p01 >> 16);
            vt[(size_t)(ch + 2) * vstride] = (u16)(p23 & 0xffffu);
            vt[(size_t)(ch + 3) * vstride] = (u16)(p23 >> 16);
            if (fdst) *(float4*)(fdst + ch) = make_float4(v0, v1, v2, v3);
          }
      }
    }
  } else if (MODE == 2) {
#pragma unroll
    for (int j = 0; j < 2; ++j) {
      const int m = m_lane[j];
      const float* xr = (m < TP) ? (p.x_p + (size_t)m * 1024) : (p.x_s + (size_t)(m - TP) * 1024);
      float* yr = p.out + O_Y + (size_t)m * 1024;
      u16* hb = (u16*)(ws + W_HB) + (size_t)m * 1024;
      float ss = 0.f;
#pragma unroll
      for (int i = 0; i < 2; ++i)
#pragma unroll
        for (int g = 0; g < 4; ++g) {
          int n = ncol0 + i * 32 + 8 * g + 4 * h;
          const float4 xv = *(const float4*)(xr + n);
          float v0 = xv.x + acc[i][j][4 * g] * fscale[j], v1 = xv.y + acc[i][j][4 * g + 1] * fscale[j],
                v2 = xv.z + acc[i][j][4 * g + 2] * fscale[j], v3 = xv.w + acc[i][j][4 * g + 3] * fscale[j];
          *(float4*)(yr + n) = make_float4(v0, v1, v2, v3);
          *(uint2*)(hb + n) = make_uint2(pk2(v0, v1), pk2(v2, v3));
          ss += v0 * v0 + v1 * v1 + v2 * v2 + v3 * v3;
        }
      ss += __shfl_xor(ss, 32);
      if (h == 0) ((float*)(ws + W_SSQ2))[(size_t)m * 16 + nt * 2 + wn] = ss;
    }
  } else {
#pragma unroll
    for (int j = 0; j < 2; ++j) {
      u16* pq = (u16*)(ws + W_PQ) + (size_t)m_lane[j] * 2048;
#pragma unroll
      for (int i = 0; i < 2; ++i)
#pragma unroll
        for (int g = 0; g < 4; ++g) {
          int n = ncol0 + i * 32 + 8 * g + 4 * h;
          float v0 = acc[i][j][4 * g] * fscale[j], v1 = acc[i][j][4 * g + 1] * fscale[j],
                v2 = acc[i][j][4 * g + 2] * fscale[j], v3 = acc[i][j][4 * g + 3] * fscale[j];
          *(uint2*)(pq + n) = make_uint2(pk2(v0, v1), pk2(v2, v3));
        }
    }
  }
}

template <int FINAL>
DI void lru_item(const Params& p, int item, char* smem) {
  char* ws = p.ws;
  const bool samp = item >= 512;
  int b, c, m0, nvalid;
  if (!samp) { b = item >> 6; c = item & 63; m0 = b * 2048 + c * 32; nvalid = 32; }
  else { b = item - 512; c = 0; m0 = TP + b * 16; nvalid = 16; }
  const int tid = threadIdx.x, lane = tid & 63, w = tid >> 6, tl = lane & 31, h = lane >> 5;
  u16* XC = (u16*)smem;
  float* hin = (float*)(smem + 32 * 1040);
  __syncthreads();
  {
    const int ch = 2 * tid;
    const float2 w0 = *(const float2*)(p.conv_w + ch), w1 = *(const float2*)(p.conv_w + 512 + ch),
                 w2 = *(const float2*)(p.conv_w + 1024 + ch), w3 = *(const float2*)(p.conv_w + 1536 + ch),
                 cb = *(const float2*)(p.conv_b + ch);
    float2 r0 = {0.f, 0.f}, r1 = {0.f, 0.f}, r2 = {0.f, 0.f};
    const u16* ub = (const u16*)(ws + W_U);
    if (!samp) {
      if (c > 0) {
        unsigned a0 = *(const unsigned*)(ub + (size_t)(m0 - 3) * 512 + ch), a1 = *(const unsigned*)(ub + (size_t)(m0 - 2) * 512 + ch),
                 a2 = *(const unsigned*)(ub + (size_t)(m0 - 1) * 512 + ch);
        r0 = {bf_lo(a0), bf_hi(a0)}; r1 = {bf_lo(a1), bf_hi(a1)}; r2 = {bf_lo(a2), bf_hi(a2)};
      }
    } else {
      const float* sc = p.state_conv + (size_t)b * 3 * 512 + ch;
      r0 = *(const float2*)(sc); r1 = *(const float2*)(sc + 512); r2 = *(const float2*)(sc + 1024);
    }
#pragma unroll 8
    for (int t = 0; t < 32; ++t) {
      float2 cur = {0.f, 0.f};
      if (t < nvalid) {
        unsigned a = *(const unsigned*)(ub + (size_t)(m0 + t) * 512 + ch);
        cur = {bf_lo(a), bf_hi(a)};
      }
      float x0 = cb.x + w0.x * r0.x + w1.x * r1.x + w2.x * r2.x + w3.x * cur.x;
      float x1 = cb.y + w0.y * r0.y + w1.y * r1.y + w2.y * r2.y + w3.y * cur.y;
      *(unsigned*)(XC + t * 520 + ch) = pk2(x0, x1);
      r0 = r1; r1 = r2; r2 = cur;
    }
    if (FINAL) {
      float2 hh;
      if (samp) hh = *(const float2*)(p.state_lru + (size_t)b * 512 + ch);
      else {
        hh = {0.f, 0.f};
        const float* sA = (const float*)(ws + W_SUMA) + (size_t)(b * 64) * 512 + ch;
        const float* sH = (const float*)(ws + W_SUMH) + (size_t)(b * 64) * 512 + ch;
        int cc = 0;
        for (; cc + 4 <= c; cc += 4) {
          float2 A0 = *(const float2*)(sA + (size_t)(cc + 0) * 512), H0 = *(const float2*)(sH + (size_t)(cc + 0) * 512);
          float2 A1 = *(const float2*)(sA + (size_t)(cc + 1) * 512), H1 = *(const float2*)(sH + (size_t)(cc + 1) * 512);
          float2 A2 = *(const float2*)(sA + (size_t)(cc + 2) * 512), H2 = *(const float2*)(sH + (size_t)(cc + 2) * 512);
          float2 A3 = *(const float2*)(sA + (size_t)(cc + 3) * 512), H3 = *(const float2*)(sH + (size_t)(cc + 3) * 512);
          hh.x = A0.x * hh.x + H0.x; hh.y = A0.y * hh.y + H0.y;
          hh.x = A1.x * hh.x + H1.x; hh.y = A1.y * hh.y + H1.y;
          hh.x = A2.x * hh.x + H2.x; hh.y = A2.y * hh.y + H2.y;
          hh.x = A3.x * hh.x + H3.x; hh.y = A3.y * hh.y + H3.y;
        }
        for (; cc < c; ++cc) {
          float2 A0 = *(const float2*)(sA + (size_t)cc * 512), H0 = *(const float2*)(sH + (size_t)cc * 512);
          hh.x = A0.x * hh.x + H0.x; hh.y = A0.y * hh.y + H0.y;
        }
      }
      hin[ch] = hh.x; hin[ch + 1] = hh.y;
    }
  }
  __syncthreads();
  const u16* WaT = (const u16*)(ws + W_WAT);
  const u16* WiT = (const u16*)(ws + W_WIT);
  const float* c8 = (const float*)(ws + W_C8);
  const int m = m0 + tl;
  const bool valid = tl < nvalid;
  float ssq = 0.f;
#pragma unroll 1
  for (int nbk = 0; nbk < 2; ++nbk) {
    const int n = 2 * w + nbk;
    f32x16 accA[2], accI[2];
#pragma unroll
    for (int i = 0; i < 2; ++i)
#pragma unroll
      for (int r = 0; r < 16; ++r) { accA[i][r] = 0.f; accI[i][r] = 0.f; }
#pragma unroll
    for (int kk = 0; kk < 4; ++kk) {
      const bf16x8 bx = *(const bf16x8*)((const char*)XC + tl * 1040 + (n * 64 + kk * 16 + h * 8) * 2);
#pragma unroll
      for (int i = 0; i < 2; ++i) {
        const bf16x8 aa = *(const bf16x8*)(WaT + (size_t)(n * 64 + i * 32 + tl) * 64 + kk * 16 + h * 8);
        const bf16x8 ai = *(const bf16x8*)(WiT + (size_t)(n * 64 + i * 32 + tl) * 64 + kk * 16 + h * 8);
        accA[i] = MFMA32(aa, bx, accA[i]);
        accI[i] = MFMA32(ai, bx, accI[i]);
      }
    }
#pragma unroll
    for (int i = 0; i < 2; ++i)
#pragma unroll
      for (int g = 0; g < 4; ++g) {
        const int ch = n * 64 + i * 32 + 8 * g + 4 * h;
        const float4 ba4 = *(const float4*)(p.lru_ba + ch), bi4 = *(const float4*)(p.lru_bi + ch), c84 = *(const float4*)(c8 + ch);
        const float bav[4] = {ba4.x, ba4.y, ba4.z, ba4.w}, biv[4] = {bi4.x, bi4.y, bi4.z, bi4.w}, c8v[4] = {c84.x, c84.y, c84.z, c84.w};
        const uint2 xcp = *(const uint2*)(XC + tl * 520 + ch);
        const float xcv[4] = {bf_lo(xcp.x), bf_hi(xcp.x), bf_lo(xcp.y), bf_hi(xcp.y)};
        float hv[4];
#pragma unroll
        for (int q = 0; q < 4; ++q) {
          const int r = 4 * g + q;
          float rr = sigmoidf_(accA[i][r] + bav[q]);
          float ii = sigmoidf_(accI[i][r] + biv[q]);
          float la = c8v[q] * rr;
          float A = __expf(la);
          float x2 = 2.0f * la;
          float em = -x2 * (1.0f + x2 * (0.5f + x2 * (0.16666667f + x2 * (0.041666668f + x2 * (0.0083333333f + x2 * 0.0013888889f)))));
          float H = sqrtf(fmaxf(em, 0.f)) * ii * xcv[q];
#pragma unroll
          for (int dlt = 1; dlt < 32; dlt <<= 1) {
            float Ap = __shfl_up(A, dlt, 32), Hp = __shfl_up(H, dlt, 32);
            if (tl >= dlt) { H = A * Hp + H; A = A * Ap; }
          }
          if (!FINAL) {
            if (tl == 31) {
              ((float*)(ws + W_SUMA))[(size_t)(b * 64 + c) * 512 + ch + q] = A;
              ((float*)(ws + W_SUMH))[(size_t)(b * 64 + c) * 512 + ch + q] = H;
            }
          } else {
            hv[q] = H + A * hin[ch + q];
          }
        }
        if (FINAL) {
          if (tl == nvalid - 1 && (samp || c == 63)) {
            float* dst = p.out + (samp ? O_LRUS : O_LRUP) + (size_t)b * 512 + ch;
            *(float4*)dst = make_float4(hv[0], hv[1], hv[2], hv[3]);
          }
          if (valid) {
            const uint2 gp = *(const uint2*)((const u16*)(ws + W_GG) + (size_t)m * 512 + ch);
            float o0 = hv[0] * bf_lo(gp.x), o1 = hv[1] * bf_hi(gp.x), o2 = hv[2] * bf_lo(gp.y), o3 = hv[3] * bf_hi(gp.y);
            ssq += o0 * o0 + o1 * o1 + o2 * o2 + o3 * o3;
            *(uint2*)((u16*)(ws + W_CAT) + (size_t)m * 1024 + ch) = make_uint2(pk2(o0, o1), pk2(o2, o3));
          }
        }
      }
  }
  if (FINAL) {
    ssq += __shfl_xor(ssq, 32);
    if (valid && h == 0) ((float*)(ws + W_SSQL))[(size_t)m * 4 + w] = ssq;
  }
}

DI void attn_item(const Params& p, int item, char* smem) {
  char* ws = p.ws;
  const int tid = threadIdx.x, lane = tid & 63, w = tid >> 6, tl = lane & 31, h = lane >> 5;
  const bool samp = item >= 512;
  int b, c, g;
  const u16* Kb; const u16* Vt; int vstride, kc_lo, kc_hi, nkeys, mq0; bool qvalid;
  if (!samp) {
    b = item >> 6; c = (item >> 1) & 31; g = item & 1;
    Kb = (const u16*)(ws + W_KP) + (size_t)b * 2048 * 128;
    Vt = (const u16*)(ws + W_VTP) + (size_t)b * 128 * 2048;
    vstride = 2048; kc_lo = (c >= 2) ? c - 2 : 0; kc_hi = c; nkeys = 1 << 30;
    mq0 = b * 2048 + c * 64 + tl; qvalid = true;
  } else {
    int it = item - 512; b = it >> 1; g = it & 1; c = 0;
    Kb = (const u16*)(ws + W_KS) + (size_t)b * 192 * 128;
    Vt = (const u16*)(ws + W_VTS) + (size_t)b * 128 * 192;
    vstride = 192; kc_lo = 0; kc_hi = 2; nkeys = 144;
    mq0 = TP + b * 16 + (tl & 15); qvalid = tl < 16;
  }
  const int hq = g * 4 + w;
  const float sink = p.sinks[hq];
  char* sV = smem;
  const int nj = samp ? 1 : 2;
#pragma unroll 1
  for (int j = 0; j < nj; ++j) {
    const int mqj = mq0 + j * 32;
    bf16x8 bq[4];
#pragma unroll
    for (int kk = 0; kk < 4; ++kk)
      bq[kk] = *(const bf16x8*)((const u16*)(ws + W_Q) + (size_t)mqj * 512 + hq * 64 + kk * 16 + h * 8);
    float mrun = sink, lrun = 1.f;
    f32x16 O[2];
#pragma unroll
    for (int i = 0; i < 2; ++i)
#pragma unroll
      for (int r = 0; r < 16; ++r) O[i][r] = 0.f;
#pragma unroll 1
    for (int kc = kc_lo; kc <= kc_hi; ++kc) {
      __syncthreads();
#pragma unroll
      for (int i = 0; i < 2; ++i) {
        int idx = tid + 256 * i, d = idx >> 3, part = idx & 7;
        *(u32x4*)(sV + d * 144 + part * 16) = *(const u32x4*)(Vt + (size_t)(g * 64 + d) * vstride + kc * 64 + part * 8);
      }
      f32x16 S[2];
#pragma unroll
      for (int i = 0; i < 2; ++i)
#pragma unroll
        for (int r = 0; r < 16; ++r) S[i][r] = 0.f;
#pragma unroll
      for (int kk = 0; kk < 4; ++kk)
#pragma unroll
        for (int kt = 0; kt < 2; ++kt) {
          const bf16x8 ak = *(const bf16x8*)(Kb + (size_t)(kc * 64 + kt * 32 + tl) * 128 + g * 64 + kk * 16 + h * 8);
          S[kt] = MFMA32(ak, bq[kk], S[kt]);
        }
      if (samp) {
#pragma unroll
        for (int kt = 0; kt < 2; ++kt)
#pragma unroll
          for (int r = 0; r < 16; ++r) {
            int key = kc * 64 + kt * 32 + crow(r, h);
            if (key >= nkeys) S[kt][r] = -INFINITY;
          }
      }
      {
        float mx = -INFINITY;
#pragma unroll
        for (int kt = 0; kt < 2; ++kt)
#pragma unroll
          for (int r = 0; r < 16; ++r) mx = fmaxf(mx, S[kt][r]);
        mx = fmaxf(mx, __shfl_xor(mx, 32));
        const float mnew = fmaxf(mrun, mx);
        const float alpha = __expf(mrun - mnew);
        float ps = 0.f;
#pragma unroll
        for (int kt = 0; kt < 2; ++kt)
#pragma unroll
          for (int r = 0; r < 16; ++r) {
            float pv = __expf(S[kt][r] - mnew);
            S[kt][r] = pv;
            ps += pv;
          }
        ps += __shfl_xor(ps, 32);
        lrun = lrun * alpha + ps;
        mrun = mnew;
#pragma unroll
        for (int dt = 0; dt < 2; ++dt)
#pragma unroll
          for (int r = 0; r < 16; ++r) O[dt][r] *= alpha;
      }
      __syncthreads();
#pragma unroll
      for (int kt = 0; kt < 2; ++kt)
#pragma unroll
        for (int s2 = 0; s2 < 2; ++s2) {
          u32x4 pp;
          pp[0] = pk2(S[kt][8 * s2 + 0], S[kt][8 * s2 + 1]);
          pp[1] = pk2(S[kt][8 * s2 + 2], S[kt][8 * s2 + 3]);
          pp[2] = pk2(S[kt][8 * s2 + 4], S[kt][8 * s2 + 5]);
          pp[3] = pk2(S[kt][8 * s2 + 6], S[kt][8 * s2 + 7]);
          const bf16x8 bp = __builtin_bit_cast(bf16x8, pp);
#pragma unroll
          for (int dt = 0; dt < 2; ++dt) {
            const int d = dt * 32 + tl;
            const uint2 lo = *(const uint2*)(sV + d * 144 + (kt * 32 + 16 * s2 + 4 * h) * 2);
            const uint2 hi = *(const uint2*)(sV + d * 144 + (kt * 32 + 16 * s2 + 8 + 4 * h) * 2);
            u32x4 av4;
            av4[0] = lo.x; av4[1] = lo.y; av4[2] = hi.x; av4[3] = hi.y;
            O[dt] = MFMA32(__builtin_bit_cast(bf16x8, av4), bp, O[dt]);
          }
        }
    }
    const float inv = 1.0f / lrun;
    float ss = 0.f;
    u16* dst = (u16*)(ws + W_CAT) + (size_t)mqj * 1024 + 512 + hq * 64;
#pragma unroll
    for (int dt = 0; dt < 2; ++dt)
#pragma unroll
      for (int g4 = 0; g4 < 4; ++g4) {
        int d = dt * 32 + 8 * g4 + 4 * h;
        float v0 = O[dt][4 * g4] * inv, v1 = O[dt][4 * g4 + 1] * inv, v2 = O[dt][4 * g4 + 2] * inv, v3 = O[dt][4 * g4 + 3] * inv;
        ss += v0 * v0 + v1 * v1 + v2 * v2 + v3 * v3;
        if (qvalid) *(uint2*)(dst + d) = make_uint2(pk2(v0, v1), pk2(v2, v3));
      }
    ss += __shfl_xor(ss, 32);
    if (qvalid && h == 0) ((float*)(ws + W_SSQA))[(size_t)mqj * 8 + hq] = ss;
  }
}

DI unsigned f2ord(float f) { unsigned u = __float_as_uint(f); return u ^ ((unsigned)((int)u >> 31) | 0x80000000u); }
DI float ord2f(unsigned u) { return __uint_as_float((u & 0x80000000u) ? (u ^ 0x80000000u) : ~u); }
DI void cas_desc(unsigned& a, unsigned& b) { unsigned mx = a > b ? a : b, mn = a > b ? b : a; a = mx; b = mn; }
DI void sort16_desc(unsigned (&v)[16]) {
#pragma unroll
  for (int k = 2; k <= 16; k <<= 1)
#pragma unroll
    for (int j = k >> 1; j > 0; j >>= 1)
#pragma unroll
      for (int i = 0; i < 16; ++i) {
        int l = i ^ j;
        if (l > i) {
          if ((i & k) == 0) cas_desc(v[i], v[l]); else cas_desc(v[l], v[i]);
        }
      }
}
DI void merge16_desc(unsigned (&v)[16]) {
#pragma unroll
  for (int j = 8; j > 0; j >>= 1)
#pragma unroll
    for (int i = 0; i < 16; ++i) {
      int l = i ^ j;
      if (l > i) cas_desc(v[i], v[l]);
    }
}
DI void merge_top16(unsigned (&a)[16], unsigned (&b)[16]) {
#pragma unroll
  for (int i = 0; i < 16; ++i) a[i] = a[i] > b[15 - i] ? a[i] : b[15 - i];
  merge16_desc(a);
}

struct CandTab { int i[64]; int j[64]; int n; };
constexpr CandTab make_tab() {
  CandTab t{};
  int n = 0;
  for (int i = 0; i < 16; ++i)
    for (int j = 0; j < 16; ++j)
      if ((i + 1) * (j + 1) <= 16) { t.i[n] = i; t.j[n] = j; ++n; }
  t.n = n;
  return t;
}

DI void route_item(const Params& p, int item, char* smem) {
  char* ws = p.ws;
  const int tid = threadIdx.x, lane = tid & 63, w = tid >> 6, tl = lane & 31, h = lane >> 5;
  const int tt = item >> 3, hd = item & 7;
  const int m0 = tt * 64;
  const int half = w >> 1, tq = w & 1;
  const int m = m0 + tq * 32 + tl;
  unsigned* L = (unsigned*)smem;
  __syncthreads();
  {
    const u16* Kb = (const u16*)(ws + (half ? W_K2B : W_K1B));
    const u16* pq = (const u16*)(ws + W_PQ) + (size_t)m * 2048 + hd * 256 + half * 128;
    f32x16 acc[4];
#pragma unroll
    for (int kt = 0; kt < 4; ++kt)
#pragma unroll
      for (int r = 0; r < 16; ++r) acc[kt][r] = 0.f;
#pragma unroll
    for (int kk = 0; kk < 8; ++kk) {
      const bf16x8 bqv = *(const bf16x8*)(pq + kk * 16 + h * 8);
#pragma unroll
      for (int kt = 0; kt < 4; ++kt) {
        const bf16x8 ak = *(const bf16x8*)(Kb + (size_t)(kt * 32 + tl) * 128 + kk * 16 + h * 8);
        acc[kt] = MFMA32(ak, bqv, acc[kt]);
      }
    }
    unsigned top[16], tmp[16];
#pragma unroll
    for (int r = 0; r < 16; ++r) top[r] = (f2ord(acc[0][r]) & ~127u) | (unsigned)(127 - (0 * 32 + crow(r, h)));
    sort16_desc(top);
#pragma unroll
    for (int kt = 1; kt < 4; ++kt) {
#pragma unroll
      for (int r = 0; r < 16; ++r) tmp[r] = (f2ord(acc[kt][r]) & ~127u) | (unsigned)(127 - (kt * 32 + crow(r, h)));
      sort16_desc(tmp);
      merge_top16(top, tmp);
    }
#pragma unroll
    for (int i = 0; i < 16; ++i) tmp[i] = __shfl_xor(top[i], 32);
    merge_top16(top, tmp);
    if (h == 0) {
      uint4* dst = (uint4*)(L + (half * 64 + tq * 32 + tl) * 16);
      dst[0] = make_uint4(top[0], top[1], top[2], top[3]);
      dst[1] = make_uint4(top[4], top[5], top[6], top[7]);
      dst[2] = make_uint4(top[8], top[9], top[10], top[11]);
      dst[3] = make_uint4(top[12], top[13], top[14], top[15]);
    }
  }
  __syncthreads();
  if (tid < 64) {
    constexpr CandTab CT = make_tab();
    const int tok = tid;
    unsigned l1[16], l2[16];
    {
      const uint4* s1 = (const uint4*)(L + tok * 16);
      const uint4* s2 = (const uint4*)(L + (64 + tok) * 16);
#pragma unroll
      for (int q = 0; q < 4; ++q) {
        uint4 a = s1[q], b = s2[q];
        l1[4 * q] = a.x; l1[4 * q + 1] = a.y; l1[4 * q + 2] = a.z; l1[4 * q + 3] = a.w;
        l2[4 * q] = b.x; l2[4 * q + 1] = b.y; l2[4 * q + 2] = b.z; l2[4 * q + 3] = b.w;
      }
    }
    float f1[16], f2[16];
#pragma unroll
    for (int i = 0; i < 16; ++i) { f1[i] = ord2f(l1[i] & ~127u); f2[i] = ord2f(l2[i] & ~127u); }
    unsigned top[16], tmp[16];
#pragma unroll
    for (int grp = 0; grp < 4; ++grp) {
#pragma unroll
      for (int q = 0; q < 16; ++q) {
        const int cidx = grp * 16 + q;
        unsigned key = 0;
        if (cidx < CT.n) {
          const int ci = CT.i[cidx], cj = CT.j[cidx];
          key = (f2ord(f1[ci] + f2[cj]) & ~255u) | (unsigned)(255 - (ci * 16 + cj));
        }
        if (grp == 0) top[q] = key; else tmp[q] = key;
      }
      if (grp == 0) sort16_desc(top);
      else { sort16_desc(tmp); merge_top16(top, tmp); }
    }
    float sv[16]; int ex[16];
    float smax = -INFINITY;
#pragma unroll
    for (int q = 0; q < 16; ++q) {
      const int code = 255 - (int)(top[q] & 255u);
      const int ci = code >> 4, cj = code & 15;
      const unsigned a = L[tok * 16 + ci], bb = L[(64 + tok) * 16 + cj];
      const int i1 = 127 - (int)(a & 127u), i2 = 127 - (int)(bb & 127u);
      sv[q] = ord2f(a & ~127u) + ord2f(bb & ~127u);
      ex[q] = i1 * 128 + i2;
      smax = fmaxf(smax, sv[q]);
    }
    float sum = 0.f;
#pragma unroll
    for (int q = 0; q < 16; ++q) { sv[q] = __expf(sv[q] - smax); sum += sv[q]; }
    const float inv = 1.0f / sum;
    const int mm = m0 + tok;
    int4* di = (int4*)((int*)(ws + W_SIDX) + (size_t)mm * 128 + hd * 16);
    float4* dg = (float4*)((float*)(ws + W_SGATE) + (size_t)mm * 128 + hd * 16);
#pragma unroll
    for (int q = 0; q < 4; ++q) {
      di[q] = make_int4(ex[4 * q], ex[4 * q + 1], ex[4 * q + 2], ex[4 * q + 3]);
      dg[q] = make_float4(sv[4 * q] * inv, sv[4 * q + 1] * inv, sv[4 * q + 2] * inv, sv[4 * q + 3] * inv);
    }
  }
}

DI float dot2bf(unsigned a, unsigned b, float c) {
  return __builtin_amdgcn_fdot2_f32_bf16(__builtin_bit_cast(bf2_t, a), __builtin_bit_cast(bf2_t, b), c, false);
}
DI void peer_gather(const Params& p) {
  char* ws = p.ws;
  const int lane = threadIdx.x & 63, w = threadIdx.x >> 6;
  const int gw = blockIdx.x * 4 + w, nw = gridDim.x * 4;
  const char* UB = ws + W_UB;
  const char* VB = ws + W_VB;
  for (int m = gw; m < TT; m += nw) {
    const uint4* hp = (const uint4*)(ws + W_HB + (size_t)m * 2048);
    const uint4 h0 = hp[lane], h1 = hp[64 + lane];
    float ss = ((const float*)(ws + W_SSQ2))[(size_t)m * 16 + (lane & 15)];
    ss += __shfl_xor(ss, 8); ss += __shfl_xor(ss, 4); ss += __shfl_xor(ss, 2); ss += __shfl_xor(ss, 1);
    const float rs2 = rsqrtf(ss * (1.0f / 1024.0f) + EPS);
    const int* sidx = (const int*)(ws + W_SIDX) + (size_t)m * 128;
    const float* sg = (const float*)(ws + W_SGATE) + (size_t)m * 128;
    const int idx[2] = {sidx[lane], sidx[64 + lane]};
    const float gt[2] = {sg[lane], sg[64 + lane]};
    float wv[2];
#pragma unroll
    for (int bt = 0; bt < 2; ++bt) {
      float pacc[64];
#pragma unroll
      for (int e0 = 0; e0 < 64; e0 += 8) {
        uint4 ra[8], rb[8];
#pragma unroll
        for (int u = 0; u < 8; ++u) {
          const int row = __builtin_amdgcn_readlane(idx[bt], e0 + u);
          const uint4* rp = (const uint4*)(UB + (size_t)row * 2048);
          ra[u] = rp[lane];
          rb[u] = rp[64 + lane];
        }
#pragma unroll
        for (int u = 0; u < 8; ++u) {
          float a0 = 0.f, a1 = 0.f;
          a0 = dot2bf(ra[u].x, h0.x, a0); a1 = dot2bf(ra[u].y, h0.y, a1);
          a0 = dot2bf(ra[u].z, h0.z, a0); a1 = dot2bf(ra[u].w, h0.w, a1);
          a0 = dot2bf(rb[u].x, h1.x, a0); a1 = dot2bf(rb[u].y, h1.y, a1);
          a0 = dot2bf(rb[u].z, h1.z, a0); a1 = dot2bf(rb[u].w, h1.w, a1);
          pacc[e0 + u] = a0 + a1;
        }
      }
#pragma unroll
      for (int s = 32; s >= 1; s >>= 1) {
        const bool upper = (lane & s) != 0;
#pragma unroll
        for (int i = 0; i < s; ++i) {
          const float send = upper ? pacc[i] : pacc[i + s];
          const float keep = upper ? pacc[i + s] : pacc[i];
          pacc[i] = keep + __shfl_xor(send, s);
        }
      }
      wv[bt] = gelu_(pacc[0] * rs2) * gt[bt];
    }
    float o[16];
#pragma unroll
    for (int q = 0; q < 16; ++q) o[q] = 0.f;
#pragma unroll
    for (int bt = 0; bt < 2; ++bt) {
#pragma unroll 1
      for (int e0 = 0; e0 < 64; e0 += 8) {
        uint4 ra[8], rb[8];
#pragma unroll
        for (int u = 0; u < 8; ++u) {
          const int row = __builtin_amdgcn_readlane(idx[bt], e0 + u);
          const uint4* rp = (const uint4*)(VB + (size_t)row * 2048);
          ra[u] = rp[lane];
          rb[u] = rp[64 + lane];
        }
#pragma unroll
        for (int u = 0; u < 8; ++u) {
          const float wj = __uint_as_float(__builtin_amdgcn_readlane(__float_as_uint(wv[bt]), e0 + u));
          o[0] += wj * bf_lo(ra[u].x); o[1] += wj * bf_hi(ra[u].x); o[2] += wj * bf_lo(ra[u].y); o[3] += wj * bf_hi(ra[u].y);
          o[4] += wj * bf_lo(ra[u].z); o[5] += wj * bf_hi(ra[u].z); o[6] += wj * bf_lo(ra[u].w); o[7] += wj * bf_hi(ra[u].w);
          o[8] += wj * bf_lo(rb[u].x); o[9] += wj * bf_hi(rb[u].x); o[10] += wj * bf_lo(rb[u].y); o[11] += wj * bf_hi(rb[u].y);
          o[12] += wj * bf_lo(rb[u].z); o[13] += wj * bf_hi(rb[u].z); o[14] += wj * bf_lo(rb[u].w); o[15] += wj * bf_hi(rb[u].w);
        }
      }
    }
    float4* y0 = (float4*)(p.out + O_Y + (size_t)m * 1024 + lane * 8);
    float4* y1 = (float4*)(p.out + O_Y + (size_t)m * 1024 + 512 + lane * 8);
    float4 a = y0[0], b = y0[1], c = y1[0], d = y1[1];
    a.x += o[0]; a.y += o[1]; a.z += o[2]; a.w += o[3];
    b.x += o[4]; b.y += o[5]; b.z += o[6]; b.w += o[7];
    c.x += o[8]; c.y += o[9]; c.z += o[10]; c.w += o[11];
    d.x += o[12]; d.y += o[13]; d.z += o[14]; d.w += o[15];
    y0[0] = a; y0[1] = b; y1[0] = c; y1[1] = d;
  }
}

#define XB_TMO      128
#define XB_XCNT(j)  (256  + 64 * (j))
#define XB_XSUB(j)  (1280 + 64 * (j))
#define XB_XGEN(j)  (2304 + 64 * (j))
#define XB_TOP      3328
#define XB_TOPGEN   3392
#define XCD_BAR_WORDS 3456
#define XB_SPIN_CAP (1u << 18)
#define LAS __attribute__((address_space(3)))
DI unsigned xb_ld(unsigned* p) { return __hip_atomic_load(p, __ATOMIC_RELAXED, __HIP_MEMORY_SCOPE_AGENT); }
DI unsigned xb_add(unsigned* p, unsigned v) { return __hip_atomic_fetch_add(p, v, __ATOMIC_RELAXED, __HIP_MEMORY_SCOPE_AGENT); }
DI unsigned xb_xcc_id() { return (unsigned)__builtin_amdgcn_s_getreg((3 << 11) | 20) & 0xFu; }
#define XB_SPIN(cond, bar) do { unsigned _sp = 0; while (cond) { __builtin_amdgcn_s_sleep(1); \
    if ((++_sp & 255u) == 0u) { if (xb_ld(&(bar)[XB_TMO])) break; if (_sp > XB_SPIN_CAP) { atomicAdd(&(bar)[XB_TMO], 1u); break; } } } } while (0)
struct XcdBarrier { unsigned* bar; unsigned x; volatile LAS unsigned* st; };
DI XcdBarrier xcd_barrier_post(unsigned* bar, volatile LAS unsigned* st) {
  XcdBarrier b; b.bar = bar; b.x = xb_xcc_id(); b.st = st;
  if (threadIdx.x == 0) (void)xb_add(&bar[XB_XCNT(b.x)], 1u);
  return b;
}
DI void xcd_barrier_complete(unsigned* bar, unsigned x, unsigned& nloc, unsigned& nx) {
  const unsigned G = gridDim.x * gridDim.y * gridDim.z;
  unsigned sum, cnt, mine, sp = 0u;
  for (;;) {
    sum = 0u; cnt = 0u; mine = 0u;
#pragma unroll
    for (unsigned j = 0; j < 16; ++j) { const unsigned c = xb_ld(&bar[XB_XCNT(j)]); sum += c; cnt += (c > 0u) ? 1u : 0u; mine = (j == x) ? c : mine; }
    if (sum == G) break;
    __builtin_amdgcn_s_sleep(1);
    if ((++sp & 255u) == 0u) { if (xb_ld(&bar[XB_TMO])) break; if (sp > XB_SPIN_CAP) { atomicAdd(&bar[XB_TMO], 1u); break; } }
  }
  nloc = mine > 0u ? mine : 1u; nx = cnt > 0u ? cnt : 1u;
}
DI void xcd_barrier(const XcdBarrier& b) {
  asm volatile("s_waitcnt vmcnt(0)" ::: "memory");
  __syncthreads();
  if (threadIdx.x == 0) {
    unsigned* bar = b.bar;
    __builtin_amdgcn_s_waitcnt(0);
    unsigned nloc = b.st[0], nx = b.st[1];
    if (nloc == 0u) { xcd_barrier_complete(bar, b.x, nloc, nx); b.st[0] = nloc; b.st[1] = nx; }
    const unsigned old = xb_add(&bar[XB_XSUB(b.x)], 1u);
    const unsigned gen = old / nloc;
    if (old + 1u == (gen + 1u) * nloc) {
      __builtin_amdgcn_fence(__ATOMIC_RELEASE, "agent");
      asm volatile("s_waitcnt vmcnt(0)" ::: "memory");
      const unsigned og = xb_add(&bar[XB_TOP], 1u);
      const unsigned tg = og / nx;
      if (og + 1u == (tg + 1u) * nx) xb_add(&bar[XB_TOPGEN], 1u);
      else XB_SPIN(xb_ld(&bar[XB_TOPGEN]) == tg, bar);
      __builtin_amdgcn_fence(__ATOMIC_ACQUIRE, "agent");
      xb_add(&bar[XB_XGEN(b.x)], 1u);
      asm volatile("s_waitcnt vmcnt(0)" ::: "memory");
    } else {
      XB_SPIN(xb_ld(&bar[XB_XGEN(b.x)]) == gen, bar);
      __builtin_amdgcn_fence(__ATOMIC_ACQUIRE, "agent");
      asm volatile("s_waitcnt vmcnt(0)" ::: "memory");
    }
  }
  __syncthreads();
}

__global__ void __launch_bounds__(256, 2) hymba_mega(Params p) {
  __shared__ __attribute__((aligned(16))) char smem[36864];
  __shared__ uint4 xb_words;
  cg::grid_group grid = cg::this_grid();
  const int nb = gridDim.x, bid = blockIdx.x;
  if (threadIdx.x == 0) xb_words = make_uint4(0u, 0u, 0u, 0u);
  __syncthreads();
  XcdBarrier xb = xcd_barrier_post((unsigned*)(p.ws + W_BAR), (volatile LAS unsigned*)&xb_words);
  if (p.out == nullptr) grid.sync();
  phase0(p, smem);
  xcd_barrier(xb);
  for (int t = bid; t < 130 * 14; t += nb) gemm_tile<1>(p, t / 14, t % 14, smem);
  xcd_barrier(xb);
  for (int it = bid; it < 512; it += nb) lru_item<0>(p, it, smem);
  xcd_barrier(xb);
  for (int it = bid; it < 528 + 544; it += nb) {
    if (it < 528) lru_item<1>(p, it, smem);
    else attn_item(p, it - 528, smem);
  }
  xcd_barrier(xb);
  for (int t = bid; t < 130 * 8; t += nb) gemm_tile<2>(p, t >> 3, t & 7, smem);
  xcd_barrier(xb);
  for (int t = bid; t < 130 * 16; t += nb) gemm_tile<3>(p, t >> 4, t & 15, smem);
  xcd_barrier(xb);
  for (int it = bid; it < 260 * 8; it += nb) route_item(p, it, smem);
  xcd_barrier(xb);
  peer_gather(p);
}

extern "C" void kernel_launch(void* const* d_in, const int* in_sizes, int n_in, void* d_out, int out_size, void* d_ws,
                              size_t ws_size, hipStream_t stream) {
  static int grid_blocks = 0;
  if (!grid_blocks) {
    int dev = 0, cus = 0, per_cu = 0;
    (void)hipGetDevice(&dev);
    (void)hipDeviceGetAttribute(&cus, hipDeviceAttributeMultiprocessorCount, dev);
    (void)hipOccupancyMaxActiveBlocksPerMultiprocessor(&per_cu, hymba_mega, 256, 0);
    if (per_cu > 2) per_cu = 2;
    if (per_cu < 1) per_cu = 1;
    grid_blocks = cus * per_cu;
  }
  if (ws_size < W_END) fprintf(stderr, "workspace too small: %zu < %zu\n", ws_size, (size_t)W_END);
  Params p{};
  const float** pp = (const float**)&p;
  for (int i = 0; i < 27; ++i) pp[i] = (const float*)d_in[i];
  p.out = (float*)d_out;
  p.ws = (char*)d_ws;
  (void)hipMemsetAsync((char*)d_ws + W_BAR, 0, XCD_BAR_WORDS * 4, stream);
  void* args[] = {&p};
  hipError_t e = hipLaunchCooperativeKernel((void*)hymba_mega, dim3(grid_blocks), dim3(256), args, 0, stream);
  if (e != hipSuccess) fprintf(stderr, "cooperative launch failed: %s (grid %d)\n", hipGetErrorString(e), grid_blocks);
}
```

```cpp
#include <hip/hip_runtime.h>
#include <hip/hip_cooperative_groups.h>
#include <cstdio>
namespace cg = cooperative_groups;

#define DI __device__ __forceinline__
typedef __bf16 bf2_t __attribute__((ext_vector_type(2)));
typedef float fl2_t __attribute__((ext_vector_type(2)));
typedef short bf16x8 __attribute__((ext_vector_type(8)));
typedef float f32x16 __attribute__((ext_vector_type(16)));
typedef unsigned short u16;
typedef unsigned u32x4 __attribute__((ext_vector_type(4)));
#define MFMA32(a, b, c) __builtin_amdgcn_mfma_f32_32x32x16_bf16((a), (b), (c), 0, 0, 0)

constexpr int TP = 16384, TS = 256, TT = 16640;
constexpr float EPS = 1e-6f;
constexpr float USCALE = 512.0f, VSCALE = 64.0f;

constexpr size_t O_Y = 0;
constexpr size_t O_KP = 17039360, O_VP = 17170432, O_CONVP = 17301504, O_LRUP = 17313792;
constexpr size_t O_KS = 17317888, O_VS = 17580032, O_CONVS = 17842176, O_LRUS = 17866752;

constexpr size_t al(size_t x) { return (x + 255) & ~size_t(255); }
constexpr size_t W_WTIN = 0;
constexpr size_t W_WTOUT = W_WTIN + al(1792ull * 1024 * 2);
constexpr size_t W_WTQ = W_WTOUT + al(1024ull * 1024 * 2);
constexpr size_t W_K1B = W_WTQ + al(2048ull * 1024 * 2);
constexpr size_t W_K2B = W_K1B + al(128 * 128 * 2);
constexpr size_t W_WAT = W_K2B + al(128 * 128 * 2);
constexpr size_t W_WIT = W_WAT + al(8 * 64 * 64 * 2);
constexpr size_t W_C8 = W_WIT + al(8 * 64 * 64 * 2);
constexpr size_t W_UB = W_C8 + al(512 * 4);
constexpr size_t W_VB = W_UB + al(16384ull * 1024 * 2);
constexpr size_t W_RB = W_VB + al(16384ull * 1024 * 2);
constexpr size_t W_XB = W_RB;
constexpr size_t W_CAT = W_RB;
constexpr size_t W_SIDX = W_RB;
constexpr size_t W_SGATE = W_RB + al(TT * 128ull * 4);
constexpr size_t W_RC = W_RB + al(TT * 1024ull * 2);
constexpr size_t W_U = W_RC;
constexpr size_t W_GG = W_RC + TT * 512ull * 2;
constexpr size_t W_HB = W_RC;
constexpr size_t W_Q = W_RC + al(TT * 1024ull * 2);
constexpr size_t W_KP = W_Q + al(TT * 512ull * 2);
constexpr size_t W_KS = W_KP + al(TP * 128ull * 2);
constexpr size_t W_VTP = W_KS + al(16 * 192 * 128 * 2);
constexpr size_t W_VTS = W_VTP + al(8 * 128 * 2048ull * 2);
constexpr size_t W_SUMA = W_VTS + al(16 * 128 * 192 * 2);
constexpr size_t W_SUMH = W_SUMA + al(512 * 512 * 4);
constexpr size_t W_RS1 = W_SUMH + al(512 * 512 * 4);
constexpr size_t W_SSQL = W_RS1 + al(TT * 4);
constexpr size_t W_SSQA = W_SSQL + al(TT * 4 * 4);
constexpr size_t W_SSQ2 = W_SSQA + al(TT * 8 * 4);
constexpr size_t W_PQ = W_SSQ2 + al(TT * 16 * 4);
constexpr size_t W_PART = W_PQ;
constexpr size_t W_WTS = W_SGATE + al(TT * 128ull * 4);
constexpr size_t W_RS2 = W_PQ + al(TT * 2048ull * 2);
constexpr size_t W_BAR = W_RS2 + al(TT * 4);
constexpr size_t W_END = W_BAR + al(3456 * 4);

struct Params {
  const float *x_p, *x_s, *cache_k, *cache_v, *state_conv, *state_lru, *ln1_g, *w_in, *conv_w, *conv_b,
      *lru_wa, *lru_ba, *lru_wi, *lru_bi, *lru_lambda, *q_g, *k_g, *sinks, *g_lru, *g_attn, *w_out, *ln2_g,
      *w_query, *sk1, *sk2, *peer_u, *peer_v;
  float* out;
  char* ws;
};

DI unsigned pk2(float a, float b) {
  fl2_t f = {a, b};
  return __builtin_bit_cast(unsigned, __builtin_convertvector(f, bf2_t));
}
DI float bf_lo(unsigned u) { return __uint_as_float(u << 16); }
DI float bf_hi(unsigned u) { return __uint_as_float(u & 0xffff0000u); }
DI float bf1(u16 v) { return __uint_as_float(((unsigned)v) << 16); }
DI float sigmoidf_(float x) { return 1.0f / (1.0f + __expf(-x)); }
DI float gelu_(float x) {
  float z = 0.7978845608028654f * (x + 0.044715f * x * x * x);
  return x / (1.0f + __expf(-2.0f * z));
}
DI int crow(int r, int h) { return (r & 3) + 8 * (r >> 2) + 4 * h; }

DI void transpose_tile(const float* __restrict__ src, int ld_src, u16* __restrict__ dst, int ld_dst, int k0, int n0,
                       const float* __restrict__ gain, float* tile) {
  const int tid = threadIdx.x;
  const int c = tid & 63, r0 = tid >> 6;
  __syncthreads();
#pragma unroll 4
  for (int rr = 0; rr < 16; ++rr) {
    int r = rr * 4 + r0;
    float v = src[(size_t)(k0 + r) * ld_src + n0 + c];
    if (gain) v *= gain[k0 + r];
    tile[r * 65 + c] = v;
  }
  __syncthreads();
  const int n = tid >> 2, kq = (tid & 3) * 16;
  unsigned pk[8];
#pragma unroll
  for (int i = 0; i < 8; ++i) pk[i] = pk2(tile[(kq + 2 * i) * 65 + n], tile[(kq + 2 * i + 1) * 65 + n]);
  uint4* d = (uint4*)(dst + (size_t)(n0 + n) * ld_dst + k0 + kq);
  d[0] = make_uint4(pk[0], pk[1], pk[2], pk[3]);
  d[1] = make_uint4(pk[4], pk[5], pk[6], pk[7]);
}

DI void phase0(const Params& p, char* smem) {
  const int nb = gridDim.x, bid = blockIdx.x, tid = threadIdx.x;
  char* ws = p.ws;
  float* tile = (float*)smem;
  for (int it = bid; it < 1232; it += nb) {
    if (it < 448) {
      int kt = it / 28, nt = it % 28;
      transpose_tile(p.w_in, 1792, (u16*)(ws + W_WTIN), 1024, kt * 64, nt * 64, p.ln1_g, tile);
    } else if (it < 704) {
      int j = it - 448;
      int kt = j >> 4, nt = j & 15;
      const float* gain = (kt < 8) ? p.g_lru : (p.g_attn - 512);
      transpose_tile(p.w_out, 1024, (u16*)(ws + W_WTOUT), 1024, kt * 64, nt * 64, gain, tile);
    } else if (it < 1216) {
      int j = it - 704;
      int kt = j >> 5, nt = j & 31;
      transpose_tile(p.w_query, 2048, (u16*)(ws + W_WTQ), 1024, kt * 64, nt * 64, p.ln2_g, tile);
    } else {
      int j = it - 1216;
      int n = j & 7;
      if (j < 8) transpose_tile(p.lru_wa + n * 4096, 64, (u16*)(ws + W_WAT) + n * 4096, 64, 0, 0, nullptr, tile);
      else transpose_tile(p.lru_wi + n * 4096, 64, (u16*)(ws + W_WIT) + n * 4096, 64, 0, 0, nullptr, tile);
    }
  }
  const size_t gt = (size_t)bid * 256 + tid, gstride = (size_t)nb * 256;
  {
    for (size_t i = gt; i < 16384ull * 64; i += gstride) {
      const int e = (int)(i >> 6), c16 = (int)(i & 63);
      const float4* su = (const float4*)(p.peer_u + (size_t)e * 1024 + c16 * 16);
      const float4* sv = (const float4*)(p.peer_v + (size_t)e * 1024 + c16 * 16);
      const float4* g2 = (const float4*)(p.ln2_g + c16 * 16);
      u32x4 ou, ov;
#pragma unroll
      for (int q = 0; q < 4; ++q) {
        const float4 a = su[q], g = g2[q], c = sv[q];
        int pu = 0, pv = 0;
        pu = __builtin_amdgcn_cvt_pk_fp8_f32(a.x * g.x * USCALE, a.y * g.y * USCALE, pu, false);
        pu = __builtin_amdgcn_cvt_pk_fp8_f32(a.z * g.z * USCALE, a.w * g.w * USCALE, pu, true);
        pv = __builtin_amdgcn_cvt_pk_fp8_f32(c.x * VSCALE, c.y * VSCALE, pv, false);
        pv = __builtin_amdgcn_cvt_pk_fp8_f32(c.z * VSCALE, c.w * VSCALE, pv, true);
        ou[q] = (unsigned)pu; ov[q] = (unsigned)pv;
      }
      const size_t off = ((size_t)((c16 >> 3) * 16384 + e)) * 128 + (c16 & 7) * 16;
      *(u32x4*)(ws + W_UB + off) = ou;
      *(u32x4*)(ws + W_VB + off) = ov;
    }
  }
  for (size_t i = gt; i < 4096; i += gstride) {
    const float* s = (i < 2048) ? p.sk1 : p.sk2;
    size_t j = (i & 2047);
    const float4* sp = (const float4*)s + j * 2;
    float4 a = sp[0], b = sp[1];
    uint4 o = make_uint4(pk2(a.x, a.y), pk2(a.z, a.w), pk2(b.x, b.y), pk2(b.z, b.w));
    ((uint4*)(ws + ((i < 2048) ? W_K1B : W_K2B)))[j] = o;
  }
  for (size_t i = gt; i < 512; i += gstride) {
    float l = p.lru_lambda[i];
    float sp = (l < -15.f) ? -l : log1pf(expf(-l));
    ((float*)(ws + W_C8))[i] = -8.0f * sp;
  }
  for (size_t i = gt; i < 16 * 128 * 16; i += gstride) {
    int b = (int)(i >> 11), rem = (int)(i & 2047);
    int t = rem >> 4, c8i = rem & 15;
    const float4* sk = (const float4*)(p.cache_k + ((size_t)(b * 128 + t) * 128 + c8i * 8));
    float4 a = sk[0], bb = sk[1];
    uint4 o = make_uint4(pk2(a.x, a.y), pk2(a.z, a.w), pk2(bb.x, bb.y), pk2(bb.z, bb.w));
    *(uint4*)(ws + W_KS + ((size_t)(b * 192 + t) * 128 + c8i * 8) * 2) = o;
    const float4* sv = (const float4*)(p.cache_v + ((size_t)(b * 128 + t) * 128 + c8i * 8));
    float4 va = sv[0], vb = sv[1];
    if (t >= 16) {
      float4* dk = (float4*)(p.out + O_KS + ((size_t)(b * 128 + t - 16) * 128 + c8i * 8));
      dk[0] = a; dk[1] = bb;
      float4* dv = (float4*)(p.out + O_VS + ((size_t)(b * 128 + t - 16) * 128 + c8i * 8));
      dv[0] = va; dv[1] = vb;
    }
    u16* vt = (u16*)(ws + W_VTS) + (size_t)b * 128 * 192;
    float vv[8] = {va.x, va.y, va.z, va.w, vb.x, vb.y, vb.z, vb.w};
#pragma unroll
    for (int q = 0; q < 8; ++q) vt[(size_t)(c8i * 8 + q) * 192 + t] = (u16)(pk2(vv[q], 0.f) & 0xffffu);
  }
  for (size_t i = gt; i < 16 * 48 * 128; i += gstride) {
    int b = (int)(i / (48 * 128)), rem = (int)(i % (48 * 128));
    ((u16*)(ws + W_KS))[(size_t)(b * 192 + 144) * 128 + rem] = 0;
    int ch = rem / 48, tt = rem % 48;
    ((u16*)(ws + W_VTS))[(size_t)(b * 128 + ch) * 192 + 144 + tt] = 0;
  }
  {
    const int lane = tid & 63;
    const int gw = bid * 4 + (tid >> 6), nw = nb * 4;
    for (int m = gw; m < TT; m += nw) {
      const float* xr = (m < TP) ? (p.x_p + (size_t)m * 1024) : (p.x_s + (size_t)(m - TP) * 1024);
      const float4* xp = (const float4*)xr;
      float ss = 0.f;
      uint4* dst = (uint4*)(ws + W_XB + (size_t)m * 2048);
#pragma unroll
      for (int q = 0; q < 2; ++q) {
        float4 a = xp[q * 128 + lane * 2], b = xp[q * 128 + lane * 2 + 1];
        ss += a.x * a.x + a.y * a.y + a.z * a.z + a.w * a.w + b.x * b.x + b.y * b.y + b.z * b.z + b.w * b.w;
        dst[q * 64 + lane] = make_uint4(pk2(a.x, a.y), pk2(a.z, a.w), pk2(b.x, b.y), pk2(b.z, b.w));
      }
#pragma unroll
      for (int s = 32; s >= 1; s >>= 1) ss += __shfl_xor(ss, s);
      if (lane == 0) ((float*)(ws + W_RS1))[m] = rsqrtf(ss * (1.0f / 1024.0f) + EPS);
    }
  }
}

template <int MODE>
DI void gemm_tile(const Params& p, int mt, int nt, char* smem) {
  constexpr int LROW = 144;
  char* ws = p.ws;
  const char* Wt = ws + (MODE == 1 ? W_WTIN : (MODE == 2 ? W_WTOUT : W_WTQ));
  const char* X = ws + (MODE == 1 ? W_XB : (MODE == 2 ? W_CAT : W_HB));
  char* sW = smem;
  char* sX = smem + 128 * LROW;
  const int tid = threadIdx.x, lane = tid & 63, w = tid >> 6, wn = w & 1, wm = w >> 1;
  const int tl = lane & 31, h = lane >> 5;
  const char* gW = Wt + (size_t)(nt * 128) * 2048;
  const char* gX = X + (size_t)(mt * 128) * 2048;
  u32x4 rW[4], rX[4];
  f32x16 acc[2][2];
#pragma unroll
  for (int i = 0; i < 2; ++i)
#pragma unroll
    for (int j = 0; j < 2; ++j)
#pragma unroll
      for (int r = 0; r < 16; ++r) acc[i][j][r] = 0.f;

  const int m_lane[2] = {mt * 128 + wm * 64 + tl, mt * 128 + wm * 64 + 32 + tl};
  float ratio[2] = {1.f, 1.f}, fscale[2] = {1.f, 1.f};
  if (MODE == 2) {
#pragma unroll
    for (int j = 0; j < 2; ++j) {
      const float4 sl = *(const float4*)(ws + W_SSQL + (size_t)m_lane[j] * 16);
      const float4 sa0 = *(const float4*)(ws + W_SSQA + (size_t)m_lane[j] * 32);
      const float4 sa1 = *(const float4*)(ws + W_SSQA + (size_t)m_lane[j] * 32 + 16);
      float rsl = rsqrtf((sl.x + sl.y + sl.z + sl.w) * (1.0f / 512.0f) + EPS);
      float rsa = rsqrtf((sa0.x + sa0.y + sa0.z + sa0.w + sa1.x + sa1.y + sa1.z + sa1.w) * (1.0f / 512.0f) + EPS);
      ratio[j] = rsl / rsa;
      fscale[j] = rsa;
    }
  } else if (MODE == 1) {
#pragma unroll
    for (int j = 0; j < 2; ++j) fscale[j] = ((const float*)(ws + W_RS1))[m_lane[j]];
  } else {
#pragma unroll
    for (int j = 0; j < 2; ++j) {
      const float4* sp = (const float4*)(ws + W_SSQ2 + (size_t)m_lane[j] * 64);
      float4 a = sp[0], b = sp[1], c = sp[2], d = sp[3];
      float s = a.x + a.y + a.z + a.w + b.x + b.y + b.z + b.w + c.x + c.y + c.z + c.w + d.x + d.y + d.z + d.w;
      fscale[j] = rsqrtf(s * (1.0f / 1024.0f) + EPS);
    }
  }

#pragma unroll
  for (int i = 0; i < 4; ++i) {
    int c = tid + 256 * i, row = c >> 3, kc = c & 7;
    rW[i] = *(const u32x4*)(gW + (size_t)row * 2048 + kc * 16);
    rX[i] = *(const u32x4*)(gX + (size_t)row * 2048 + kc * 16);
  }
  for (int ks = 0; ks < 16; ++ks) {
    __syncthreads();
#pragma unroll
    for (int i = 0; i < 4; ++i) {
      int c = tid + 256 * i, row = c >> 3, kc = c & 7;
      *(u32x4*)(sW + row * LROW + kc * 16) = rW[i];
      *(u32x4*)(sX + row * LROW + kc * 16) = rX[i];
    }
    __syncthreads();
    if (ks + 1 < 16) {
#pragma unroll
      for (int i = 0; i < 4; ++i) {
        int c = tid + 256 * i, row = c >> 3, kc = c & 7;
        rW[i] = *(const u32x4*)(gW + (size_t)row * 2048 + (ks + 1) * 128 + kc * 16);
        rX[i] = *(const u32x4*)(gX + (size_t)row * 2048 + (ks + 1) * 128 + kc * 16);
      }
    }
    if (MODE == 2 && ks == 8) {
#pragma unroll
      for (int i = 0; i < 2; ++i)
#pragma unroll
        for (int j = 0; j < 2; ++j)
#pragma unroll
          for (int r = 0; r < 16; ++r) acc[i][j][r] *= ratio[j];
    }
#pragma unroll
    for (int kk = 0; kk < 4; ++kk) {
      bf16x8 a[2], b[2];
#pragma unroll
      for (int i = 0; i < 2; ++i) a[i] = *(const bf16x8*)(sW + (wn * 64 + i * 32 + tl) * LROW + kk * 32 + h * 16);
#pragma unroll
      for (int j = 0; j < 2; ++j) b[j] = *(const bf16x8*)(sX + (wm * 64 + j * 32 + tl) * LROW + kk * 32 + h * 16);
#pragma unroll
      for (int i = 0; i < 2; ++i)
#pragma unroll
        for (int j = 0; j < 2; ++j) acc[i][j] = MFMA32(a[i], b[j], acc[i][j]);
    }
  }

  const int ncol0 = nt * 128 + wn * 64;
  if (MODE == 1) {
    if (ncol0 < 512) {
#pragma unroll
      for (int j = 0; j < 2; ++j) {
        const int m = m_lane[j];
        float* convdst = nullptr;
        if (m < TP) {
          int t = m & 2047;
          if (t >= 2045) convdst = p.out + O_CONVP + (size_t)((m >> 11) * 3 + (t - 2045)) * 512;
        } else {
          int ms = m - TP, t = ms & 15;
          if (t >= 13) convdst = p.out + O_CONVS + (size_t)((ms >> 4) * 3 + (t - 13)) * 512;
        }
        u16* ub = (u16*)(ws + W_U) + (size_t)m * 512;
#pragma unroll
        for (int i = 0; i < 2; ++i)
#pragma unroll
          for (int g = 0; g < 4; ++g) {
            int n = ncol0 + i * 32 + 8 * g + 4 * h;
            float v0 = acc[i][j][4 * g] * fscale[j], v1 = acc[i][j][4 * g + 1] * fscale[j],
                  v2 = acc[i][j][4 * g + 2] * fscale[j], v3 = acc[i][j][4 * g + 3] * fscale[j];
            *(uint2*)(ub + n) = make_uint2(pk2(v0, v1), pk2(v2, v3));
            if (convdst) *(float4*)(convdst + n) = make_float4(v0, v1, v2, v3);
          }
      }
    } else if (ncol0 < 1024) {
#pragma unroll
      for (int j = 0; j < 2; ++j) {
        u16* gb = (u16*)(ws + W_GG) + (size_t)m_lane[j] * 512;
#pragma unroll
        for (int i = 0; i < 2; ++i)
#pragma unroll
          for (int g = 0; g < 4; ++g) {
            int n = ncol0 - 512 + i * 32 + 8 * g + 4 * h;
            float v0 = gelu_(acc[i][j][4 * g] * fscale[j]), v1 = gelu_(acc[i][j][4 * g + 1] * fscale[j]),
                  v2 = gelu_(acc[i][j][4 * g + 2] * fscale[j]), v3 = gelu_(acc[i][j][4 * g + 3] * fscale[j]);
            *(uint2*)(gb + n) = make_uint2(pk2(v0, v1), pk2(v2, v3));
          }
      }
    } else if (ncol0 < 1664) {
      const bool isq = ncol0 < 1536;
      const float* gain = isq ? p.q_g : p.k_g;
      const float post = isq ? 0.125f : 1.0f;
#pragma unroll
      for (int j = 0; j < 2; ++j) {
        const int m = m_lane[j];
        float ss = 0.f;
#pragma unroll
        for (int i = 0; i < 2; ++i)
#pragma unroll
          for (int r = 0; r < 16; ++r) {
            float v = acc[i][j][r] * fscale[j];
            ss += v * v;
          }
        ss += __shfl_xor(ss, 32);
        const float sc = fscale[j] * rsqrtf(ss * (1.0f / 64.0f) + EPS) * post;
        u16* dst;
        float* fdst = nullptr;
        int nloc0;
        if (isq) {
          nloc0 = ncol0 - 1024;
          dst = (u16*)(ws + W_Q) + (size_t)m * 512 + nloc0;
        } else {
          nloc0 = ncol0 - 1536;
          if (m < TP) {
            dst = (u16*)(ws + W_KP) + (size_t)m * 128 + nloc0;
            int t = m & 2047;
            if (t >= 1920) fdst = p.out + O_KP + (size_t)((m >> 11) * 128 + (t - 1920)) * 128 + nloc0;
          } else {
            int ms = m - TP, b = ms >> 4, t = ms & 15;
            dst = (u16*)(ws + W_KS) + (size_t)(b * 192 + 128 + t) * 128 + nloc0;
            fdst = p.out + O_KS + (size_t)(b * 128 + 112 + t) * 128 + nloc0;
          }
        }
#pragma unroll
        for (int i = 0; i < 2; ++i)
#pragma unroll
          for (int g = 0; g < 4; ++g) {
            int d = i * 32 + 8 * g + 4 * h;
            const float4 gn = *(const float4*)(gain + d);
            float v0 = acc[i][j][4 * g] * sc * gn.x, v1 = acc[i][j][4 * g + 1] * sc * gn.y,
                  v2 = acc[i][j][4 * g + 2] * sc * gn.z, v3 = acc[i][j][4 * g + 3] * sc * gn.w;
            *(uint2*)(dst + d) = make_uint2(pk2(v0, v1), pk2(v2, v3));
            if (fdst) *(float4*)(fdst + d) = make_float4(v0, v1, v2, v3);
          }
      }
    } else {
#pragma unroll
      for (int j = 0; j < 2; ++j) {
        const int m = m_lane[j];
        u16* vt;
        size_t vstride;
        float* fdst = nullptr;
        const int ch0 = ncol0 - 1664;
        if (m < TP) {
          int b = m >> 11, t = m & 2047;
          vt = (u16*)(ws + W_VTP) + (size_t)b * 128 * 2048 + t;
          vstride = 2048;
          if (t >= 1920) fdst = p.out + O_VP + (size_t)(b * 128 + (t - 1920)) * 128;
        } else {
          int ms = m - TP, b = ms >> 4, t = ms & 15;
          vt = (u16*)(ws + W_VTS) + (size_t)b * 128 * 192 + 128 + t;
          vstride = 192;
          fdst = p.out + O_VS + (size_t)(b * 128 + 112 + t) * 128;
        }
#pragma unroll
        for (int i = 0; i < 2; ++i)
#pragma unroll
          for (int g = 0; g < 4; ++g) {
            int ch = ch0 + i * 32 + 8 * g + 4 * h;
            float v0 = acc[i][j][4 * g] * fscale[j], v1 = acc[i][j][4 * g + 1] * fscale[j],
                  v2 = acc[i][j][4 * g + 2] * fscale[j], v3 = acc[i][j][4 * g + 3] * fscale[j];
            unsigned p01 = pk2(v0, v1), p23 = pk2(v2, v3);
            vt[(size_t)(ch + 0) * vstride] = (u16)(p01 & 0xffffu);
            vt[(size_t)(ch + 1) * vstride] = (u16)(p01 >> 16);
            vt[(size_t)(ch + 2) * vstride] = (u16)(p23 & 0xffffu);
            vt[(size_t)(ch + 3) * vstride] = (u16)(p23 >> 16);
            if (fdst) *(float4*)(fdst + ch) = make_float4(v0, v1, v2, v3);
          }
      }
    }
  } else if (MODE == 2) {
#pragma unroll
    for (int j = 0; j < 2; ++j) {
      const int m = m_lane[j];
      const float* xr = (m < TP) ? (p.x_p + (size_t)m * 1024) : (p.x_s + (size_t)(m - TP) * 1024);
      float* yr = p.out + O_Y + (size_t)m * 1024;
      u16* hb = (u16*)(ws + W_HB) + (size_t)m * 1024;
      float ss = 0.f;
#pragma unroll
      for (int i = 0; i < 2; ++i)
#pragma unroll
        for (int g = 0; g < 4; ++g) {
          int n = ncol0 + i * 32 + 8 * g + 4 * h;
          const float4 xv = *(const float4*)(xr + n);
          float v0 = xv.x + acc[i][j][4 * g] * fscale[j], v1 = xv.y + acc[i][j][4 * g + 1] * fscale[j],
                v2 = xv.z + acc[i][j][4 * g + 2] * fscale[j], v3 = xv.w + acc[i][j][4 * g + 3] * fscale[j];
          *(float4*)(yr + n) = make_float4(v0, v1, v2, v3);
          *(uint2*)(hb + n) = make_uint2(pk2(v0, v1), pk2(v2, v3));
          ss += v0 * v0 + v1 * v1 + v2 * v2 + v3 * v3;
        }
      ss += __shfl_xor(ss, 32);
      if (h == 0) ((float*)(ws + W_SSQ2))[(size_t)m * 16 + nt * 2 + wn] = ss;
    }
  } else {
#pragma unroll
    for (int j = 0; j < 2; ++j) {
      if (nt == 0 && wn == 0 && h == 0) ((float*)(ws + W_RS2))[m_lane[j]] = fscale[j];
      u16* pq = (u16*)(ws + W_PQ) + (size_t)m_lane[j] * 2048;
#pragma unroll
      for (int i = 0; i < 2; ++i)
#pragma unroll
        for (int g = 0; g < 4; ++g) {
          int n = ncol0 + i * 32 + 8 * g + 4 * h;
          float v0 = acc[i][j][4 * g] * fscale[j], v1 = acc[i][j][4 * g + 1] * fscale[j],
                v2 = acc[i][j][4 * g + 2] * fscale[j], v3 = acc[i][j][4 * g + 3] * fscale[j];
          *(uint2*)(pq + n) = make_uint2(pk2(v0, v1), pk2(v2, v3));
        }
    }
  }
}

template <int FINAL>
DI void lru_item(const Params& p, int item, char* smem) {
  char* ws = p.ws;
  const bool samp = item >= 512;
  int b, c, m0, nvalid;
  if (!samp) { b = item >> 6; c = item & 63; m0 = b * 2048 + c * 32; nvalid = 32; }
  else { b = item - 512; c = 0; m0 = TP + b * 16; nvalid = 16; }
  const int tid = threadIdx.x, lane = tid & 63, w = tid >> 6, tl = lane & 31, h = lane >> 5;
  u16* XC = (u16*)smem;
  float* hin = (float*)(smem + 32 * 1040);
  __syncthreads();
  {
    const int ch = 2 * tid;
    const float2 w0 = *(const float2*)(p.conv_w + ch), w1 = *(const float2*)(p.conv_w + 512 + ch),
                 w2 = *(const float2*)(p.conv_w + 1024 + ch), w3 = *(const float2*)(p.conv_w + 1536 + ch),
                 cb = *(const float2*)(p.conv_b + ch);
    float2 r0 = {0.f, 0.f}, r1 = {0.f, 0.f}, r2 = {0.f, 0.f};
    const u16* ub = (const u16*)(ws + W_U);
    if (!samp) {
      if (c > 0) {
        unsigned a0 = *(const unsigned*)(ub + (size_t)(m0 - 3) * 512 + ch), a1 = *(const unsigned*)(ub + (size_t)(m0 - 2) * 512 + ch),
                 a2 = *(const unsigned*)(ub + (size_t)(m0 - 1) * 512 + ch);
        r0 = {bf_lo(a0), bf_hi(a0)}; r1 = {bf_lo(a1), bf_hi(a1)}; r2 = {bf_lo(a2), bf_hi(a2)};
      }
    } else {
      const float* sc = p.state_conv + (size_t)b * 3 * 512 + ch;
      r0 = *(const float2*)(sc); r1 = *(const float2*)(sc + 512); r2 = *(const float2*)(sc + 1024);
    }
#pragma unroll 8
    for (int t = 0; t < 32; ++t) {
      float2 cur = {0.f, 0.f};
      if (t < nvalid) {
        unsigned a = *(const unsigned*)(ub + (size_t)(m0 + t) * 512 + ch);
        cur = {bf_lo(a), bf_hi(a)};
      }
      float x0 = cb.x + w0.x * r0.x + w1.x * r1.x + w2.x * r2.x + w3.x * cur.x;
      float x1 = cb.y + w0.y * r0.y + w1.y * r1.y + w2.y * r2.y + w3.y * cur.y;
      *(unsigned*)(XC + t * 520 + ch) = pk2(x0, x1);
      r0 = r1; r1 = r2; r2 = cur;
    }
    if (FINAL) {
      float2 hh;
      if (samp) hh = *(const float2*)(p.state_lru + (size_t)b * 512 + ch);
      else {
        hh = {0.f, 0.f};
        const float* sA = (const float*)(ws + W_SUMA) + (size_t)(b * 64) * 512 + ch;
        const float* sH = (const float*)(ws + W_SUMH) + (size_t)(b * 64) * 512 + ch;
        int cc = 0;
        for (; cc + 4 <= c; cc += 4) {
          float2 A0 = *(const float2*)(sA + (size_t)(cc + 0) * 512), H0 = *(const float2*)(sH + (size_t)(cc + 0) * 512);
          float2 A1 = *(const float2*)(sA + (size_t)(cc + 1) * 512), H1 = *(const float2*)(sH + (size_t)(cc + 1) * 512);
          float2 A2 = *(const float2*)(sA + (size_t)(cc + 2) * 512), H2 = *(const float2*)(sH + (size_t)(cc + 2) * 512);
          float2 A3 = *(const float2*)(sA + (size_t)(cc + 3) * 512), H3 = *(const float2*)(sH + (size_t)(cc + 3) * 512);
          hh.x = A0.x * hh.x + H0.x; hh.y = A0.y * hh.y + H0.y;
          hh.x = A1.x * hh.x + H1.x; hh.y = A1.y * hh.y + H1.y;
          hh.x = A2.x * hh.x + H2.x; hh.y = A2.y * hh.y + H2.y;
          hh.x = A3.x * hh.x + H3.x; hh.y = A3.y * hh.y + H3.y;
        }
        for (; cc < c; ++cc) {
          float2 A0 = *(const float2*)(sA + (size_t)cc * 512), H0 = *(const float2*)(sH + (size_t)cc * 512);
          hh.x = A0.x * hh.x + H0.x; hh.y = A0.y * hh.y + H0.y;
        }
      }
      hin[ch] = hh.x; hin[ch + 1] = hh.y;
    }
  }
  __syncthreads();
  const u16* WaT = (const u16*)(ws + W_WAT);
  const u16* WiT = (const u16*)(ws + W_WIT);
  const float* c8 = (const float*)(ws + W_C8);
  const int m = m0 + tl;
  const bool valid = tl < nvalid;
  float ssq = 0.f;
#pragma unroll 1
  for (int nbk = 0; nbk < 2; ++nbk) {
    const int n = 2 * w + nbk;
    f32x16 accA[2], accI[2];
#pragma unroll
    for (int i = 0; i < 2; ++i)
#pragma unroll
      for (int r = 0; r < 16; ++r) { accA[i][r] = 0.f; accI[i][r] = 0.f; }
#pragma unroll
    for (int kk = 0; kk < 4; ++kk) {
      const bf16x8 bx = *(const bf16x8*)((const char*)XC + tl * 1040 + (n * 64 + kk * 16 + h * 8) * 2);
#pragma unroll
      for (int i = 0; i < 2; ++i) {
        const bf16x8 aa = *(const bf16x8*)(WaT + (size_t)(n * 64 + i * 32 + tl) * 64 + kk * 16 + h * 8);
        const bf16x8 ai = *(const bf16x8*)(WiT + (size_t)(n * 64 + i * 32 + tl) * 64 + kk * 16 + h * 8);
        accA[i] = MFMA32(aa, bx, accA[i]);
        accI[i] = MFMA32(ai, bx, accI[i]);
      }
    }
#pragma unroll
    for (int i = 0; i < 2; ++i)
#pragma unroll
      for (int g = 0; g < 4; ++g) {
        const int ch = n * 64 + i * 32 + 8 * g + 4 * h;
        const float4 ba4 = *(const float4*)(p.lru_ba + ch), bi4 = *(const float4*)(p.lru_bi + ch), c84 = *(const float4*)(c8 + ch);
        const float bav[4] = {ba4.x, ba4.y, ba4.z, ba4.w}, biv[4] = {bi4.x, bi4.y, bi4.z, bi4.w}, c8v[4] = {c84.x, c84.y, c84.z, c84.w};
        const uint2 xcp = *(const uint2*)(XC + tl * 520 + ch);
        const float xcv[4] = {bf_lo(xcp.x), bf_hi(xcp.x), bf_lo(xcp.y), bf_hi(xcp.y)};
        float hv[4];
#pragma unroll
        for (int q = 0; q < 4; ++q) {
          const int r = 4 * g + q;
          float rr = sigmoidf_(accA[i][r] + bav[q]);
          float ii = sigmoidf_(accI[i][r] + biv[q]);
          float la = c8v[q] * rr;
          float A = __expf(la);
          float x2 = 2.0f * la;
          float em = -x2 * (1.0f + x2 * (0.5f + x2 * (0.16666667f + x2 * (0.041666668f + x2 * (0.0083333333f + x2 * 0.0013888889f)))));
          float H = sqrtf(fmaxf(em, 0.f)) * ii * xcv[q];
#pragma unroll
          for (int dlt = 1; dlt < 32; dlt <<= 1) {
            float Ap = __shfl_up(A, dlt, 32), Hp = __shfl_up(H, dlt, 32);
            if (tl >= dlt) { H = A * Hp + H; A = A * Ap; }
          }
          if (!FINAL) {
            if (tl == 31) {
              ((float*)(ws + W_SUMA))[(size_t)(b * 64 + c) * 512 + ch + q] = A;
              ((float*)(ws + W_SUMH))[(size_t)(b * 64 + c) * 512 + ch + q] = H;
            }
          } else {
            hv[q] = H + A * hin[ch + q];
          }
        }
        if (FINAL) {
          if (tl == nvalid - 1 && (samp || c == 63)) {
            float* dst = p.out + (samp ? O_LRUS : O_LRUP) + (size_t)b * 512 + ch;
            *(float4*)dst = make_float4(hv[0], hv[1], hv[2], hv[3]);
          }
          if (valid) {
            const uint2 gp = *(const uint2*)((const u16*)(ws + W_GG) + (size_t)m * 512 + ch);
            float o0 = hv[0] * bf_lo(gp.x), o1 = hv[1] * bf_hi(gp.x), o2 = hv[2] * bf_lo(gp.y), o3 = hv[3] * bf_hi(gp.y);
            ssq += o0 * o0 + o1 * o1 + o2 * o2 + o3 * o3;
            *(uint2*)((u16*)(ws + W_CAT) + (size_t)m * 1024 + ch) = make_uint2(pk2(o0, o1), pk2(o2, o3));
          }
        }
      }
  }
  if (FINAL) {
    ssq += __shfl_xor(ssq, 32);
    if (valid && h == 0) ((float*)(ws + W_SSQL))[(size_t)m * 4 + w] = ssq;
  }
}

DI void attn_item(const Params& p, int item, char* smem) {
  char* ws = p.ws;
  const int tid = threadIdx.x, lane = tid & 63, w = tid >> 6, tl = lane & 31, h = lane >> 5;
  const bool samp = item >= 512;
  int b, c, g;
  const u16* Kb; const u16* Vt; int vstride, kc_lo, kc_hi, nkeys, mq0; bool qvalid;
  if (!samp) {
    b = item >> 6; c = (item >> 1) & 31; g = item & 1;
    Kb = (const u16*)(ws + W_KP) + (size_t)b * 2048 * 128;
    Vt = (const u16*)(ws + W_VTP) + (size_t)b * 128 * 2048;
    vstride = 2048; kc_lo = (c >= 2) ? c - 2 : 0; kc_hi = c; nkeys = 1 << 30;
    mq0 = b * 2048 + c * 64 + tl; qvalid = true;
  } else {
    int it = item - 512; b = it >> 1; g = it & 1; c = 0;
    Kb = (const u16*)(ws + W_KS) + (size_t)b * 192 * 128;
    Vt = (const u16*)(ws + W_VTS) + (size_t)b * 128 * 192;
    vstride = 192; kc_lo = 0; kc_hi = 2; nkeys = 144;
    mq0 = TP + b * 16 + (tl & 15); qvalid = tl < 16;
  }
  const int hq = g * 4 + w;
  const float sink = p.sinks[hq];
  char* sV = smem;
  const int nj = samp ? 1 : 2;
#pragma unroll 1
  for (int j = 0; j < nj; ++j) {
    const int mqj = mq0 + j * 32;
    bf16x8 bq[4];
#pragma unroll
    for (int kk = 0; kk < 4; ++kk)
      bq[kk] = *(const bf16x8*)((const u16*)(ws + W_Q) + (size_t)mqj * 512 + hq * 64 + kk * 16 + h * 8);
    float mrun = sink, lrun = 1.f;
    f32x16 O[2];
#pragma unroll
    for (int i = 0; i < 2; ++i)
#pragma unroll
      for (int r = 0; r < 16; ++r) O[i][r] = 0.f;
#pragma unroll 1
    for (int kc = kc_lo; kc <= kc_hi; ++kc) {
      __syncthreads();
#pragma unroll
      for (int i = 0; i < 2; ++i) {
        int idx = tid + 256 * i, d = idx >> 3, part = idx & 7;
        *(u32x4*)(sV + d * 144 + part * 16) = *(const u32x4*)(Vt + (size_t)(g * 64 + d) * vstride + kc * 64 + part * 8);
      }
      f32x16 S[2];
#pragma unroll
      for (int i = 0; i < 2; ++i)
#pragma unroll
        for (int r = 0; r < 16; ++r) S[i][r] = 0.f;
#pragma unroll
      for (int kk = 0; kk < 4; ++kk)
#pragma unroll
        for (int kt = 0; kt < 2; ++kt) {
          const bf16x8 ak = *(const bf16x8*)(Kb + (size_t)(kc * 64 + kt * 32 + tl) * 128 + g * 64 + kk * 16 + h * 8);
          S[kt] = MFMA32(ak, bq[kk], S[kt]);
        }
      if (samp) {
#pragma unroll
        for (int kt = 0; kt < 2; ++kt)
#pragma unroll
          for (int r = 0; r < 16; ++r) {
            int key = kc * 64 + kt * 32 + crow(r, h);
            if (key >= nkeys) S[kt][r] = -INFINITY;
          }
      }
      {
        float mx = -INFINITY;
#pragma unroll
        for (int kt = 0; kt < 2; ++kt)
#pragma unroll
          for (int r = 0; r < 16; ++r) mx = fmaxf(mx, S[kt][r]);
        mx = fmaxf(mx, __shfl_xor(mx, 32));
        const float mnew = fmaxf(mrun, mx);
        const float alpha = __expf(mrun - mnew);
        float ps = 0.f;
#pragma unroll
        for (int kt = 0; kt < 2; ++kt)
#pragma unroll
          for (int r = 0; r < 16; ++r) {
            float pv = __expf(S[kt][r] - mnew);
            S[kt][r] = pv;
            ps += pv;
          }
        ps += __shfl_xor(ps, 32);
        lrun = lrun * alpha + ps;
        mrun = mnew;
#pragma unroll
        for (int dt = 0; dt < 2; ++dt)
#pragma unroll
          for (int r = 0; r < 16; ++r) O[dt][r] *= alpha;
      }
      __syncthreads();
#pragma unroll
      for (int kt = 0; kt < 2; ++kt)
#pragma unroll
        for (int s2 = 0; s2 < 2; ++s2) {
          u32x4 pp;
          pp[0] = pk2(S[kt][8 * s2 + 0], S[kt][8 * s2 + 1]);
          pp[1] = pk2(S[kt][8 * s2 + 2], S[kt][8 * s2 + 3]);
          pp[2] = pk2(S[kt][8 * s2 + 4], S[kt][8 * s2 + 5]);
          pp[3] = pk2(S[kt][8 * s2 + 6], S[kt][8 * s2 + 7]);
          const bf16x8 bp = __builtin_bit_cast(bf16x8, pp);
#pragma unroll
          for (int dt = 0; dt < 2; ++dt) {
            const int d = dt * 32 + tl;
            const uint2 lo = *(const uint2*)(sV + d * 144 + (kt * 32 + 16 * s2 + 4 * h) * 2);
            const uint2 hi = *(const uint2*)(sV + d * 144 + (kt * 32 + 16 * s2 + 8 + 4 * h) * 2);
            u32x4 av4;
            av4[0] = lo.x; av4[1] = lo.y; av4[2] = hi.x; av4[3] = hi.y;
            O[dt] = MFMA32(__builtin_bit_cast(bf16x8, av4), bp, O[dt]);
          }
        }
    }
    const float inv = 1.0f / lrun;
    float ss = 0.f;
    u16* dst = (u16*)(ws + W_CAT) + (size_t)mqj * 1024 + 512 + hq * 64;
#pragma unroll
    for (int dt = 0; dt < 2; ++dt)
#pragma unroll
      for (int g4 = 0; g4 < 4; ++g4) {
        int d = dt * 32 + 8 * g4 + 4 * h;
        float v0 = O[dt][4 * g4] * inv, v1 = O[dt][4 * g4 + 1] * inv, v2 = O[dt][4 * g4 + 2] * inv, v3 = O[dt][4 * g4 + 3] * inv;
        ss += v0 * v0 + v1 * v1 + v2 * v2 + v3 * v3;
        if (qvalid) *(uint2*)(dst + d) = make_uint2(pk2(v0, v1), pk2(v2, v3));
      }
    ss += __shfl_xor(ss, 32);
    if (qvalid && h == 0) ((float*)(ws + W_SSQA))[(size_t)mqj * 8 + hq] = ss;
  }
}

DI unsigned f2ord(float f) { unsigned u = __float_as_uint(f); return u ^ ((unsigned)((int)u >> 31) | 0x80000000u); }
DI float ord2f(unsigned u) { return __uint_as_float((u & 0x80000000u) ? (u ^ 0x80000000u) : ~u); }
DI void cas_desc(unsigned& a, unsigned& b) { unsigned mx = a > b ? a : b, mn = a > b ? b : a; a = mx; b = mn; }
DI void sort16_desc(unsigned (&v)[16]) {
#pragma unroll
  for (int k = 2; k <= 16; k <<= 1)
#pragma unroll
    for (int j = k >> 1; j > 0; j >>= 1)
#pragma unroll
      for (int i = 0; i < 16; ++i) {
        int l = i ^ j;
        if (l > i) {
          if ((i & k) == 0) cas_desc(v[i], v[l]); else cas_desc(v[l], v[i]);
        }
      }
}
DI void merge16_desc(unsigned (&v)[16]) {
#pragma unroll
  for (int j = 8; j > 0; j >>= 1)
#pragma unroll
    for (int i = 0; i < 16; ++i) {
      int l = i ^ j;
      if (l > i) cas_desc(v[i], v[l]);
    }
}
DI void merge_top16(unsigned (&a)[16], unsigned (&b)[16]) {
#pragma unroll
  for (int i = 0; i < 16; ++i) a[i] = a[i] > b[15 - i] ? a[i] : b[15 - i];
  merge16_desc(a);
}

struct CandTab { int i[64]; int j[64]; int n; };
constexpr CandTab make_tab() {
  CandTab t{};
  int n = 0;
  for (int i = 0; i < 16; ++i)
    for (int j = 0; j < 16; ++j)
      if ((i + 1) * (j + 1) <= 16) { t.i[n] = i; t.j[n] = j; ++n; }
  t.n = n;
  return t;
}

DI void route_item(const Params& p, int item, char* smem) {
  char* ws = p.ws;
  const int tid = threadIdx.x, lane = tid & 63, w = tid >> 6, tl = lane & 31, h = lane >> 5;
  const int tt = item >> 3, hd = item & 7;
  const int m0 = tt * 64;
  const int half = w >> 1, tq = w & 1;
  const int m = m0 + tq * 32 + tl;
  unsigned* L = (unsigned*)smem;
  __syncthreads();
  {
    const u16* Kb = (const u16*)(ws + (half ? W_K2B : W_K1B));
    const u16* pq = (const u16*)(ws + W_PQ) + (size_t)m * 2048 + hd * 256 + half * 128;
    f32x16 acc[4];
#pragma unroll
    for (int kt = 0; kt < 4; ++kt)
#pragma unroll
      for (int r = 0; r < 16; ++r) acc[kt][r] = 0.f;
#pragma unroll
    for (int kk = 0; kk < 8; ++kk) {
      const bf16x8 bqv = *(const bf16x8*)(pq + kk * 16 + h * 8);
#pragma unroll
      for (int kt = 0; kt < 4; ++kt) {
        const bf16x8 ak = *(const bf16x8*)(Kb + (size_t)(kt * 32 + tl) * 128 + kk * 16 + h * 8);
        acc[kt] = MFMA32(ak, bqv, acc[kt]);
      }
    }
    unsigned top[16], tmp[16];
#pragma unroll
    for (int r = 0; r < 16; ++r) top[r] = (f2ord(acc[0][r]) & ~127u) | (unsigned)(127 - (0 * 32 + crow(r, h)));
    sort16_desc(top);
#pragma unroll
    for (int kt = 1; kt < 4; ++kt) {
#pragma unroll
      for (int r = 0; r < 16; ++r) tmp[r] = (f2ord(acc[kt][r]) & ~127u) | (unsigned)(127 - (kt * 32 + crow(r, h)));
      sort16_desc(tmp);
      merge_top16(top, tmp);
    }
#pragma unroll
    for (int i = 0; i < 16; ++i) tmp[i] = __shfl_xor(top[i], 32);
    merge_top16(top, tmp);
    if (h == 0) {
      uint4* dst = (uint4*)(L + (half * 64 + tq * 32 + tl) * 16);
      dst[0] = make_uint4(top[0], top[1], top[2], top[3]);
      dst[1] = make_uint4(top[4], top[5], top[6], top[7]);
      dst[2] = make_uint4(top[8], top[9], top[10], top[11]);
      dst[3] = make_uint4(top[12], top[13], top[14], top[15]);
    }
  }
  __syncthreads();
  if (tid < 64) {
    constexpr CandTab CT = make_tab();
    const int tok = tid;
    unsigned l1[16], l2[16];
    {
      const uint4* s1 = (const uint4*)(L + tok * 16);
      const uint4* s2 = (const uint4*)(L + (64 + tok) * 16);
#pragma unroll
      for (int q = 0; q < 4; ++q) {
        uint4 a = s1[q], b = s2[q];
        l1[4 * q] = a.x; l1[4 * q + 1] = a.y; l1[4 * q + 2] = a.z; l1[4 * q + 3] = a.w;
        l2[4 * q] = b.x; l2[4 * q + 1] = b.y; l2[4 * q + 2] = b.z; l2[4 * q + 3] = b.w;
      }
    }
    float f1[16], f2[16];
#pragma unroll
    for (int i = 0; i < 16; ++i) { f1[i] = ord2f(l1[i] & ~127u); f2[i] = ord2f(l2[i] & ~127u); }
    unsigned top[16], tmp[16];
#pragma unroll
    for (int grp = 0; grp < 4; ++grp) {
#pragma unroll
      for (int q = 0; q < 16; ++q) {
        const int cidx = grp * 16 + q;
        unsigned key = 0;
        if (cidx < CT.n) {
          const int ci = CT.i[cidx], cj = CT.j[cidx];
          key = (f2ord(f1[ci] + f2[cj]) & ~255u) | (unsigned)(255 - (ci * 16 + cj));
        }
        if (grp == 0) top[q] = key; else tmp[q] = key;
      }
      if (grp == 0) sort16_desc(top);
      else { sort16_desc(tmp); merge_top16(top, tmp); }
    }
    float sv[16]; int ex[16];
    float smax = -INFINITY;
#pragma unroll
    for (int q = 0; q < 16; ++q) {
      const int code = 255 - (int)(top[q] & 255u);
      const int ci = code >> 4, cj = code & 15;
      const unsigned a = L[tok * 16 + ci], bb = L[(64 + tok) * 16 + cj];
      const int i1 = 127 - (int)(a & 127u), i2 = 127 - (int)(bb & 127u);
      sv[q] = ord2f(a & ~127u) + ord2f(bb & ~127u);
      ex[q] = i1 * 128 + i2;
      smax = fmaxf(smax, sv[q]);
    }
    float sum = 0.f;
#pragma unroll
    for (int q = 0; q < 16; ++q) { sv[q] = __expf(sv[q] - smax); sum += sv[q]; }
    const float inv = 1.0f / sum;
    const int mm = m0 + tok;
    int4* di = (int4*)((int*)(ws + W_SIDX) + (size_t)mm * 128 + hd * 16);
    float4* dg = (float4*)((float*)(ws + W_SGATE) + (size_t)mm * 128 + hd * 16);
#pragma unroll
    for (int q = 0; q < 4; ++q) {
      di[q] = make_int4(ex[4 * q], ex[4 * q + 1], ex[4 * q + 2], ex[4 * q + 3]);
      dg[q] = make_float4(sv[4 * q] * inv, sv[4 * q + 1] * inv, sv[4 * q + 2] * inv, sv[4 * q + 3] * inv);
    }
  }
}

DI void peer_u_phase(const Params& p) {
  char* ws = p.ws;
  const int lane = threadIdx.x & 63, w = threadIdx.x >> 6, g = lane >> 3, li = lane & 7;
  const int v = blockIdx.x & 7, bx = blockIdx.x >> 3, nbx = (gridDim.x - v + 7) >> 3;
  const int gwx = bx * 4 + w, nwx = nbx * 4;
  const char* Us = ws + W_UB + (size_t)v * 16384 * 128 + li * 16;
  const int* sidx = (const int*)(ws + W_SIDX) + g * 16;
  int4 ix[4];
  u32x4 hq0, hq1;
  int m = gwx;
  if (m < TT) {
#pragma unroll
    for (int q = 0; q < 4; ++q) ix[q] = ((const int4*)(sidx + (size_t)m * 128))[q];
    const u32x4* hp = (const u32x4*)(ws + W_HB + (size_t)m * 2048 + v * 256 + li * 32);
    hq0 = hp[0]; hq1 = hp[1];
  }
  for (; m < TT; m += nwx) {
    const int idx[16] = {ix[0].x, ix[0].y, ix[0].z, ix[0].w, ix[1].x, ix[1].y, ix[1].z, ix[1].w,
                         ix[2].x, ix[2].y, ix[2].z, ix[2].w, ix[3].x, ix[3].y, ix[3].z, ix[3].w};
    u32x4 rows[16];
#pragma unroll
    for (int s2 = 0; s2 < 16; ++s2) rows[s2] = *(const u32x4*)(Us + (size_t)idx[s2] * 128);
    fl2_t hv[8];
    hv[0] = {bf_lo(hq0[0]), bf_hi(hq0[0])}; hv[1] = {bf_lo(hq0[1]), bf_hi(hq0[1])};
    hv[2] = {bf_lo(hq0[2]), bf_hi(hq0[2])}; hv[3] = {bf_lo(hq0[3]), bf_hi(hq0[3])};
    hv[4] = {bf_lo(hq1[0]), bf_hi(hq1[0])}; hv[5] = {bf_lo(hq1[1]), bf_hi(hq1[1])};
    hv[6] = {bf_lo(hq1[2]), bf_hi(hq1[2])}; hv[7] = {bf_lo(hq1[3]), bf_hi(hq1[3])};
    const int mn = m + nwx;
    if (mn < TT) {
#pragma unroll
      for (int q = 0; q < 4; ++q) ix[q] = ((const int4*)(sidx + (size_t)mn * 128))[q];
      const u32x4* hp = (const u32x4*)(ws + W_HB + (size_t)mn * 2048 + v * 256 + li * 32);
      hq0 = hp[0]; hq1 = hp[1];
    }
    float ps[16];
#pragma unroll
    for (int s2 = 0; s2 < 16; ++s2) {
      fl2_t acc = {0.f, 0.f};
#pragma unroll
      for (int d = 0; d < 4; ++d) {
        const fl2_t lo = __builtin_amdgcn_cvt_pk_f32_fp8((int)rows[s2][d], false);
        const fl2_t hi = __builtin_amdgcn_cvt_pk_f32_fp8((int)rows[s2][d], true);
        acc = __builtin_elementwise_fma(lo, hv[2 * d], acc);
        acc = __builtin_elementwise_fma(hi, hv[2 * d + 1], acc);
      }
      ps[s2] = acc.x + acc.y;
    }
#pragma unroll
    for (int st = 0; st < 3; ++st) {
      const int bit = 4 >> st, half = 8 >> st;
      const bool upper = (li & bit) != 0;
#pragma unroll
      for (int i = 0; i < half; ++i) {
        const float send = upper ? ps[i] : ps[i + half];
        const float keep = upper ? ps[i + half] : ps[i];
        ps[i] = keep + __shfl_xor(send, bit);
      }
    }
    const int sl = ((li >> 2) & 1) * 8 + ((li >> 1) & 1) * 4 + (li & 1) * 2;
    *(float2*)((float*)(ws + W_PART) + ((size_t)m * 8 + v) * 128 + g * 16 + sl) = make_float2(ps[0], ps[1]);
  }
}

DI void peer_combine(const Params& p) {
  char* ws = p.ws;
  const size_t gt = (size_t)blockIdx.x * 256 + threadIdx.x, gstride = (size_t)gridDim.x * 256;
  for (size_t i = gt; i < (size_t)TT * 128; i += gstride) {
    const size_t m = i >> 7, sl = i & 127;
    const float* pp = (const float*)(ws + W_PART) + m * 1024 + sl;
    float d = 0.f;
#pragma unroll
    for (int v = 0; v < 8; ++v) d += pp[v * 128];
    const float rs2 = ((const float*)(ws + W_RS2))[m];
    const float gate = ((const float*)(ws + W_SGATE))[i];
    ((float*)(ws + W_WTS))[i] = gelu_(d * rs2 * (1.0f / USCALE)) * gate * (1.0f / VSCALE);
  }
}

DI void peer_v_phase(const Params& p) {
  char* ws = p.ws;
  const int lane = threadIdx.x & 63, w = threadIdx.x >> 6, g = lane >> 3, li = lane & 7;
  const int v = blockIdx.x & 7, bx = blockIdx.x >> 3, nbx = (gridDim.x - v + 7) >> 3;
  const int gwx = bx * 4 + w, nwx = nbx * 4;
  const char* Vs = ws + W_VB + (size_t)v * 16384 * 128 + li * 16;
  const int* sidx = (const int*)(ws + W_SIDX) + g * 16;
  const float* wts = (const float*)(ws + W_WTS) + g * 16;
  int4 ix[4];
  float4 wx[4];
  int m = gwx;
  if (m < TT) {
#pragma unroll
    for (int q = 0; q < 4; ++q) { ix[q] = ((const int4*)(sidx + (size_t)m * 128))[q]; wx[q] = ((const float4*)(wts + (size_t)m * 128))[q]; }
  }
  for (; m < TT; m += nwx) {
    const int idx[16] = {ix[0].x, ix[0].y, ix[0].z, ix[0].w, ix[1].x, ix[1].y, ix[1].z, ix[1].w,
                         ix[2].x, ix[2].y, ix[2].z, ix[2].w, ix[3].x, ix[3].y, ix[3].z, ix[3].w};
    const float wt[16] = {wx[0].x, wx[0].y, wx[0].z, wx[0].w, wx[1].x, wx[1].y, wx[1].z, wx[1].w,
                          wx[2].x, wx[2].y, wx[2].z, wx[2].w, wx[3].x, wx[3].y, wx[3].z, wx[3].w};
    u32x4 rows[16];
#pragma unroll
    for (int s2 = 0; s2 < 16; ++s2) rows[s2] = *(const u32x4*)(Vs + (size_t)idx[s2] * 128);
    const int mn = m + nwx;
    if (mn < TT) {
#pragma unroll
      for (int q = 0; q < 4; ++q) { ix[q] = ((const int4*)(sidx + (size_t)mn * 128))[q]; wx[q] = ((const float4*)(wts + (size_t)mn * 128))[q]; }
    }
    fl2_t acc[8];
#pragma unroll
    for (int q = 0; q < 8; ++q) acc[q] = {0.f, 0.f};
#pragma unroll
    for (int s2 = 0; s2 < 16; ++s2) {
      const fl2_t ww = {wt[s2], wt[s2]};
#pragma unroll
      for (int d = 0; d < 4; ++d) {
        const fl2_t lo = __builtin_amdgcn_cvt_pk_f32_fp8((int)rows[s2][d], false);
        const fl2_t hi = __builtin_amdgcn_cvt_pk_f32_fp8((int)rows[s2][d], true);
        acc[2 * d] = __builtin_elementwise_fma(lo, ww, acc[2 * d]);
        acc[2 * d + 1] = __builtin_elementwise_fma(hi, ww, acc[2 * d + 1]);
      }
    }
    float ps[16];
#pragma unroll
    for (int q = 0; q < 8; ++q) { ps[2 * q] = acc[q].x; ps[2 * q + 1] = acc[q].y; }
#pragma unroll
    for (int st = 0; st < 3; ++st) {
      const int bit = 32 >> st, half = 8 >> st;
      const bool upper = (lane & bit) != 0;
#pragma unroll
      for (int i = 0; i < half; ++i) {
        const float send = upper ? ps[i] : ps[i + half];
        const float keep = upper ? ps[i + half] : ps[i];
        ps[i] = keep + __shfl_xor(send, bit);
      }
    }
    const int cl = ((g >> 2) & 1) * 8 + ((g >> 1) & 1) * 4 + (g & 1) * 2;
    float2* yp = (float2*)(p.out + O_Y + (size_t)m * 1024 + v * 128 + li * 16 + cl);
    float2 yv = *yp;
    yv.x += ps[0]; yv.y += ps[1];
    *yp = yv;
  }
}

#define XB_TMO      128
#define XB_XCNT(j)  (256  + 64 * (j))
#define XB_XSUB(j)  (1280 + 64 * (j))
#define XB_XGEN(j)  (2304 + 64 * (j))
#define XB_TOP      3328
#define XB_TOPGEN   3392
#define XCD_BAR_WORDS 3456
#define XB_SPIN_CAP (1u << 18)
#define LAS __attribute__((address_space(3)))
DI unsigned xb_ld(unsigned* p) { return __hip_atomic_load(p, __ATOMIC_RELAXED, __HIP_MEMORY_SCOPE_AGENT); }
DI unsigned xb_add(unsigned* p, unsigned v) { return __hip_atomic_fetch_add(p, v, __ATOMIC_RELAXED, __HIP_MEMORY_SCOPE_AGENT); }
DI unsigned xb_xcc_id() { return (unsigned)__builtin_amdgcn_s_getreg((3 << 11) | 20) & 0xFu; }
#define XB_SPIN(cond, bar) do { unsigned _sp = 0; while (cond) { __builtin_amdgcn_s_sleep(1); \
    if ((++_sp & 255u) == 0u) { if (xb_ld(&(bar)[XB_TMO])) break; if (_sp > XB_SPIN_CAP) { atomicAdd(&(bar)[XB_TMO], 1u); break; } } } } while (0)
struct XcdBarrier { unsigned* bar; unsigned x; volatile LAS unsigned* st; };
DI XcdBarrier xcd_barrier_post(unsigned* bar, volatile LAS unsigned* st) {
  XcdBarrier b; b.bar = bar; b.x = xb_xcc_id(); b.st = st;
  if (threadIdx.x == 0) (void)xb_add(&bar[XB_XCNT(b.x)], 1u);
  return b;
}
DI void xcd_barrier_complete(unsigned* bar, unsigned x, unsigned& nloc, unsigned& nx) {
  const unsigned G = gridDim.x * gridDim.y * gridDim.z;
  unsigned sum, cnt, mine, sp = 0u;
  for (;;) {
    sum = 0u; cnt = 0u; mine = 0u;
#pragma unroll
    for (unsigned j = 0; j < 16; ++j) { const unsigned c = xb_ld(&bar[XB_XCNT(j)]); sum += c; cnt += (c > 0u) ? 1u : 0u; mine = (j == x) ? c : mine; }
    if (sum == G) break;
    __builtin_amdgcn_s_sleep(1);
    if ((++sp & 255u) == 0u) { if (xb_ld(&bar[XB_TMO])) break; if (sp > XB_SPIN_CAP) { atomicAdd(&bar[XB_TMO], 1u); break; } }
  }
  nloc = mine > 0u ? mine : 1u; nx = cnt > 0u ? cnt : 1u;
}
DI void xcd_barrier(const XcdBarrier& b) {
  asm volatile("s_waitcnt vmcnt(0)" ::: "memory");
  __syncthreads();
  if (threadIdx.x == 0) {
    unsigned* bar = b.bar;
    __builtin_amdgcn_s_waitcnt(0);
    unsigned nloc = b.st[0], nx = b.st[1];
    if (nloc == 0u) { xcd_barrier_complete(bar, b.x, nloc, nx); b.st[0] = nloc; b.st[1] = nx; }
    const unsigned old = xb_add(&bar[XB_XSUB(b.x)], 1u);
    const unsigned gen = old / nloc;
    if (old + 1u == (gen + 1u) * nloc) {
      __builtin_amdgcn_fence(__ATOMIC_RELEASE, "agent");
      asm volatile("s_waitcnt vmcnt(0)" ::: "memory");
      const unsigned og = xb_add(&bar[XB_TOP], 1u);
      const unsigned tg = og / nx;
      if (og + 1u == (tg + 1u) * nx) xb_add(&bar[XB_TOPGEN], 1u);
      else XB_SPIN(xb_ld(&bar[XB_TOPGEN]) == tg, bar);
      __builtin_amdgcn_fence(__ATOMIC_ACQUIRE, "agent");
      xb_add(&bar[XB_XGEN(b.x)], 1u);
      asm volatile("s_waitcnt vmcnt(0)" ::: "memory");
    } else {
      XB_SPIN(xb_ld(&bar[XB_XGEN(b.x)]) == gen, bar);
      __builtin_amdgcn_fence(__ATOMIC_ACQUIRE, "agent");
      asm volatile("s_waitcnt vmcnt(0)" ::: "memory");
    }
  }
  __syncthreads();
}

__global__ void __launch_bounds__(256, 2) hymba_mega(Params p) {
  __shared__ __attribute__((aligned(16))) char smem[36864];
  __shared__ uint4 xb_words;
  cg::grid_group grid = cg::this_grid();
  const int nb = gridDim.x, bid = blockIdx.x;
  if (threadIdx.x == 0) xb_words = make_uint4(0u, 0u, 0u, 0u);
  __syncthreads();
  XcdBarrier xb = xcd_barrier_post((unsigned*)(p.ws + W_BAR), (volatile LAS unsigned*)&xb_words);
  if (p.out == nullptr) grid.sync();
  phase0(p, smem);
  xcd_barrier(xb);
  for (int t = bid; t < 130 * 14; t += nb) gemm_tile<1>(p, t / 14, t % 14, smem);
  xcd_barrier(xb);
  for (int it = bid; it < 512; it += nb) lru_item<0>(p, it, smem);
  xcd_barrier(xb);
  for (int it = bid; it < 528 + 544; it += nb) {
    if (it < 528) lru_item<1>(p, it, smem);
    else attn_item(p, it - 528, smem);
  }
  xcd_barrier(xb);
  for (int t = bid; t < 130 * 8; t += nb) gemm_tile<2>(p, t >> 3, t & 7, smem);
  xcd_barrier(xb);
  for (int t = bid; t < 130 * 16; t += nb) gemm_tile<3>(p, t >> 4, t & 15, smem);
  xcd_barrier(xb);
  for (int it = bid; it < 260 * 8; it += nb) route_item(p, it, smem);
  xcd_barrier(xb);
  peer_u_phase(p);
  xcd_barrier(xb);
  peer_combine(p);
  xcd_barrier(xb);
  peer_v_phase(p);
}

extern "C" void kernel_launch(void* const* d_in, const int* in_sizes, int n_in, void* d_out, int out_size, void* d_ws,
                              size_t ws_size, hipStream_t stream) {
  static int grid_blocks = 0;
  if (!grid_blocks) {
    int dev = 0, cus = 0, per_cu = 0;
    (void)hipGetDevice(&dev);
    (void)hipDeviceGetAttribute(&cus, hipDeviceAttributeMultiprocessorCount, dev);
    (void)hipOccupancyMaxActiveBlocksPerMultiprocessor(&per_cu, hymba_mega, 256, 0);
    if (per_cu > 2) per_cu = 2;
    if (per_cu < 1) per_cu = 1;
    grid_blocks = cus * per_cu;
  }
  if (ws_size < W_END) fprintf(stderr, "workspace too small: %zu < %zu\n", ws_size, (size_t)W_END);
  Params p{};
  const float** pp = (const float**)&p;
  for (int i = 0; i < 27; ++i) pp[i] = (const float*)d_in[i];
  p.out = (float*)d_out;
  p.ws = (char*)d_ws;
  (void)hipMemsetAsync((char*)d_ws + W_BAR, 0, XCD_BAR_WORDS * 4, stream);
  void* args[] = {&p};
  hipError_t e = hipLaunchCooperativeKernel((void*)hymba_mega, dim3(grid_blocks), dim3(256), args, 0, stream);
  if (e != hipSuccess) fprintf(stderr, "cooperative launch failed: %s (grid %d)\n", hipGetErrorString(e), grid_blocks);
}
```

```cpp
#include <hip/hip_runtime.h>
#include <hip/hip_cooperative_groups.h>
#include <cstdio>
namespace cg = cooperative_groups;

#define DI __device__ __forceinline__
typedef __bf16 bf2_t __attribute__((ext_vector_type(2)));
typedef float fl2_t __attribute__((ext_vector_type(2)));
typedef short bf16x8 __attribute__((ext_vector_type(8)));
typedef float f32x16 __attribute__((ext_vector_type(16)));
typedef unsigned short u16;
typedef unsigned u32x4 __attribute__((ext_vector_type(4)));
#define MFMA32(a, b, c) __builtin_amdgcn_mfma_f32_32x32x16_bf16((a), (b), (c), 0, 0, 0)

constexpr int TP = 16384, TS = 256, TT = 16640;
constexpr float EPS = 1e-6f;
constexpr float USCALE = 512.0f, VSCALE = 64.0f;

constexpr size_t O_Y = 0;
constexpr size_t O_KP = 17039360, O_VP = 17170432, O_CONVP = 17301504, O_LRUP = 17313792;
constexpr size_t O_KS = 17317888, O_VS = 17580032, O_CONVS = 17842176, O_LRUS = 17866752;

constexpr size_t al(size_t x) { return (x + 255) & ~size_t(255); }
constexpr size_t W_WTIN = 0;
constexpr size_t W_WTOUT = W_WTIN + al(1792ull * 1024 * 2);
constexpr size_t W_WTQ = W_WTOUT + al(1024ull * 1024 * 2);
constexpr size_t W_K1B = W_WTQ + al(2048ull * 1024 * 2);
constexpr size_t W_K2B = W_K1B + al(128 * 128 * 2);
constexpr size_t W_WAT = W_K2B + al(128 * 128 * 2);
constexpr size_t W_WIT = W_WAT + al(8 * 64 * 64 * 2);
constexpr size_t W_C8 = W_WIT + al(8 * 64 * 64 * 2);
constexpr size_t W_UB = W_C8 + al(512 * 4);
constexpr size_t W_VB = W_UB + al(16384ull * 1024 * 2);
constexpr size_t W_RB = W_VB + al(16384ull * 1024 * 2);
constexpr size_t W_XB = W_RB;
constexpr size_t W_CAT = W_RB;
constexpr size_t W_SIDX = W_RB;
constexpr size_t W_SGATE = W_RB + al(TT * 128ull * 4);
constexpr size_t W_RC = W_RB + al(TT * 1024ull * 2);
constexpr size_t W_U = W_RC;
constexpr size_t W_GG = W_RC + TT * 512ull * 2;
constexpr size_t W_HB = W_RC;
constexpr size_t W_Q = W_RC + al(TT * 1024ull * 2);
constexpr size_t W_KP = W_Q + al(TT * 512ull * 2);
constexpr size_t W_KS = W_KP + al(TP * 128ull * 2);
constexpr size_t W_VTP = W_KS + al(16 * 192 * 128 * 2);
constexpr size_t W_VTS = W_VTP + al(8 * 128 * 2048ull * 2);
constexpr size_t W_SUMA = W_VTS + al(16 * 128 * 192 * 2);
constexpr size_t W_SUMH = W_SUMA + al(512 * 512 * 4);
constexpr size_t W_RS1 = W_SUMH + al(512 * 512 * 4);
constexpr size_t W_SSQL = W_RS1 + al(TT * 4);
constexpr size_t W_SSQA = W_SSQL + al(TT * 4 * 4);
constexpr size_t W_SSQ2 = W_SSQA + al(TT * 8 * 4);
constexpr size_t W_PQ = W_SSQ2 + al(TT * 16 * 4);
constexpr size_t W_PART = W_PQ;
constexpr size_t W_WTS = W_SGATE + al(TT * 128ull * 4);
constexpr size_t W_RS2 = W_PQ + al(TT * 2048ull * 2);
constexpr size_t W_BAR = W_RS2 + al(TT * 4);
constexpr size_t W_END = W_BAR + al(3456 * 4);

struct Params {
  const float *x_p, *x_s, *cache_k, *cache_v, *state_conv, *state_lru, *ln1_g, *w_in, *conv_w, *conv_b,
      *lru_wa, *lru_ba, *lru_wi, *lru_bi, *lru_lambda, *q_g, *k_g, *sinks, *g_lru, *g_attn, *w_out, *ln2_g,
      *w_query, *sk1, *sk2, *peer_u, *peer_v;
  float* out;
  char* ws;
};

DI unsigned pk2(float a, float b) {
  fl2_t f = {a, b};
  return __builtin_bit_cast(unsigned, __builtin_convertvector(f, bf2_t));
}
DI float bf_lo(unsigned u) { return __uint_as_float(u << 16); }
DI float bf_hi(unsigned u) { return __uint_as_float(u & 0xffff0000u); }
DI float bf1(u16 v) { return __uint_as_float(((unsigned)v) << 16); }
DI float sigmoidf_(float x) { return 1.0f / (1.0f + __expf(-x)); }
DI float gelu_(float x) {
  float z = 0.7978845608028654f * (x + 0.044715f * x * x * x);
  return x / (1.0f + __expf(-2.0f * z));
}
DI int crow(int r, int h) { return (r & 3) + 8 * (r >> 2) + 4 * h; }

DI void transpose_tile(const float* __restrict__ src, int ld_src, u16* __restrict__ dst, int ld_dst, int k0, int n0,
                       const float* __restrict__ gain, float* tile) {
  const int tid = threadIdx.x;
  const int c = tid & 63, r0 = tid >> 6;
  __syncthreads();
#pragma unroll 4
  for (int rr = 0; rr < 16; ++rr) {
    int r = rr * 4 + r0;
    float v = src[(size_t)(k0 + r) * ld_src + n0 + c];
    if (gain) v *= gain[k0 + r];
    tile[r * 65 + c] = v;
  }
  __syncthreads();
  const int n = tid >> 2, kq = (tid & 3) * 16;
  unsigned pk[8];
#pragma unroll
  for (int i = 0; i < 8; ++i) pk[i] = pk2(tile[(kq + 2 * i) * 65 + n], tile[(kq + 2 * i + 1) * 65 + n]);
  uint4* d = (uint4*)(dst + (size_t)(n0 + n) * ld_dst + k0 + kq);
  d[0] = make_uint4(pk[0], pk[1], pk[2], pk[3]);
  d[1] = make_uint4(pk[4], pk[5], pk[6], pk[7]);
}

DI void phase0(const Params& p, char* smem) {
  const int nb = gridDim.x, bid = blockIdx.x, tid = threadIdx.x;
  char* ws = p.ws;
  float* tile = (float*)smem;
  for (int it = bid; it < 1232; it += nb) {
    if (it < 448) {
      int kt = it / 28, nt = it % 28;
      transpose_tile(p.w_in, 1792, (u16*)(ws + W_WTIN), 1024, kt * 64, nt * 64, p.ln1_g, tile);
    } else if (it < 704) {
      int j = it - 448;
      int kt = j >> 4, nt = j & 15;
      const float* gain = (kt < 8) ? p.g_lru : (p.g_attn - 512);
      transpose_tile(p.w_out, 1024, (u16*)(ws + W_WTOUT), 1024, kt * 64, nt * 64, gain, tile);
    } else if (it < 1216) {
      int j = it - 704;
      int kt = j >> 5, nt = j & 31;
      transpose_tile(p.w_query, 2048, (u16*)(ws + W_WTQ), 1024, kt * 64, nt * 64, p.ln2_g, tile);
    } else {
      int j = it - 1216;
      int n = j & 7;
      if (j < 8) transpose_tile(p.lru_wa + n * 4096, 64, (u16*)(ws + W_WAT) + n * 4096, 64, 0, 0, nullptr, tile);
      else transpose_tile(p.lru_wi + n * 4096, 64, (u16*)(ws + W_WIT) + n * 4096, 64, 0, 0, nullptr, tile);
    }
  }
  const size_t gt = (size_t)bid * 256 + tid, gstride = (size_t)nb * 256;
  {
    for (size_t i = gt; i < 16384ull * 64; i += gstride) {
      const int e = (int)(i >> 6), c16 = (int)(i & 63);
      const float4* su = (const float4*)(p.peer_u + (size_t)e * 1024 + c16 * 16);
      const float4* sv = (const float4*)(p.peer_v + (size_t)e * 1024 + c16 * 16);
      const float4* g2 = (const float4*)(p.ln2_g + c16 * 16);
      u32x4 ou, ov;
#pragma unroll
      for (int q = 0; q < 4; ++q) {
        const float4 a = su[q], g = g2[q], c = sv[q];
        int pu = 0, pv = 0;
        pu = __builtin_amdgcn_cvt_pk_fp8_f32(a.x * g.x * USCALE, a.y * g.y * USCALE, pu, false);
        pu = __builtin_amdgcn_cvt_pk_fp8_f32(a.z * g.z * USCALE, a.w * g.w * USCALE, pu, true);
        pv = __builtin_amdgcn_cvt_pk_fp8_f32(c.x * VSCALE, c.y * VSCALE, pv, false);
        pv = __builtin_amdgcn_cvt_pk_fp8_f32(c.z * VSCALE, c.w * VSCALE, pv, true);
        ou[q] = (unsigned)pu; ov[q] = (unsigned)pv;
      }
      const size_t off = ((size_t)((c16 >> 3) * 16384 + e)) * 128 + (c16 & 7) * 16;
      *(u32x4*)(ws + W_UB + off) = ou;
      *(u32x4*)(ws + W_VB + off) = ov;
    }
  }
  for (size_t i = gt; i < 4096; i += gstride) {
    const float* s = (i < 2048) ? p.sk1 : p.sk2;
    size_t j = (i & 2047);
    const float4* sp = (const float4*)s + j * 2;
    float4 a = sp[0], b = sp[1];
    uint4 o = make_uint4(pk2(a.x, a.y), pk2(a.z, a.w), pk2(b.x, b.y), pk2(b.z, b.w));
    ((uint4*)(ws + ((i < 2048) ? W_K1B : W_K2B)))[j] = o;
  }
  for (size_t i = gt; i < 512; i += gstride) {
    float l = p.lru_lambda[i];
    float sp = (l < -15.f) ? -l : log1pf(expf(-l));
    ((float*)(ws + W_C8))[i] = -8.0f * sp;
  }
  for (size_t i = gt; i < 16 * 128 * 16; i += gstride) {
    int b = (int)(i >> 11), rem = (int)(i & 2047);
    int t = rem >> 4, c8i = rem & 15;
    const float4* sk = (const float4*)(p.cache_k + ((size_t)(b * 128 + t) * 128 + c8i * 8));
    float4 a = sk[0], bb = sk[1];
    uint4 o = make_uint4(pk2(a.x, a.y), pk2(a.z, a.w), pk2(bb.x, bb.y), pk2(bb.z, bb.w));
    *(uint4*)(ws + W_KS + ((size_t)(b * 192 + t) * 128 + c8i * 8) * 2) = o;
    const float4* sv = (const float4*)(p.cache_v + ((size_t)(b * 128 + t) * 128 + c8i * 8));
    float4 va = sv[0], vb = sv[1];
    if (t >= 16) {
      float4* dk = (float4*)(p.out + O_KS + ((size_t)(b * 128 + t - 16) * 128 + c8i * 8));
      dk[0] = a; dk[1] = bb;
      float4* dv = (float4*)(p.out + O_VS + ((size_t)(b * 128 + t - 16) * 128 + c8i * 8));
      dv[0] = va; dv[1] = vb;
    }
    u16* vt = (u16*)(ws + W_VTS) + (size_t)b * 128 * 192;
    float vv[8] = {va.x, va.y, va.z, va.w, vb.x, vb.y, vb.z, vb.w};
#pragma unroll
    for (int q = 0; q < 8; ++q) vt[(size_t)(c8i * 8 + q) * 192 + t] = (u16)(pk2(vv[q], 0.f) & 0xffffu);
  }
  for (size_t i = gt; i < 16 * 48 * 128; i += gstride) {
    int b = (int)(i / (48 * 128)), rem = (int)(i % (48 * 128));
    ((u16*)(ws + W_KS))[(size_t)(b * 192 + 144) * 128 + rem] = 0;
    int ch = rem / 48, tt = rem % 48;
    ((u16*)(ws + W_VTS))[(size_t)(b * 128 + ch) * 192 + 144 + tt] = 0;
  }
  {
    const int lane = tid & 63;
    const int gw = bid * 4 + (tid >> 6), nw = nb * 4;
    for (int m = gw; m < TT; m += nw) {
      const float* xr = (m < TP) ? (p.x_p + (size_t)m * 1024) : (p.x_s + (size_t)(m - TP) * 1024);
      const float4* xp = (const float4*)xr;
      float ss = 0.f;
      uint4* dst = (uint4*)(ws + W_XB + (size_t)m * 2048);
#pragma unroll
      for (int q = 0; q < 2; ++q) {
        float4 a = xp[q * 128 + lane * 2], b = xp[q * 128 + lane * 2 + 1];
        ss += a.x * a.x + a.y * a.y + a.z * a.z + a.w * a.w + b.x * b.x + b.y * b.y + b.z * b.z + b.w * b.w;
        dst[q * 64 + lane] = make_uint4(pk2(a.x, a.y), pk2(a.z, a.w), pk2(b.x, b.y), pk2(b.z, b.w));
      }
#pragma unroll
      for (int s = 32; s >= 1; s >>= 1) ss += __shfl_xor(ss, s);
      if (lane == 0) ((float*)(ws + W_RS1))[m] = rsqrtf(ss * (1.0f / 1024.0f) + EPS);
    }
  }
}

template <int MODE>
DI void gemm_tile(const Params& p, int mt, int nt, char* smem) {
  constexpr int LROW = 144;
  char* ws = p.ws;
  const char* Wt = ws + (MODE == 1 ? W_WTIN : (MODE == 2 ? W_WTOUT : W_WTQ));
  const char* X = ws + (MODE == 1 ? W_XB : (MODE == 2 ? W_CAT : W_HB));
  char* sW = smem;
  char* sX = smem + 128 * LROW;
  const int tid = threadIdx.x, lane = tid & 63, w = tid >> 6, wn = w & 1, wm = w >> 1;
  const int tl = lane & 31, h = lane >> 5;
  const char* gW = Wt + (size_t)(nt * 128) * 2048;
  const char* gX = X + (size_t)(mt * 128) * 2048;
  u32x4 rW[4], rX[4];
  f32x16 acc[2][2];
#pragma unroll
  for (int i = 0; i < 2; ++i)
#pragma unroll
    for (int j = 0; j < 2; ++j)
#pragma unroll
      for (int r = 0; r < 16; ++r) acc[i][j][r] = 0.f;

  const int m_lane[2] = {mt * 128 + wm * 64 + tl, mt * 128 + wm * 64 + 32 + tl};
  float ratio[2] = {1.f, 1.f}, fscale[2] = {1.f, 1.f};
  if (MODE == 2) {
#pragma unroll
    for (int j = 0; j < 2; ++j) {
      const float4 sl = *(const float4*)(ws + W_SSQL + (size_t)m_lane[j] * 16);
      const float4 sa0 = *(const float4*)(ws + W_SSQA + (size_t)m_lane[j] * 32);
      const float4 sa1 = *(const float4*)(ws + W_SSQA + (size_t)m_lane[j] * 32 + 16);
      float rsl = rsqrtf((sl.x + sl.y + sl.z + sl.w) * (1.0f / 512.0f) + EPS);
      float rsa = rsqrtf((sa0.x + sa0.y + sa0.z + sa0.w + sa1.x + sa1.y + sa1.z + sa1.w) * (1.0f / 512.0f) + EPS);
      ratio[j] = rsl / rsa;
      fscale[j] = rsa;
    }
  } else if (MODE == 1) {
#pragma unroll
    for (int j = 0; j < 2; ++j) fscale[j] = ((const float*)(ws + W_RS1))[m_lane[j]];
  } else {
#pragma unroll
    for (int j = 0; j < 2; ++j) {
      const float4* sp = (const float4*)(ws + W_SSQ2 + (size_t)m_lane[j] * 64);
      float4 a = sp[0], b = sp[1], c = sp[2], d = sp[3];
      float s = a.x + a.y + a.z + a.w + b.x + b.y + b.z + b.w + c.x + c.y + c.z + c.w + d.x + d.y + d.z + d.w;
      fscale[j] = rsqrtf(s * (1.0f / 1024.0f) + EPS);
    }
  }

#pragma unroll
  for (int i = 0; i < 4; ++i) {
    int c = tid + 256 * i, row = c >> 3, kc = c & 7;
    rW[i] = *(const u32x4*)(gW + (size_t)row * 2048 + kc * 16);
    rX[i] = *(const u32x4*)(gX + (size_t)row * 2048 + kc * 16);
  }
  for (int ks = 0; ks < 16; ++ks) {
    __syncthreads();
#pragma unroll
    for (int i = 0; i < 4; ++i) {
      int c = tid + 256 * i, row = c >> 3, kc = c & 7;
      *(u32x4*)(sW + row * LROW + kc * 16) = rW[i];
      *(u32x4*)(sX + row * LROW + kc * 16) = rX[i];
    }
    __syncthreads();
    if (ks + 1 < 16) {
#pragma unroll
      for (int i = 0; i < 4; ++i) {
        int c = tid + 256 * i, row = c >> 3, kc = c & 7;
        rW[i] = *(const u32x4*)(gW + (size_t)row * 2048 + (ks + 1) * 128 + kc * 16);
        rX[i] = *(const u32x4*)(gX + (size_t)row * 2048 + (ks + 1) * 128 + kc * 16);
      }
    }
    if (MODE == 2 && ks == 8) {
#pragma unroll
      for (int i = 0; i < 2; ++i)
#pragma unroll
        for (int j = 0; j < 2; ++j)
#pragma unroll
          for (int r = 0; r < 16; ++r) acc[i][j][r] *= ratio[j];
    }
#pragma unroll
    for (int kk = 0; kk < 4; ++kk) {
      bf16x8 a[2], b[2];
#pragma unroll
      for (int i = 0; i < 2; ++i) a[i] = *(const bf16x8*)(sW + (wn * 64 + i * 32 + tl) * LROW + kk * 32 + h * 16);
#pragma unroll
      for (int j = 0; j < 2; ++j) b[j] = *(const bf16x8*)(sX + (wm * 64 + j * 32 + tl) * LROW + kk * 32 + h * 16);
#pragma unroll
      for (int i = 0; i < 2; ++i)
#pragma unroll
        for (int j = 0; j < 2; ++j) acc[i][j] = MFMA32(a[i], b[j], acc[i][j]);
    }
  }

  const int ncol0 = nt * 128 + wn * 64;
  if (MODE == 1) {
    if (ncol0 < 512) {
#pragma unroll
      for (int j = 0; j < 2; ++j) {
        const int m = m_lane[j];
        float* convdst = nullptr;
        if (m < TP) {
          int t = m & 2047;
          if (t >= 2045) convdst = p.out + O_CONVP + (size_t)((m >> 11) * 3 + (t - 2045)) * 512;
        } else {
          int ms = m - TP, t = ms & 15;
          if (t >= 13) convdst = p.out + O_CONVS + (size_t)((ms >> 4) * 3 + (t - 13)) * 512;
        }
        u16* ub = (u16*)(ws + W_U) + (size_t)m * 512;
#pragma unroll
        for (int i = 0; i < 2; ++i)
#pragma unroll
          for (int g = 0; g < 4; ++g) {
            int n = ncol0 + i * 32 + 8 * g + 4 * h;
            float v0 = acc[i][j][4 * g] * fscale[j], v1 = acc[i][j][4 * g + 1] * fscale[j],
                  v2 = acc[i][j][4 * g + 2] * fscale[j], v3 = acc[i][j][4 * g + 3] * fscale[j];
            *(uint2*)(ub + n) = make_uint2(pk2(v0, v1), pk2(v2, v3));
            if (convdst) *(float4*)(convdst + n) = make_float4(v0, v1, v2, v3);
          }
      }
    } else if (ncol0 < 1024) {
#pragma unroll
      for (int j = 0; j < 2; ++j) {
        u16* gb = (u16*)(ws + W_GG) + (size_t)m_lane[j] * 512;
#pragma unroll
        for (int i = 0; i < 2; ++i)
#pragma unroll
          for (int g = 0; g < 4; ++g) {
            int n = ncol0 - 512 + i * 32 + 8 * g + 4 * h;
            float v0 = gelu_(acc[i][j][4 * g] * fscale[j]), v1 = gelu_(acc[i][j][4 * g + 1] * fscale[j]),
                  v2 = gelu_(acc[i][j][4 * g + 2] * fscale[j]), v3 = gelu_(acc[i][j][4 * g + 3] * fscale[j]);
            *(uint2*)(gb + n) = make_uint2(pk2(v0, v1), pk2(v2, v3));
          }
      }
    } else if (ncol0 < 1664) {
      const bool isq = ncol0 < 1536;
      const float* gain = isq ? p.q_g : p.k_g;
      const float post = isq ? 0.125f : 1.0f;
#pragma unroll
      for (int j = 0; j < 2; ++j) {
        const int m = m_lane[j];
        float ss = 0.f;
#pragma unroll
        for (int i = 0; i < 2; ++i)
#pragma unroll
          for (int r = 0; r < 16; ++r) {
            float v = acc[i][j][r] * fscale[j];
            ss += v * v;
          }
        ss += __shfl_xor(ss, 32);
        const float sc = fscale[j] * rsqrtf(ss * (1.0f / 64.0f) + EPS) * post;
        u16* dst;
        float* fdst = nullptr;
        int nloc0;
        if (isq) {
          nloc0 = ncol0 - 1024;
          dst = (u16*)(ws + W_Q) + (size_t)m * 512 + nloc0;
        } else {
          nloc0 = ncol0 - 1536;
          if (m < TP) {
            dst = (u16*)(ws + W_KP) + (size_t)m * 128 + nloc0;
            int t = m & 2047;
            if (t >= 1920) fdst = p.out + O_KP + (size_t)((m >> 11) * 128 + (t - 1920)) * 128 + nloc0;
          } else {
            int ms = m - TP, b = ms >> 4, t = ms & 15;
            dst = (u16*)(ws + W_KS) + (size_t)(b * 192 + 128 + t) * 128 + nloc0;
            fdst = p.out + O_KS + (size_t)(b * 128 + 112 + t) * 128 + nloc0;
          }
        }
#pragma unroll
        for (int i = 0; i < 2; ++i)
#pragma unroll
          for (int g = 0; g < 4; ++g) {
            int d = i * 32 + 8 * g + 4 * h;
            const float4 gn = *(const float4*)(gain + d);
            float v0 = acc[i][j][4 * g] * sc * gn.x, v1 = acc[i][j][4 * g + 1] * sc * gn.y,
                  v2 = acc[i][j][4 * g + 2] * sc * gn.z, v3 = acc[i][j][4 * g + 3] * sc * gn.w;
            *(uint2*)(dst + d) = make_uint2(pk2(v0, v1), pk2(v2, v3));
            if (fdst) *(float4*)(fdst + d) = make_float4(v0, v1, v2, v3);
          }
      }
    } else {
#pragma unroll
      for (int j = 0; j < 2; ++j) {
        const int m = m_lane[j];
        u16* vt;
        size_t vstride;
        float* fdst = nullptr;
        const int ch0 = ncol0 - 1664;
        if (m < TP) {
          int b = m >> 11, t = m & 2047;
          vt = (u16*)(ws + W_VTP) + (size_t)b * 128 * 2048 + t;
          vstride = 2048;
          if (t >= 1920) fdst = p.out + O_VP + (size_t)(b * 128 + (t - 1920)) * 128;
        } else {
          int ms = m - TP, b = ms >> 4, t = ms & 15;
          vt = (u16*)(ws + W_VTS) + (size_t)b * 128 * 192 + 128 + t;
          vstride = 192;
          fdst = p.out + O_VS + (size_t)(b * 128 + 112 + t) * 128;
        }
#pragma unroll
        for (int i = 0; i < 2; ++i)
#pragma unroll
          for (int g = 0; g < 4; ++g) {
            int ch = ch0 + i * 32 + 8 * g + 4 * h;
            float v0 = acc[i][j][4 * g] * fscale[j], v1 = acc[i][j][4 * g + 1] * fscale[j],
                  v2 = acc[i][j][4 * g + 2] * fscale[j], v3 = acc[i][j][4 * g + 3] * fscale[j];
            unsigned p01 = pk2(v0, v1), p23 = pk2(v2, v3);
            vt[(size_t)(ch + 0) * vstride] = (u16)(p01 & 0xffffu);
            vt[(size_t)(ch + 1) * vstride] = (u16)(p01 >> 16);
            vt[(size_t)(ch + 2) * vstride] = (u16)(p23 & 0xffffu);
            vt[(size_t)(ch + 3) * vstride] = (u16)(p23 >> 16);
            if (fdst) *(float4*)(fdst + ch) = make_float4(v0, v1, v2, v3);
          }
      }
    }
  } else if (MODE == 2) {
#pragma unroll
    for (int j = 0; j < 2; ++j) {
      const int m = m_lane[j];
      const float* xr = (m < TP) ? (p.x_p + (size_t)m * 1024) : (p.x_s + (size_t)(m - TP) * 1024);
      float* yr = p.out + O_Y + (size_t)m * 1024;
      u16* hb = (u16*)(ws + W_HB) + (size_t)m * 1024;
      float ss = 0.f;
#pragma unroll
      for (int i = 0; i < 2; ++i)
#pragma unroll
        for (int g = 0; g < 4; ++g) {
          int n = ncol0 + i * 32 + 8 * g + 4 * h;
          const float4 xv = *(const float4*)(xr + n);
          float v0 = xv.x + acc[i][j][4 * g] * fscale[j], v1 = xv.y + acc[i][j][4 * g + 1] * fscale[j],
                v2 = xv.z + acc[i][j][4 * g + 2] * fscale[j], v3 = xv.w + acc[i][j][4 * g + 3] * fscale[j];
          *(float4*)(yr + n) = make_float4(v0, v1, v2, v3);
          *(uint2*)(hb + n) = make_uint2(pk2(v0, v1), pk2(v2, v3));
          ss += v0 * v0 + v1 * v1 + v2 * v2 + v3 * v3;
        }
      ss += __shfl_xor(ss, 32);
      if (h == 0) ((float*)(ws + W_SSQ2))[(size_t)m * 16 + nt * 2 + wn] = ss;
    }
  } else {
#pragma unroll
    for (int j = 0; j < 2; ++j) {
      if (nt == 0 && wn == 0 && h == 0) ((float*)(ws + W_RS2))[m_lane[j]] = fscale[j];
      u16* pq = (u16*)(ws + W_PQ) + (size_t)m_lane[j] * 2048;
#pragma unroll
      for (int i = 0; i < 2; ++i)
#pragma unroll
        for (int g = 0; g < 4; ++g) {
          int n = ncol0 + i * 32 + 8 * g + 4 * h;
          float v0 = acc[i][j][4 * g] * fscale[j], v1 = acc[i][j][4 * g + 1] * fscale[j],
                v2 = acc[i][j][4 * g + 2] * fscale[j], v3 = acc[i][j][4 * g + 3] * fscale[j];
          *(uint2*)(pq + n) = make_uint2(pk2(v0, v1), pk2(v2, v3));
        }
    }
  }
}

#define SCAN_STEP(CTRL) { \
    const float Ap = __uint_as_float(__builtin_amdgcn_update_dpp(0x3f800000u, __float_as_uint(A), CTRL, 0xF, 0xF, false)); \
    const float Hp = __uint_as_float(__builtin_amdgcn_update_dpp(0u, __float_as_uint(H), CTRL, 0xF, 0xF, false)); \
    H = A * Hp + H; A = A * Ap; }
template <int FINAL>
DI void lru_item(const Params& p, int item, char* smem) {
  char* ws = p.ws;
  const bool samp = item >= 512;
  int b, c, m0, nvalid;
  if (!samp) { b = item >> 6; c = item & 63; m0 = b * 2048 + c * 32; nvalid = 32; }
  else { b = item - 512; c = 0; m0 = TP + b * 16; nvalid = 16; }
  const int tid = threadIdx.x, lane = tid & 63, w = tid >> 6, tl = lane & 31, h = lane >> 5;
  u16* XC = (u16*)smem;
  float* hin = (float*)(smem + 32 * 1040);
  __syncthreads();
  {
    const int ch = 2 * tid;
    const float2 w0 = *(const float2*)(p.conv_w + ch), w1 = *(const float2*)(p.conv_w + 512 + ch),
                 w2 = *(const float2*)(p.conv_w + 1024 + ch), w3 = *(const float2*)(p.conv_w + 1536 + ch),
                 cb = *(const float2*)(p.conv_b + ch);
    float2 r0 = {0.f, 0.f}, r1 = {0.f, 0.f}, r2 = {0.f, 0.f};
    const u16* ub = (const u16*)(ws + W_U);
    if (!samp) {
      if (c > 0) {
        unsigned a0 = *(const unsigned*)(ub + (size_t)(m0 - 3) * 512 + ch), a1 = *(const unsigned*)(ub + (size_t)(m0 - 2) * 512 + ch),
                 a2 = *(const unsigned*)(ub + (size_t)(m0 - 1) * 512 + ch);
        r0 = {bf_lo(a0), bf_hi(a0)}; r1 = {bf_lo(a1), bf_hi(a1)}; r2 = {bf_lo(a2), bf_hi(a2)};
      }
    } else {
      const float* sc = p.state_conv + (size_t)b * 3 * 512 + ch;
      r0 = *(const float2*)(sc); r1 = *(const float2*)(sc + 512); r2 = *(const float2*)(sc + 1024);
    }
    unsigned uraw[32];
#pragma unroll
    for (int t = 0; t < 32; ++t) uraw[t] = (t < nvalid) ? *(const unsigned*)(ub + (size_t)(m0 + t) * 512 + ch) : 0u;
#pragma unroll
    for (int t = 0; t < 32; ++t) {
      float2 cur = {bf_lo(uraw[t]), bf_hi(uraw[t])};
      float x0 = cb.x + w0.x * r0.x + w1.x * r1.x + w2.x * r2.x + w3.x * cur.x;
      float x1 = cb.y + w0.y * r0.y + w1.y * r1.y + w2.y * r2.y + w3.y * cur.y;
      *(unsigned*)(XC + t * 520 + ch) = pk2(x0, x1);
      r0 = r1; r1 = r2; r2 = cur;
    }
    if (FINAL) {
      float2 hh;
      if (samp) hh = *(const float2*)(p.state_lru + (size_t)b * 512 + ch);
      else {
        hh = {0.f, 0.f};
        const float* sA = (const float*)(ws + W_SUMA) + (size_t)(b * 64) * 512 + ch;
        const float* sH = (const float*)(ws + W_SUMH) + (size_t)(b * 64) * 512 + ch;
        int cc = 0;
        for (; cc + 4 <= c; cc += 4) {
          float2 A0 = *(const float2*)(sA + (size_t)(cc + 0) * 512), H0 = *(const float2*)(sH + (size_t)(cc + 0) * 512);
          float2 A1 = *(const float2*)(sA + (size_t)(cc + 1) * 512), H1 = *(const float2*)(sH + (size_t)(cc + 1) * 512);
          float2 A2 = *(const float2*)(sA + (size_t)(cc + 2) * 512), H2 = *(const float2*)(sH + (size_t)(cc + 2) * 512);
          float2 A3 = *(const float2*)(sA + (size_t)(cc + 3) * 512), H3 = *(const float2*)(sH + (size_t)(cc + 3) * 512);
          hh.x = A0.x * hh.x + H0.x; hh.y = A0.y * hh.y + H0.y;
          hh.x = A1.x * hh.x + H1.x; hh.y = A1.y * hh.y + H1.y;
          hh.x = A2.x * hh.x + H2.x; hh.y = A2.y * hh.y + H2.y;
          hh.x = A3.x * hh.x + H3.x; hh.y = A3.y * hh.y + H3.y;
        }
        for (; cc < c; ++cc) {
          float2 A0 = *(const float2*)(sA + (size_t)cc * 512), H0 = *(const float2*)(sH + (size_t)cc * 512);
          hh.x = A0.x * hh.x + H0.x; hh.y = A0.y * hh.y + H0.y;
        }
      }
      hin[ch] = hh.x; hin[ch + 1] = hh.y;
    }
  }
  __syncthreads();
  const u16* WaT = (const u16*)(ws + W_WAT);
  const u16* WiT = (const u16*)(ws + W_WIT);
  const float* c8 = (const float*)(ws + W_C8);
  const int m = m0 + tl;
  const bool valid = tl < nvalid;
  float ssq = 0.f;
#pragma unroll 1
  for (int nbk = 0; nbk < 2; ++nbk) {
    const int n = 2 * w + nbk;
    f32x16 accA[2], accI[2];
#pragma unroll
    for (int i = 0; i < 2; ++i)
#pragma unroll
      for (int r = 0; r < 16; ++r) { accA[i][r] = 0.f; accI[i][r] = 0.f; }
#pragma unroll
    for (int kk = 0; kk < 4; ++kk) {
      const bf16x8 bx = *(const bf16x8*)((const char*)XC + tl * 1040 + (n * 64 + kk * 16 + h * 8) * 2);
#pragma unroll
      for (int i = 0; i < 2; ++i) {
        const bf16x8 aa = *(const bf16x8*)(WaT + (size_t)(n * 64 + i * 32 + tl) * 64 + kk * 16 + h * 8);
        const bf16x8 ai = *(const bf16x8*)(WiT + (size_t)(n * 64 + i * 32 + tl) * 64 + kk * 16 + h * 8);
        accA[i] = MFMA32(aa, bx, accA[i]);
        accI[i] = MFMA32(ai, bx, accI[i]);
      }
    }
#pragma unroll
    for (int i = 0; i < 2; ++i)
#pragma unroll
      for (int g = 0; g < 4; ++g) {
        const int ch = n * 64 + i * 32 + 8 * g + 4 * h;
        const float4 ba4 = *(const float4*)(p.lru_ba + ch), bi4 = *(const float4*)(p.lru_bi + ch), c84 = *(const float4*)(c8 + ch);
        const float bav[4] = {ba4.x, ba4.y, ba4.z, ba4.w}, biv[4] = {bi4.x, bi4.y, bi4.z, bi4.w}, c8v[4] = {c84.x, c84.y, c84.z, c84.w};
        const uint2 xcp = *(const uint2*)(XC + tl * 520 + ch);
        const float xcv[4] = {bf_lo(xcp.x), bf_hi(xcp.x), bf_lo(xcp.y), bf_hi(xcp.y)};
        float hv[4];
#pragma unroll
        for (int q = 0; q < 4; ++q) {
          const int r = 4 * g + q;
          float rr = sigmoidf_(accA[i][r] + bav[q]);
          float ii = sigmoidf_(accI[i][r] + biv[q]);
          float la = c8v[q] * rr;
          float A = __expf(la);
          float x2 = 2.0f * la;
          float em = -x2 * (1.0f + x2 * (0.5f + x2 * (0.16666667f + x2 * (0.041666668f + x2 * (0.0083333333f + x2 * 0.0013888889f)))));
          float H = sqrtf(fmaxf(em, 0.f)) * ii * xcv[q];
          SCAN_STEP(0x111) SCAN_STEP(0x112) SCAN_STEP(0x114) SCAN_STEP(0x118)
          {
            const float Ap = __uint_as_float(__builtin_amdgcn_update_dpp(0x3f800000u, __float_as_uint(A), 0x142, 0xA, 0xF, false));
            const float Hp = __uint_as_float(__builtin_amdgcn_update_dpp(0u, __float_as_uint(H), 0x142, 0xA, 0xF, false));
            H = A * Hp + H; A = A * Ap;
          }
          if (!FINAL) {
            if (tl == 31) {
              ((float*)(ws + W_SUMA))[(size_t)(b * 64 + c) * 512 + ch + q] = A;
              ((float*)(ws + W_SUMH))[(size_t)(b * 64 + c) * 512 + ch + q] = H;
            }
          } else {
            hv[q] = H + A * hin[ch + q];
          }
        }
        if (FINAL) {
          if (tl == nvalid - 1 && (samp || c == 63)) {
            float* dst = p.out + (samp ? O_LRUS : O_LRUP) + (size_t)b * 512 + ch;
            *(float4*)dst = make_float4(hv[0], hv[1], hv[2], hv[3]);
          }
          if (valid) {
            const uint2 gp = *(const uint2*)((const u16*)(ws + W_GG) + (size_t)m * 512 + ch);
            float o0 = hv[0] * bf_lo(gp.x), o1 = hv[1] * bf_hi(gp.x), o2 = hv[2] * bf_lo(gp.y), o3 = hv[3] * bf_hi(gp.y);
            ssq += o0 * o0 + o1 * o1 + o2 * o2 + o3 * o3;
            *(uint2*)((u16*)(ws + W_CAT) + (size_t)m * 1024 + ch) = make_uint2(pk2(o0, o1), pk2(o2, o3));
          }
        }
      }
  }
  if (FINAL) {
    ssq += __shfl_xor(ssq, 32);
    if (valid && h == 0) ((float*)(ws + W_SSQL))[(size_t)m * 4 + w] = ssq;
  }
}

DI void attn_item(const Params& p, int item, char* smem) {
  char* ws = p.ws;
  const int tid = threadIdx.x, lane = tid & 63, w = tid >> 6, tl = lane & 31, h = lane >> 5;
  const bool samp = item >= 512;
  int b, c, g;
  const u16* Kb; const u16* Vt; int vstride, kc_lo, kc_hi, nkeys, mq0; bool qvalid;
  if (!samp) {
    b = item >> 6; c = (item >> 1) & 31; g = item & 1;
    Kb = (const u16*)(ws + W_KP) + (size_t)b * 2048 * 128;
    Vt = (const u16*)(ws + W_VTP) + (size_t)b * 128 * 2048;
    vstride = 2048; kc_lo = (c >= 2) ? c - 2 : 0; kc_hi = c; nkeys = 1 << 30;
    mq0 = b * 2048 + c * 64 + tl; qvalid = true;
  } else {
    int it = item - 512; b = it >> 1; g = it & 1; c = 0;
    Kb = (const u16*)(ws + W_KS) + (size_t)b * 192 * 128;
    Vt = (const u16*)(ws + W_VTS) + (size_t)b * 128 * 192;
    vstride = 192; kc_lo = 0; kc_hi = 2; nkeys = 144;
    mq0 = TP + b * 16 + (tl & 15); qvalid = tl < 16;
  }
  const int hq = g * 4 + w;
  const float sink = p.sinks[hq];
  char* sK = smem;
  char* sV = smem + 192 * 144;
  const int nch = kc_hi - kc_lo + 1;
  const int nj = samp ? 1 : 2;
  bf16x8 bq[2][4];
#pragma unroll
  for (int j = 0; j < 2; ++j)
#pragma unroll
    for (int kk = 0; kk < 4; ++kk)
      bq[j][kk] = *(const bf16x8*)((const u16*)(ws + W_Q) + (size_t)(mq0 + (samp ? 0 : j * 32)) * 512 + hq * 64 + kk * 16 + h * 8);
  __syncthreads();
  {
    u32x4 kr[6], vr[6];
#pragma unroll
    for (int i = 0; i < 6; ++i) {
      const int idx = tid + 256 * i;
      const int key = idx >> 3, part = idx & 7;
      if (key < nch * 64) kr[i] = *(const u32x4*)(Kb + (size_t)(kc_lo * 64 + key) * 128 + g * 64 + part * 8);
      const int d = idx / 24, pv = idx % 24;
      if (pv < nch * 8) vr[i] = *(const u32x4*)(Vt + (size_t)(g * 64 + d) * vstride + kc_lo * 64 + pv * 8);
    }
#pragma unroll
    for (int i = 0; i < 6; ++i) {
      const int idx = tid + 256 * i;
      const int key = idx >> 3, part = idx & 7;
      if (key < nch * 64) *(u32x4*)(sK + key * 144 + part * 16) = kr[i];
      const int d = idx / 24, pv = idx % 24;
      if (pv < nch * 8) *(u32x4*)(sV + d * 400 + pv * 16) = vr[i];
    }
  }
  __syncthreads();
#pragma unroll
  for (int j = 0; j < 2; ++j) {
    if (j < nj) {
    const int mqj = mq0 + j * 32;
    float mrun = sink, lrun = 1.f;
    f32x16 O[2];
#pragma unroll
    for (int i = 0; i < 2; ++i)
#pragma unroll
      for (int r = 0; r < 16; ++r) O[i][r] = 0.f;
#pragma unroll 1
    for (int kc = 0; kc < nch; ++kc) {
      f32x16 S[2];
#pragma unroll
      for (int i = 0; i < 2; ++i)
#pragma unroll
        for (int r = 0; r < 16; ++r) S[i][r] = 0.f;
#pragma unroll
      for (int kk = 0; kk < 4; ++kk)
#pragma unroll
        for (int kt = 0; kt < 2; ++kt) {
          const bf16x8 ak = *(const bf16x8*)(sK + (kc * 64 + kt * 32 + tl) * 144 + kk * 32 + h * 16);
          S[kt] = MFMA32(ak, bq[j][kk], S[kt]);
        }
      if (samp) {
#pragma unroll
        for (int kt = 0; kt < 2; ++kt)
#pragma unroll
          for (int r = 0; r < 16; ++r) {
            int key = kc * 64 + kt * 32 + crow(r, h);
            if (key >= nkeys) S[kt][r] = -INFINITY;
          }
      }
      {
        float mx = -INFINITY;
#pragma unroll
        for (int kt = 0; kt < 2; ++kt)
#pragma unroll
          for (int r = 0; r < 16; ++r) mx = fmaxf(mx, S[kt][r]);
        mx = fmaxf(mx, __shfl_xor(mx, 32));
        const float mnew = fmaxf(mrun, mx);
        const float alpha = __expf(mrun - mnew);
        float ps = 0.f;
#pragma unroll
        for (int kt = 0; kt < 2; ++kt)
#pragma unroll
          for (int r = 0; r < 16; ++r) {
            float pv = __expf(S[kt][r] - mnew);
            S[kt][r] = pv;
            ps += pv;
          }
        ps += __shfl_xor(ps, 32);
        lrun = lrun * alpha + ps;
        mrun = mnew;
#pragma unroll
        for (int dt = 0; dt < 2; ++dt)
#pragma unroll
          for (int r = 0; r < 16; ++r) O[dt][r] *= alpha;
      }
#pragma unroll
      for (int kt = 0; kt < 2; ++kt)
#pragma unroll
        for (int s2 = 0; s2 < 2; ++s2) {
          u32x4 pp;
          pp[0] = pk2(S[kt][8 * s2 + 0], S[kt][8 * s2 + 1]);
          pp[1] = pk2(S[kt][8 * s2 + 2], S[kt][8 * s2 + 3]);
          pp[2] = pk2(S[kt][8 * s2 + 4], S[kt][8 * s2 + 5]);
          pp[3] = pk2(S[kt][8 * s2 + 6], S[kt][8 * s2 + 7]);
          const bf16x8 bp = __builtin_bit_cast(bf16x8, pp);
#pragma unroll
          for (int dt = 0; dt < 2; ++dt) {
            const int d = dt * 32 + tl;
            const uint2 lo = *(const uint2*)(sV + d * 400 + (kc * 64 + kt * 32 + 16 * s2 + 4 * h) * 2);
            const uint2 hi = *(const uint2*)(sV + d * 400 + (kc * 64 + kt * 32 + 16 * s2 + 8 + 4 * h) * 2);
            u32x4 av4;
            av4[0] = lo.x; av4[1] = lo.y; av4[2] = hi.x; av4[3] = hi.y;
            O[dt] = MFMA32(__builtin_bit_cast(bf16x8, av4), bp, O[dt]);
          }
        }
    }
    const float inv = 1.0f / lrun;
    float ss = 0.f;
    u16* dst = (u16*)(ws + W_CAT) + (size_t)mqj * 1024 + 512 + hq * 64;
#pragma unroll
    for (int dt = 0; dt < 2; ++dt)
#pragma unroll
      for (int g4 = 0; g4 < 4; ++g4) {
        int d = dt * 32 + 8 * g4 + 4 * h;
        float v0 = O[dt][4 * g4] * inv, v1 = O[dt][4 * g4 + 1] * inv, v2 = O[dt][4 * g4 + 2] * inv, v3 = O[dt][4 * g4 + 3] * inv;
        ss += v0 * v0 + v1 * v1 + v2 * v2 + v3 * v3;
        if (qvalid) *(uint2*)(dst + d) = make_uint2(pk2(v0, v1), pk2(v2, v3));
      }
    ss += __shfl_xor(ss, 32);
    if (qvalid && h == 0) ((float*)(ws + W_SSQA))[(size_t)mqj * 8 + hq] = ss;
    }
  }
}

DI unsigned f2ord(float f) { unsigned u = __float_as_uint(f); return u ^ ((unsigned)((int)u >> 31) | 0x80000000u); }
DI float ord2f(unsigned u) { return __uint_as_float((u & 0x80000000u) ? (u ^ 0x80000000u) : ~u); }
DI void cas_desc(unsigned& a, unsigned& b) { unsigned mx = a > b ? a : b, mn = a > b ? b : a; a = mx; b = mn; }
DI void sort16_desc(unsigned (&v)[16]) {
#pragma unroll
  for (int k = 2; k <= 16; k <<= 1)
#pragma unroll
    for (int j = k >> 1; j > 0; j >>= 1)
#pragma unroll
      for (int i = 0; i < 16; ++i) {
        int l = i ^ j;
        if (l > i) {
          if ((i & k) == 0) cas_desc(v[i], v[l]); else cas_desc(v[l], v[i]);
        }
      }
}
DI void merge16_desc(unsigned (&v)[16]) {
#pragma unroll
  for (int j = 8; j > 0; j >>= 1)
#pragma unroll
    for (int i = 0; i < 16; ++i) {
      int l = i ^ j;
      if (l > i) cas_desc(v[i], v[l]);
    }
}
DI void merge_top16(unsigned (&a)[16], unsigned (&b)[16]) {
#pragma unroll
  for (int i = 0; i < 16; ++i) a[i] = a[i] > b[15 - i] ? a[i] : b[15 - i];
  merge16_desc(a);
}

struct CandTab { int i[64]; int j[64]; int n; };
constexpr CandTab make_tab() {
  CandTab t{};
  int n = 0;
  for (int i = 0; i < 16; ++i)
    for (int j = 0; j < 16; ++j)
      if ((i + 1) * (j + 1) <= 16) { t.i[n] = i; t.j[n] = j; ++n; }
  t.n = n;
  return t;
}

DI void route_item(const Params& p, int item, char* smem) {
  char* ws = p.ws;
  const int tid = threadIdx.x, lane = tid & 63, w = tid >> 6, tl = lane & 31, h = lane >> 5;
  const int tt = item >> 3, hd = item & 7;
  const int m0 = tt * 64;
  const int half = w >> 1, tq = w & 1;
  const int m = m0 + tq * 32 + tl;
  unsigned* L = (unsigned*)smem;
  __syncthreads();
  {
    const u16* Kb = (const u16*)(ws + (half ? W_K2B : W_K1B));
    const u16* pq = (const u16*)(ws + W_PQ) + (size_t)m * 2048 + hd * 256 + half * 128;
    f32x16 acc[4];
#pragma unroll
    for (int kt = 0; kt < 4; ++kt)
#pragma unroll
      for (int r = 0; r < 16; ++r) acc[kt][r] = 0.f;
#pragma unroll 2
    for (int kk = 0; kk < 8; ++kk) {
      const bf16x8 bqv = *(const bf16x8*)(pq + kk * 16 + h * 8);
#pragma unroll
      for (int kt = 0; kt < 4; ++kt) {
        const bf16x8 ak = *(const bf16x8*)(Kb + (size_t)(kt * 32 + tl) * 128 + kk * 16 + h * 8);
        acc[kt] = MFMA32(ak, bqv, acc[kt]);
      }
    }
    unsigned top[16], tmp[16];
#pragma unroll
    for (int r = 0; r < 16; ++r) top[r] = (f2ord(acc[0][r]) & ~127u) | (unsigned)(127 - (0 * 32 + crow(r, h)));
    sort16_desc(top);
#pragma unroll
    for (int kt = 1; kt < 4; ++kt) {
#pragma unroll
      for (int r = 0; r < 16; ++r) tmp[r] = (f2ord(acc[kt][r]) & ~127u) | (unsigned)(127 - (kt * 32 + crow(r, h)));
      sort16_desc(tmp);
      merge_top16(top, tmp);
    }
#pragma unroll
    for (int i = 0; i < 16; ++i) tmp[i] = __shfl_xor(top[i], 32);
    merge_top16(top, tmp);
    if (h == 0) {
      uint4* dst = (uint4*)(L + (half * 64 + tq * 32 + tl) * 16);
      dst[0] = make_uint4(top[0], top[1], top[2], top[3]);
      dst[1] = make_uint4(top[4], top[5], top[6], top[7]);
      dst[2] = make_uint4(top[8], top[9], top[10], top[11]);
      dst[3] = make_uint4(top[12], top[13], top[14], top[15]);
    }
  }
  __syncthreads();
  if (tid < 64) {
    constexpr CandTab CT = make_tab();
    const int tok = tid;
    unsigned l1[16], l2[16];
    {
      const uint4* s1 = (const uint4*)(L + tok * 16);
      const uint4* s2 = (const uint4*)(L + (64 + tok) * 16);
#pragma unroll
      for (int q = 0; q < 4; ++q) {
        uint4 a = s1[q], b = s2[q];
        l1[4 * q] = a.x; l1[4 * q + 1] = a.y; l1[4 * q + 2] = a.z; l1[4 * q + 3] = a.w;
        l2[4 * q] = b.x; l2[4 * q + 1] = b.y; l2[4 * q + 2] = b.z; l2[4 * q + 3] = b.w;
      }
    }
    float f1[16], f2[16];
#pragma unroll
    for (int i = 0; i < 16; ++i) { f1[i] = ord2f(l1[i] & ~127u); f2[i] = ord2f(l2[i] & ~127u); }
    unsigned top[16], tmp[16];
#pragma unroll
    for (int grp = 0; grp < 4; ++grp) {
#pragma unroll
      for (int q = 0; q < 16; ++q) {
        const int cidx = grp * 16 + q;
        unsigned key = 0;
        if (cidx < CT.n) {
          const int ci = CT.i[cidx], cj = CT.j[cidx];
          key = (f2ord(f1[ci] + f2[cj]) & ~255u) | (unsigned)(255 - (ci * 16 + cj));
        }
        if (grp == 0) top[q] = key; else tmp[q] = key;
      }
      if (grp == 0) sort16_desc(top);
      else { sort16_desc(tmp); merge_top16(top, tmp); }
    }
    float sv[16]; int ex[16];
    float smax = -INFINITY;
#pragma unroll
    for (int q = 0; q < 16; ++q) {
      const int code = 255 - (int)(top[q] & 255u);
      const int ci = code >> 4, cj = code & 15;
      const unsigned a = L[tok * 16 + ci], bb = L[(64 + tok) * 16 + cj];
      const int i1 = 127 - (int)(a & 127u), i2 = 127 - (int)(bb & 127u);
      sv[q] = ord2f(a & ~127u) + ord2f(bb & ~127u);
      ex[q] = i1 * 128 + i2;
      smax = fmaxf(smax, sv[q]);
    }
    float sum = 0.f;
#pragma unroll
    for (int q = 0; q < 16; ++q) { sv[q] = __expf(sv[q] - smax); sum += sv[q]; }
    const float inv = 1.0f / sum;
    const int mm = m0 + tok;
    int4* di = (int4*)((int*)(ws + W_SIDX) + (size_t)mm * 128 + hd * 16);
    float4* dg = (float4*)((float*)(ws + W_SGATE) + (size_t)mm * 128 + hd * 16);
#pragma unroll
    for (int q = 0; q < 4; ++q) {
      di[q] = make_int4(ex[4 * q], ex[4 * q + 1], ex[4 * q + 2], ex[4 * q + 3]);
      dg[q] = make_float4(sv[4 * q] * inv, sv[4 * q + 1] * inv, sv[4 * q + 2] * inv, sv[4 * q + 3] * inv);
    }
  }
}

DI void peer_u_phase(const Params& p) {
  char* ws = p.ws;
  const int lane = threadIdx.x & 63, w = threadIdx.x >> 6, g = lane >> 3, li = lane & 7;
  const int v = blockIdx.x & 7, bx = blockIdx.x >> 3, nbx = (gridDim.x - v + 7) >> 3;
  const int gwx = bx * 4 + w, nwx = nbx * 4;
  const char* Us = ws + W_UB + (size_t)v * 16384 * 128 + li * 16;
  const int* sidx = (const int*)(ws + W_SIDX) + g * 16;
  int4 ix[4];
  u32x4 hq0, hq1;
  int m = gwx;
  if (m < TT) {
#pragma unroll
    for (int q = 0; q < 4; ++q) ix[q] = ((const int4*)(sidx + (size_t)m * 128))[q];
    const u32x4* hp = (const u32x4*)(ws + W_HB + (size_t)m * 2048 + v * 256 + li * 32);
    hq0 = hp[0]; hq1 = hp[1];
  }
  for (; m < TT; m += nwx) {
    const int idx[16] = {ix[0].x, ix[0].y, ix[0].z, ix[0].w, ix[1].x, ix[1].y, ix[1].z, ix[1].w,
                         ix[2].x, ix[2].y, ix[2].z, ix[2].w, ix[3].x, ix[3].y, ix[3].z, ix[3].w};
    u32x4 rows[16];
#pragma unroll
    for (int s2 = 0; s2 < 16; ++s2) rows[s2] = *(const u32x4*)(Us + (size_t)idx[s2] * 128);
    fl2_t hv[8];
    hv[0] = {bf_lo(hq0[0]), bf_hi(hq0[0])}; hv[1] = {bf_lo(hq0[1]), bf_hi(hq0[1])};
    hv[2] = {bf_lo(hq0[2]), bf_hi(hq0[2])}; hv[3] = {bf_lo(hq0[3]), bf_hi(hq0[3])};
    hv[4] = {bf_lo(hq1[0]), bf_hi(hq1[0])}; hv[5] = {bf_lo(hq1[1]), bf_hi(hq1[1])};
    hv[6] = {bf_lo(hq1[2]), bf_hi(hq1[2])}; hv[7] = {bf_lo(hq1[3]), bf_hi(hq1[3])};
    const int mn = m + nwx;
    if (mn < TT) {
#pragma unroll
      for (int q = 0; q < 4; ++q) ix[q] = ((const int4*)(sidx + (size_t)mn * 128))[q];
      const u32x4* hp = (const u32x4*)(ws + W_HB + (size_t)mn * 2048 + v * 256 + li * 32);
      hq0 = hp[0]; hq1 = hp[1];
    }
    float ps[16];
#pragma unroll
    for (int s2 = 0; s2 < 16; ++s2) {
      fl2_t acc = {0.f, 0.f};
#pragma unroll
      for (int d = 0; d < 4; ++d) {
        const fl2_t lo = __builtin_amdgcn_cvt_pk_f32_fp8((int)rows[s2][d], false);
        const fl2_t hi = __builtin_amdgcn_cvt_pk_f32_fp8((int)rows[s2][d], true);
        acc = __builtin_elementwise_fma(lo, hv[2 * d], acc);
        acc = __builtin_elementwise_fma(hi, hv[2 * d + 1], acc);
      }
      ps[s2] = acc.x + acc.y;
    }
#pragma unroll
    for (int st = 0; st < 3; ++st) {
      const int bit = 4 >> st, half = 8 >> st;
      const bool upper = (li & bit) != 0;
#pragma unroll
      for (int i = 0; i < half; ++i) {
        const float send = upper ? ps[i] : ps[i + half];
        const float keep = upper ? ps[i + half] : ps[i];
        ps[i] = keep + __shfl_xor(send, bit);
      }
    }
    const int sl = ((li >> 2) & 1) * 8 + ((li >> 1) & 1) * 4 + (li & 1) * 2;
    *(float2*)((float*)(ws + W_PART) + ((size_t)m * 8 + v) * 128 + g * 16 + sl) = make_float2(ps[0], ps[1]);
  }
}

DI void peer_combine(const Params& p) {
  char* ws = p.ws;
  const size_t gt = (size_t)blockIdx.x * 256 + threadIdx.x, gstride = (size_t)gridDim.x * 256;
  for (size_t i = gt; i < (size_t)TT * 128; i += gstride) {
    const size_t m = i >> 7, sl = i & 127;
    const float* pp = (const float*)(ws + W_PART) + m * 1024 + sl;
    float d = 0.f;
#pragma unroll
    for (int v = 0; v < 8; ++v) d += pp[v * 128];
    const float rs2 = ((const float*)(ws + W_RS2))[m];
    const float gate = ((const float*)(ws + W_SGATE))[i];
    ((float*)(ws + W_WTS))[i] = gelu_(d * rs2 * (1.0f / USCALE)) * gate * (1.0f / VSCALE);
  }
}

DI void peer_v_phase(const Params& p) {
  char* ws = p.ws;
  const int lane = threadIdx.x & 63, w = threadIdx.x >> 6, g = lane >> 3, li = lane & 7;
  const int v = blockIdx.x & 7, bx = blockIdx.x >> 3, nbx = (gridDim.x - v + 7) >> 3;
  const int gwx = bx * 4 + w, nwx = nbx * 4;
  const char* Vs = ws + W_VB + (size_t)v * 16384 * 128 + li * 16;
  const int* sidx = (const int*)(ws + W_SIDX) + g * 16;
  const float* wts = (const float*)(ws + W_WTS) + g * 16;
  int4 ix[4];
  float4 wx[4];
  int m = gwx;
  if (m < TT) {
#pragma unroll
    for (int q = 0; q < 4; ++q) { ix[q] = ((const int4*)(sidx + (size_t)m * 128))[q]; wx[q] = ((const float4*)(wts + (size_t)m * 128))[q]; }
  }
  for (; m < TT; m += nwx) {
    const int idx[16] = {ix[0].x, ix[0].y, ix[0].z, ix[0].w, ix[1].x, ix[1].y, ix[1].z, ix[1].w,
                         ix[2].x, ix[2].y, ix[2].z, ix[2].w, ix[3].x, ix[3].y, ix[3].z, ix[3].w};
    const float wt[16] = {wx[0].x, wx[0].y, wx[0].z, wx[0].w, wx[1].x, wx[1].y, wx[1].z, wx[1].w,
                          wx[2].x, wx[2].y, wx[2].z, wx[2].w, wx[3].x, wx[3].y, wx[3].z, wx[3].w};
    u32x4 rows[16];
#pragma unroll
    for (int s2 = 0; s2 < 16; ++s2) rows[s2] = *(const u32x4*)(Vs + (size_t)idx[s2] * 128);
    const int mn = m + nwx;
    if (mn < TT) {
#pragma unroll
      for (int q = 0; q < 4; ++q) { ix[q] = ((const int4*)(sidx + (size_t)mn * 128))[q]; wx[q] = ((const float4*)(wts + (size_t)mn * 128))[q]; }
    }
    fl2_t acc[8];
#pragma unroll
    for (int q = 0; q < 8; ++q) acc[q] = {0.f, 0.f};
#pragma unroll
    for (int s2 = 0; s2 < 16; ++s2) {
      const fl2_t ww = {wt[s2], wt[s2]};
#pragma unroll
      for (int d = 0; d < 4; ++d) {
        const fl2_t lo = __builtin_amdgcn_cvt_pk_f32_fp8((int)rows[s2][d], false);
        const fl2_t hi = __builtin_amdgcn_cvt_pk_f32_fp8((int)rows[s2][d], true);
        acc[2 * d] = __builtin_elementwise_fma(lo, ww, acc[2 * d]);
        acc[2 * d + 1] = __builtin_elementwise_fma(hi, ww, acc[2 * d + 1]);
      }
    }
    float ps[16];
#pragma unroll
    for (int q = 0; q < 8; ++q) { ps[2 * q] = acc[q].x; ps[2 * q + 1] = acc[q].y; }
#pragma unroll
    for (int st = 0; st < 3; ++st) {
      const int bit = 32 >> st, half = 8 >> st;
      const bool upper = (lane & bit) != 0;
#pragma unroll
      for (int i = 0; i < half; ++i) {
        const float send = upper ? ps[i] : ps[i + half];
        const float keep = upper ? ps[i + half] : ps[i];
        ps[i] = keep + __shfl_xor(send, bit);
      }
    }
    const int cl = ((g >> 2) & 1) * 8 + ((g >> 1) & 1) * 4 + (g & 1) * 2;
    float2* yp = (float2*)(p.out + O_Y + (size_t)m * 1024 + v * 128 + li * 16 + cl);
    float2 yv = *yp;
    yv.x += ps[0]; yv.y += ps[1];
    *yp = yv;
  }
}

#define XB_TMO      128
#define XB_XCNT(j)  (256  + 64 * (j))
#define XB_XSUB(j)  (1280 + 64 * (j))
#define XB_XGEN(j)  (2304 + 64 * (j))
#define XB_TOP      3328
#define XB_TOPGEN   3392
#define XCD_BAR_WORDS 3456
#define XB_SPIN_CAP (1u << 18)
#define LAS __attribute__((address_space(3)))
DI unsigned xb_ld(unsigned* p) { return __hip_atomic_load(p, __ATOMIC_RELAXED, __HIP_MEMORY_SCOPE_AGENT); }
DI unsigned xb_add(unsigned* p, unsigned v) { return __hip_atomic_fetch_add(p, v, __ATOMIC_RELAXED, __HIP_MEMORY_SCOPE_AGENT); }
DI unsigned xb_xcc_id() { return (unsigned)__builtin_amdgcn_s_getreg((3 << 11) | 20) & 0xFu; }
#define XB_SPIN(cond, bar) do { unsigned _sp = 0; while (cond) { __builtin_amdgcn_s_sleep(1); \
    if ((++_sp & 255u) == 0u) { if (xb_ld(&(bar)[XB_TMO])) break; if (_sp > XB_SPIN_CAP) { atomicAdd(&(bar)[XB_TMO], 1u); break; } } } } while (0)
struct XcdBarrier { unsigned* bar; unsigned x; volatile LAS unsigned* st; };
DI XcdBarrier xcd_barrier_post(unsigned* bar, volatile LAS unsigned* st) {
  XcdBarrier b; b.bar = bar; b.x = xb_xcc_id(); b.st = st;
  if (threadIdx.x == 0) (void)xb_add(&bar[XB_XCNT(b.x)], 1u);
  return b;
}
DI void xcd_barrier_complete(unsigned* bar, unsigned x, unsigned& nloc, unsigned& nx) {
  const unsigned G = gridDim.x * gridDim.y * gridDim.z;
  unsigned sum, cnt, mine, sp = 0u;
  for (;;) {
    sum = 0u; cnt = 0u; mine = 0u;
#pragma unroll
    for (unsigned j = 0; j < 16; ++j) { const unsigned c = xb_ld(&bar[XB_XCNT(j)]); sum += c; cnt += (c > 0u) ? 1u : 0u; mine = (j == x) ? c : mine; }
    if (sum == G) break;
    __builtin_amdgcn_s_sleep(1);
    if ((++sp & 255u) == 0u) { if (xb_ld(&bar[XB_TMO])) break; if (sp > XB_SPIN_CAP) { atomicAdd(&bar[XB_TMO], 1u); break; } }
  }
  nloc = mine > 0u ? mine : 1u; nx = cnt > 0u ? cnt : 1u;
}
DI void xcd_barrier(const XcdBarrier& b) {
  asm volatile("s_waitcnt vmcnt(0)" ::: "memory");
  __syncthreads();
  if (threadIdx.x == 0) {
    unsigned* bar = b.bar;
    __builtin_amdgcn_s_waitcnt(0);
    unsigned nloc = b.st[0], nx = b.st[1];
    if (nloc == 0u) { xcd_barrier_complete(bar, b.x, nloc, nx); b.st[0] = nloc; b.st[1] = nx; }
    const unsigned old = xb_add(&bar[XB_XSUB(b.x)], 1u);
    const unsigned gen = old / nloc;
    if (old + 1u == (gen + 1u) * nloc) {
      __builtin_amdgcn_fence(__ATOMIC_RELEASE, "agent");
      asm volatile("s_waitcnt vmcnt(0)" ::: "memory");
      const unsigned og = xb_add(&bar[XB_TOP], 1u);
      const unsigned tg = og / nx;
      if (og + 1u == (tg + 1u) * nx) xb_add(&bar[XB_TOPGEN], 1u);
      else XB_SPIN(xb_ld(&bar[XB_TOPGEN]) == tg, bar);
      __builtin_amdgcn_fence(__ATOMIC_ACQUIRE, "agent");
      xb_add(&bar[XB_XGEN(b.x)], 1u);
      asm volatile("s_waitcnt vmcnt(0)" ::: "memory");
    } else {
      XB_SPIN(xb_ld(&bar[XB_XGEN(b.x)]) == gen, bar);
      __builtin_amdgcn_fence(__ATOMIC_ACQUIRE, "agent");
      asm volatile("s_waitcnt vmcnt(0)" ::: "memory");
    }
  }
  __syncthreads();
}

__global__ void __launch_bounds__(256, 2) hymba_mega(Params p) {
  __shared__ __attribute__((aligned(16))) char smem[53248];
  __shared__ uint4 xb_words;
  cg::grid_group grid = cg::this_grid();
  const int nb = gridDim.x, bid = blockIdx.x;
  if (threadIdx.x == 0) xb_words = make_uint4(0u, 0u, 0u, 0u);
  __syncthreads();
  XcdBarrier xb = xcd_barrier_post((unsigned*)(p.ws + W_BAR), (volatile LAS unsigned*)&xb_words);
  if (p.out == nullptr) grid.sync();
  phase0(p, smem);
  xcd_barrier(xb);
  for (int t = bid; t < 130 * 14; t += nb) gemm_tile<1>(p, t / 14, t % 14, smem);
  xcd_barrier(xb);
  for (int it = bid; it < 512; it += nb) lru_item<0>(p, it, smem);
  xcd_barrier(xb);
  for (int it = bid; it < 528 + 544; it += nb) {
    if (it < 528) lru_item<1>(p, it, smem);
    else attn_item(p, it - 528, smem);
  }
  xcd_barrier(xb);
  for (int t = bid; t < 130 * 8; t += nb) gemm_tile<2>(p, t >> 3, t & 7, smem);
  xcd_barrier(xb);
  for (int t = bid; t < 130 * 16; t += nb) gemm_tile<3>(p, t >> 4, t & 15, smem);
  xcd_barrier(xb);
  for (int it = bid; it < 260 * 8; it += nb) route_item(p, it, smem);
  xcd_barrier(xb);
  peer_u_phase(p);
  xcd_barrier(xb);
  peer_combine(p);
  xcd_barrier(xb);
  peer_v_phase(p);
}

extern "C" void kernel_launch(void* const* d_in, const int* in_sizes, int n_in, void* d_out, int out_size, void* d_ws,
                              size_t ws_size, hipStream_t stream) {
  static int grid_blocks = 0;
  if (!grid_blocks) {
    int dev = 0, cus = 0, per_cu = 0;
    (void)hipGetDevice(&dev);
    (void)hipDeviceGetAttribute(&cus, hipDeviceAttributeMultiprocessorCount, dev);
    (void)hipOccupancyMaxActiveBlocksPerMultiprocessor(&per_cu, hymba_mega, 256, 0);
    if (per_cu > 2) per_cu = 2;
    if (per_cu < 1) per_cu = 1;
    grid_blocks = cus * per_cu;
  }
  if (ws_size < W_END) fprintf(stderr, "workspace too small: %zu < %zu\n", ws_size, (size_t)W_END);
  Params p{};
  const float** pp = (const float**)&p;
  for (int i = 0; i < 27; ++i) pp[i] = (const float*)d_in[i];
  p.out = (float*)d_out;
  p.ws = (char*)d_ws;
  (void)hipMemsetAsync((char*)d_ws + W_BAR, 0, XCD_BAR_WORDS * 4, stream);
  void* args[] = {&p};
  hipError_t e = hipLaunchCooperativeKernel((void*)hymba_mega, dim3(grid_blocks), dim3(256), args, 0, stream);
  if (e != hipSuccess) fprintf(stderr, "cooperative launch failed: %s (grid %d)\n", hipGetErrorString(e), grid_blocks);
}
```

```cpp
#include <hip/hip_runtime.h>
#include <hip/hip_cooperative_groups.h>
#include <cstdio>
namespace cg = cooperative_groups;

#define DI __device__ __forceinline__
typedef __bf16 bf2_t __attribute__((ext_vector_type(2)));
typedef float fl2_t __attribute__((ext_vector_type(2)));
typedef short bf16x8 __attribute__((ext_vector_type(8)));
typedef float f32x16 __attribute__((ext_vector_type(16)));
typedef unsigned short u16;
typedef unsigned u32x4 __attribute__((ext_vector_type(4)));
#define MFMA32(a, b, c) __builtin_amdgcn_mfma_f32_32x32x16_bf16((a), (b), (c), 0, 0, 0)

constexpr int TP = 16384, TS = 256, TT = 16640;
constexpr float EPS = 1e-6f;
constexpr float USCALE = 512.0f, VSCALE = 64.0f;

constexpr size_t O_Y = 0;
constexpr size_t O_KP = 17039360, O_VP = 17170432, O_CONVP = 17301504, O_LRUP = 17313792;
constexpr size_t O_KS = 17317888, O_VS = 17580032, O_CONVS = 17842176, O_LRUS = 17866752;

constexpr size_t al(size_t x) { return (x + 255) & ~size_t(255); }
constexpr size_t W_WTIN = 0;
constexpr size_t W_WTOUT = W_WTIN + al(1792ull * 1024 * 2);
constexpr size_t W_WTQ = W_WTOUT + al(1024ull * 1024 * 2);
constexpr size_t W_K1B = W_WTQ + al(2048ull * 1024 * 2);
constexpr size_t W_K2B = W_K1B + al(128 * 128 * 2);
constexpr size_t W_WAT = W_K2B + al(128 * 128 * 2);
constexpr size_t W_WIT = W_WAT + al(8 * 64 * 64 * 2);
constexpr size_t W_C8 = W_WIT + al(8 * 64 * 64 * 2);
constexpr size_t W_UB = W_C8 + al(512 * 4);
constexpr size_t W_VB = W_UB + al(16384ull * 1024 * 2);
constexpr size_t W_RB = W_VB + al(16384ull * 1024 * 2);
constexpr size_t W_XB = W_RB;
constexpr size_t W_CAT = W_RB;
constexpr size_t W_SIDX = W_RB;
constexpr size_t W_SGATE = W_RB + al(TT * 128ull * 4);
constexpr size_t W_RC = W_RB + al(TT * 1024ull * 2);
constexpr size_t W_U = W_RC;
constexpr size_t W_GG = W_RC + TT * 512ull * 2;
constexpr size_t W_HB = W_RC;
constexpr size_t W_Q = W_RC + al(TT * 1024ull * 2);
constexpr size_t W_KP = W_Q + al(TT * 512ull * 2);
constexpr size_t W_KS = W_KP + al(TP * 128ull * 2);
constexpr size_t W_VTP = W_KS + al(16 * 192 * 128 * 2);
constexpr size_t W_VTS = W_VTP + al(8 * 128 * 2048ull * 2);
constexpr size_t W_SUMA = W_VTS + al(16 * 128 * 192 * 2);
constexpr size_t W_SUMH = W_SUMA + al(512 * 512 * 4);
constexpr size_t W_RS1 = W_SUMH + al(512 * 512 * 4);
constexpr size_t W_SSQL = W_RS1 + al(TT * 4);
constexpr size_t W_SSQA = W_SSQL + al(TT * 4 * 4);
constexpr size_t W_SSQ2 = W_SSQA + al(TT * 8 * 4);
constexpr size_t W_PQ = W_SSQ2 + al(TT * 16 * 4);
constexpr size_t W_TOPL = W_PQ;
constexpr size_t W_PART = W_PQ;
constexpr size_t W_WTS = W_SGATE + al(TT * 128ull * 4);
constexpr size_t W_RS2 = W_PQ + al(TT * 2048ull * 2);
constexpr size_t W_BAR = W_RS2 + al(TT * 4);
constexpr size_t W_END = W_BAR + al(3456 * 4);

struct Params {
  const float *x_p, *x_s, *cache_k, *cache_v, *state_conv, *state_lru, *ln1_g, *w_in, *conv_w, *conv_b,
      *lru_wa, *lru_ba, *lru_wi, *lru_bi, *lru_lambda, *q_g, *k_g, *sinks, *g_lru, *g_attn, *w_out, *ln2_g,
      *w_query, *sk1, *sk2, *peer_u, *peer_v;
  float* out;
  char* ws;
};

DI unsigned pk2(float a, float b) {
  fl2_t f = {a, b};
  return __builtin_bit_cast(unsigned, __builtin_convertvector(f, bf2_t));
}
DI float bf_lo(unsigned u) { return __uint_as_float(u << 16); }
DI float bf_hi(unsigned u) { return __uint_as_float(u & 0xffff0000u); }
DI float bf1(u16 v) { return __uint_as_float(((unsigned)v) << 16); }
DI float sigmoidf_(float x) { return 1.0f / (1.0f + __expf(-x)); }
DI float gelu_(float x) {
  float z = 0.7978845608028654f * (x + 0.044715f * x * x * x);
  return x / (1.0f + __expf(-2.0f * z));
}
DI int crow(int r, int h) { return (r & 3) + 8 * (r >> 2) + 4 * h; }

DI void transpose_tile(const float* __restrict__ src, int ld_src, u16* __restrict__ dst, int ld_dst, int k0, int n0,
                       const float* __restrict__ gain, float* tile) {
  const int tid = threadIdx.x;
  const int c = tid & 63, r0 = tid >> 6;
  __syncthreads();
#pragma unroll 4
  for (int rr = 0; rr < 16; ++rr) {
    int r = rr * 4 + r0;
    float v = src[(size_t)(k0 + r) * ld_src + n0 + c];
    if (gain) v *= gain[k0 + r];
    tile[r * 65 + c] = v;
  }
  __syncthreads();
  const int n = tid >> 2, kq = (tid & 3) * 16;
  unsigned pk[8];
#pragma unroll
  for (int i = 0; i < 8; ++i) pk[i] = pk2(tile[(kq + 2 * i) * 65 + n], tile[(kq + 2 * i + 1) * 65 + n]);
  uint4* d = (uint4*)(dst + (size_t)(n0 + n) * ld_dst + k0 + kq);
  d[0] = make_uint4(pk[0], pk[1], pk[2], pk[3]);
  d[1] = make_uint4(pk[4], pk[5], pk[6], pk[7]);
}

DI void wf_tile(const Params& p, int hh, int ktile) {
  const int tid = threadIdx.x, lane = tid & 63, w = tid >> 6, wn = w & 1, wm = w >> 1, tl = lane & 31, h = lane >> 5;
  const float* sk = (hh & 1) ? p.sk2 : p.sk1;
  f32x16 acc[2][2];
#pragma unroll
  for (int i = 0; i < 2; ++i)
#pragma unroll
    for (int j = 0; j < 2; ++j)
#pragma unroll
      for (int r = 0; r < 16; ++r) acc[i][j][r] = 0.f;
  const int kcol0 = ktile * 128 + wm * 64 + tl;
  const float g2a = p.ln2_g[kcol0], g2b = p.ln2_g[kcol0 + 32];
#pragma unroll 2
  for (int kk = 0; kk < 8; ++kk) {
    bf16x8 a[2], b[2];
#pragma unroll
    for (int i = 0; i < 2; ++i) {
      const float4* sp = (const float4*)(sk + (size_t)(wn * 64 + i * 32 + tl) * 128 + kk * 16 + h * 8);
      const float4 x = sp[0], y = sp[1];
      u32x4 t; t[0] = pk2(x.x, x.y); t[1] = pk2(x.z, x.w); t[2] = pk2(y.x, y.y); t[3] = pk2(y.z, y.w);
      a[i] = __builtin_bit_cast(bf16x8, t);
    }
#pragma unroll
    for (int j = 0; j < 2; ++j) {
      const float gg = j ? g2b : g2a;
      const float4* sp = (const float4*)(p.w_query + (size_t)(kcol0 + j * 32) * 2048 + hh * 128 + kk * 16 + h * 8);
      const float4 x = sp[0], y = sp[1];
      u32x4 t; t[0] = pk2(x.x * gg, x.y * gg); t[1] = pk2(x.z * gg, x.w * gg); t[2] = pk2(y.x * gg, y.y * gg); t[3] = pk2(y.z * gg, y.w * gg);
      b[j] = __builtin_bit_cast(bf16x8, t);
    }
#pragma unroll
    for (int i = 0; i < 2; ++i)
#pragma unroll
      for (int j = 0; j < 2; ++j) acc[i][j] = MFMA32(a[i], b[j], acc[i][j]);
  }
  u16* dst = (u16*)(p.ws + W_WTQ);
#pragma unroll
  for (int i = 0; i < 2; ++i)
#pragma unroll
    for (int j = 0; j < 2; ++j)
#pragma unroll
      for (int r = 0; r < 16; r += 2) {
        const int key = wn * 64 + i * 32 + crow(r, h);
        const unsigned pkv = pk2(acc[i][j][r], acc[i][j][r + 1]);
        dst[(size_t)(hh * 128 + key) * 1024 + kcol0 + j * 32] = (u16)(pkv & 0xffffu);
        dst[(size_t)(hh * 128 + key + 1) * 1024 + kcol0 + j * 32] = (u16)(pkv >> 16);
      }
}

DI void phase0(const Params& p, char* smem) {
  const int nb = gridDim.x, bid = blockIdx.x, tid = threadIdx.x;
  char* ws = p.ws;
  float* tile = (float*)smem;
  for (int it = bid; it < 848; it += nb) {
    if (it < 448) {
      int kt = it / 28, nt = it % 28;
      transpose_tile(p.w_in, 1792, (u16*)(ws + W_WTIN), 1024, kt * 64, nt * 64, p.ln1_g, tile);
    } else if (it < 704) {
      int j = it - 448;
      int kt = j >> 4, nt = j & 15;
      const float* gain = (kt < 8) ? p.g_lru : (p.g_attn - 512);
      transpose_tile(p.w_out, 1024, (u16*)(ws + W_WTOUT), 1024, kt * 64, nt * 64, gain, tile);
    } else if (it < 832) {
      wf_tile(p, (it - 704) >> 3, (it - 704) & 7);
    } else {
      int j = it - 832;
      int n = j & 7;
      if (j < 8) transpose_tile(p.lru_wa + n * 4096, 64, (u16*)(ws + W_WAT) + n * 4096, 64, 0, 0, nullptr, tile);
      else transpose_tile(p.lru_wi + n * 4096, 64, (u16*)(ws + W_WIT) + n * 4096, 64, 0, 0, nullptr, tile);
    }
  }
  const size_t gt = (size_t)bid * 256 + tid, gstride = (size_t)nb * 256;
  {
    for (size_t i = gt; i < 16384ull * 64; i += gstride) {
      const int e = (int)(i >> 6), c16 = (int)(i & 63);
      const float4* su = (const float4*)(p.peer_u + (size_t)e * 1024 + c16 * 16);
      const float4* sv = (const float4*)(p.peer_v + (size_t)e * 1024 + c16 * 16);
      const float4* g2 = (const float4*)(p.ln2_g + c16 * 16);
      u32x4 ou, ov;
#pragma unroll
      for (int q = 0; q < 4; ++q) {
        const float4 a = su[q], g = g2[q], c = sv[q];
        int pu = 0, pv = 0;
        pu = __builtin_amdgcn_cvt_pk_fp8_f32(a.x * g.x * USCALE, a.y * g.y * USCALE, pu, false);
        pu = __builtin_amdgcn_cvt_pk_fp8_f32(a.z * g.z * USCALE, a.w * g.w * USCALE, pu, true);
        pv = __builtin_amdgcn_cvt_pk_fp8_f32(c.x * VSCALE, c.y * VSCALE, pv, false);
        pv = __builtin_amdgcn_cvt_pk_fp8_f32(c.z * VSCALE, c.w * VSCALE, pv, true);
        ou[q] = (unsigned)pu; ov[q] = (unsigned)pv;
      }
      const size_t off = ((size_t)((c16 >> 3) * 16384 + e)) * 128 + (c16 & 7) * 16;
      *(u32x4*)(ws + W_UB + off) = ou;
      *(u32x4*)(ws + W_VB + off) = ov;
    }
  }
  for (size_t i = gt; i < 4096; i += gstride) {
    const float* s = (i < 2048) ? p.sk1 : p.sk2;
    size_t j = (i & 2047);
    const float4* sp = (const float4*)s + j * 2;
    float4 a = sp[0], b = sp[1];
    uint4 o = make_uint4(pk2(a.x, a.y), pk2(a.z, a.w), pk2(b.x, b.y), pk2(b.z, b.w));
    ((uint4*)(ws + ((i < 2048) ? W_K1B : W_K2B)))[j] = o;
  }
  for (size_t i = gt; i < 512; i += gstride) {
    float l = p.lru_lambda[i];
    float sp = (l < -15.f) ? -l : log1pf(expf(-l));
    ((float*)(ws + W_C8))[i] = -8.0f * sp;
  }
  for (size_t i = gt; i < 16 * 128 * 16; i += gstride) {
    int b = (int)(i >> 11), rem = (int)(i & 2047);
    int t = rem >> 4, c8i = rem & 15;
    const float4* sk = (const float4*)(p.cache_k + ((size_t)(b * 128 + t) * 128 + c8i * 8));
    float4 a = sk[0], bb = sk[1];
    uint4 o = make_uint4(pk2(a.x, a.y), pk2(a.z, a.w), pk2(bb.x, bb.y), pk2(bb.z, bb.w));
    *(uint4*)(ws + W_KS + ((size_t)(b * 192 + t) * 128 + c8i * 8) * 2) = o;
    const float4* sv = (const float4*)(p.cache_v + ((size_t)(b * 128 + t) * 128 + c8i * 8));
    float4 va = sv[0], vb = sv[1];
    if (t >= 16) {
      float4* dk = (float4*)(p.out + O_KS + ((size_t)(b * 128 + t - 16) * 128 + c8i * 8));
      dk[0] = a; dk[1] = bb;
      float4* dv = (float4*)(p.out + O_VS + ((size_t)(b * 128 + t - 16) * 128 + c8i * 8));
      dv[0] = va; dv[1] = vb;
    }
    u16* vt = (u16*)(ws + W_VTS) + (size_t)b * 128 * 192;
    float vv[8] = {va.x, va.y, va.z, va.w, vb.x, vb.y, vb.z, vb.w};
#pragma unroll
    for (int q = 0; q < 8; ++q) vt[(size_t)(c8i * 8 + q) * 192 + t] = (u16)(pk2(vv[q], 0.f) & 0xffffu);
  }
  for (size_t i = gt; i < 16 * 48 * 128; i += gstride) {
    int b = (int)(i / (48 * 128)), rem = (int)(i % (48 * 128));
    ((u16*)(ws + W_KS))[(size_t)(b * 192 + 144) * 128 + rem] = 0;
    int ch = rem / 48, tt = rem % 48;
    ((u16*)(ws + W_VTS))[(size_t)(b * 128 + ch) * 192 + 144 + tt] = 0;
  }
  {
    const int lane = tid & 63;
    const int gw = bid * 4 + (tid >> 6), nw = nb * 4;
    for (int m = gw; m < TT; m += nw) {
      const float* xr = (m < TP) ? (p.x_p + (size_t)m * 1024) : (p.x_s + (size_t)(m - TP) * 1024);
      const float4* xp = (const float4*)xr;
      float ss = 0.f;
      uint4* dst = (uint4*)(ws + W_XB + (size_t)m * 2048);
#pragma unroll
      for (int q = 0; q < 2; ++q) {
        float4 a = xp[q * 128 + lane * 2], b = xp[q * 128 + lane * 2 + 1];
        ss += a.x * a.x + a.y * a.y + a.z * a.z + a.w * a.w + b.x * b.x + b.y * b.y + b.z * b.z + b.w * b.w;
        dst[q * 64 + lane] = make_uint4(pk2(a.x, a.y), pk2(a.z, a.w), pk2(b.x, b.y), pk2(b.z, b.w));
      }
#pragma unroll
      for (int s = 32; s >= 1; s >>= 1) ss += __shfl_xor(ss, s);
      if (lane == 0) ((float*)(ws + W_RS1))[m] = rsqrtf(ss * (1.0f / 1024.0f) + EPS);
    }
  }
}

DI unsigned f2ord(float f) { unsigned u = __float_as_uint(f); return u ^ ((unsigned)((int)u >> 31) | 0x80000000u); }
DI float ord2f(unsigned u) { return __uint_as_float((u & 0x80000000u) ? (u ^ 0x80000000u) : ~u); }
DI void cas_desc(unsigned& a, unsigned& b) { unsigned mx = a > b ? a : b, mn = a > b ? b : a; a = mx; b = mn; }
DI void sort16_desc(unsigned (&v)[16]) {
#pragma unroll
  for (int k = 2; k <= 16; k <<= 1)
#pragma unroll
    for (int j = k >> 1; j > 0; j >>= 1)
#pragma unroll
      for (int i = 0; i < 16; ++i) {
        int l = i ^ j;
        if (l > i) {
          if ((i & k) == 0) cas_desc(v[i], v[l]); else cas_desc(v[l], v[i]);
        }
      }
}
DI void merge16_desc(unsigned (&v)[16]) {
#pragma unroll
  for (int j = 8; j > 0; j >>= 1)
#pragma unroll
    for (int i = 0; i < 16; ++i) {
      int l = i ^ j;
      if (l > i) cas_desc(v[i], v[l]);
    }
}
DI void merge_top16(unsigned (&a)[16], unsigned (&b)[16]) {
#pragma unroll
  for (int i = 0; i < 16; ++i) a[i] = a[i] > b[15 - i] ? a[i] : b[15 - i];
  merge16_desc(a);
}


template <int MODE>
DI void gemm_tile(const Params& p, int mt, int nt, char* smem) {
  constexpr int LROW = 144;
  char* ws = p.ws;
  const char* Wt = ws + (MODE == 1 ? W_WTIN : (MODE == 2 ? W_WTOUT : W_WTQ));
  const char* X = ws + (MODE == 1 ? W_XB : (MODE == 2 ? W_CAT : W_HB));
  char* sW = smem;
  char* sX = smem + 128 * LROW;
  const int tid = threadIdx.x, lane = tid & 63, w = tid >> 6, wn = w & 1, wm = w >> 1;
  const int tl = lane & 31, h = lane >> 5;
  const char* gW = Wt + (size_t)(nt * 128) * 2048;
  const char* gX = X + (size_t)(mt * 128) * 2048;
  u32x4 rW[4], rX[4];
  f32x16 acc[2][2];
#pragma unroll
  for (int i = 0; i < 2; ++i)
#pragma unroll
    for (int j = 0; j < 2; ++j)
#pragma unroll
      for (int r = 0; r < 16; ++r) acc[i][j][r] = 0.f;

  const int m_lane[2] = {mt * 128 + wm * 64 + tl, mt * 128 + wm * 64 + 32 + tl};
  float ratio[2] = {1.f, 1.f}, fscale[2] = {1.f, 1.f};
  if (MODE == 2) {
#pragma unroll
    for (int j = 0; j < 2; ++j) {
      const float4 sl = *(const float4*)(ws + W_SSQL + (size_t)m_lane[j] * 16);
      const float4 sa0 = *(const float4*)(ws + W_SSQA + (size_t)m_lane[j] * 32);
      const float4 sa1 = *(const float4*)(ws + W_SSQA + (size_t)m_lane[j] * 32 + 16);
      float rsl = rsqrtf((sl.x + sl.y + sl.z + sl.w) * (1.0f / 512.0f) + EPS);
      float rsa = rsqrtf((sa0.x + sa0.y + sa0.z + sa0.w + sa1.x + sa1.y + sa1.z + sa1.w) * (1.0f / 512.0f) + EPS);
      ratio[j] = rsl / rsa;
      fscale[j] = rsa;
    }
  } else if (MODE == 1) {
#pragma unroll
    for (int j = 0; j < 2; ++j) fscale[j] = ((const float*)(ws + W_RS1))[m_lane[j]];
  } else {
#pragma unroll
    for (int j = 0; j < 2; ++j) {
      const float4* sp = (const float4*)(ws + W_SSQ2 + (size_t)m_lane[j] * 64);
      float4 a = sp[0], b = sp[1], c = sp[2], d = sp[3];
      float s = a.x + a.y + a.z + a.w + b.x + b.y + b.z + b.w + c.x + c.y + c.z + c.w + d.x + d.y + d.z + d.w;
      fscale[j] = rsqrtf(s * (1.0f / 1024.0f) + EPS);
    }
  }

#pragma unroll
  for (int i = 0; i < 4; ++i) {
    int c = tid + 256 * i, row = c >> 3, kc = c & 7;
    rW[i] = *(const u32x4*)(gW + (size_t)row * 2048 + kc * 16);
    rX[i] = *(const u32x4*)(gX + (size_t)row * 2048 + kc * 16);
  }
  for (int ks = 0; ks < 16; ++ks) {
    __syncthreads();
#pragma unroll
    for (int i = 0; i < 4; ++i) {
      int c = tid + 256 * i, row = c >> 3, kc = c & 7;
      *(u32x4*)(sW + row * LROW + kc * 16) = rW[i];
      *(u32x4*)(sX + row * LROW + kc * 16) = rX[i];
    }
    __syncthreads();
    if (ks + 1 < 16) {
#pragma unroll
      for (int i = 0; i < 4; ++i) {
        int c = tid + 256 * i, row = c >> 3, kc = c & 7;
        rW[i] = *(const u32x4*)(gW + (size_t)row * 2048 + (ks + 1) * 128 + kc * 16);
        rX[i] = *(const u32x4*)(gX + (size_t)row * 2048 + (ks + 1) * 128 + kc * 16);
      }
    }
    if (MODE == 2 && ks == 8) {
#pragma unroll
      for (int i = 0; i < 2; ++i)
#pragma unroll
        for (int j = 0; j < 2; ++j)
#pragma unroll
          for (int r = 0; r < 16; ++r) acc[i][j][r] *= ratio[j];
    }
#pragma unroll
    for (int kk = 0; kk < 4; ++kk) {
      bf16x8 a[2], b[2];
#pragma unroll
      for (int i = 0; i < 2; ++i) a[i] = *(const bf16x8*)(sW + (wn * 64 + i * 32 + tl) * LROW + kk * 32 + h * 16);
#pragma unroll
      for (int j = 0; j < 2; ++j) b[j] = *(const bf16x8*)(sX + (wm * 64 + j * 32 + tl) * LROW + kk * 32 + h * 16);
#pragma unroll
      for (int i = 0; i < 2; ++i)
#pragma unroll
        for (int j = 0; j < 2; ++j) acc[i][j] = MFMA32(a[i], b[j], acc[i][j]);
    }
  }

  const int ncol0 = nt * 128 + wn * 64;
  if (MODE == 1) {
    if (ncol0 < 512) {
#pragma unroll
      for (int j = 0; j < 2; ++j) {
        const int m = m_lane[j];
        float* convdst = nullptr;
        if (m < TP) {
          int t = m & 2047;
          if (t >= 2045) convdst = p.out + O_CONVP + (size_t)((m >> 11) * 3 + (t - 2045)) * 512;
        } else {
          int ms = m - TP, t = ms & 15;
          if (t >= 13) convdst = p.out + O_CONVS + (size_t)((ms >> 4) * 3 + (t - 13)) * 512;
        }
        u16* ub = (u16*)(ws + W_U) + (size_t)m * 512;
#pragma unroll
        for (int i = 0; i < 2; ++i)
#pragma unroll
          for (int g = 0; g < 4; ++g) {
            int n = ncol0 + i * 32 + 8 * g + 4 * h;
            float v0 = acc[i][j][4 * g] * fscale[j], v1 = acc[i][j][4 * g + 1] * fscale[j],
                  v2 = acc[i][j][4 * g + 2] * fscale[j], v3 = acc[i][j][4 * g + 3] * fscale[j];
            *(uint2*)(ub + n) = make_uint2(pk2(v0, v1), pk2(v2, v3));
            if (convdst) *(float4*)(convdst + n) = make_float4(v0, v1, v2, v3);
          }
      }
    } else if (ncol0 < 1024) {
#pragma unroll
      for (int j = 0; j < 2; ++j) {
        u16* gb = (u16*)(ws + W_GG) + (size_t)m_lane[j] * 512;
#pragma unroll
        for (int i = 0; i < 2; ++i)
#pragma unroll
          for (int g = 0; g < 4; ++g) {
            int n = ncol0 - 512 + i * 32 + 8 * g + 4 * h;
            float v0 = gelu_(acc[i][j][4 * g] * fscale[j]), v1 = gelu_(acc[i][j][4 * g + 1] * fscale[j]),
                  v2 = gelu_(acc[i][j][4 * g + 2] * fscale[j]), v3 = gelu_(acc[i][j][4 * g + 3] * fscale[j]);
            *(uint2*)(gb + n) = make_uint2(pk2(v0, v1), pk2(v2, v3));
          }
      }
    } else if (ncol0 < 1664) {
      const bool isq = ncol0 < 1536;
      const float* gain = isq ? p.q_g : p.k_g;
      const float post = isq ? 0.125f : 1.0f;
#pragma unroll
      for (int j = 0; j < 2; ++j) {
        const int m = m_lane[j];
        float ss = 0.f;
#pragma unroll
        for (int i = 0; i < 2; ++i)
#pragma unroll
          for (int r = 0; r < 16; ++r) {
            float v = acc[i][j][r] * fscale[j];
            ss += v * v;
          }
        ss += __shfl_xor(ss, 32);
        const float sc = fscale[j] * rsqrtf(ss * (1.0f / 64.0f) + EPS) * post;
        u16* dst;
        float* fdst = nullptr;
        int nloc0;
        if (isq) {
          nloc0 = ncol0 - 1024;
          dst = (u16*)(ws + W_Q) + (size_t)m * 512 + nloc0;
        } else {
          nloc0 = ncol0 - 1536;
          if (m < TP) {
            dst = (u16*)(ws + W_KP) + (size_t)m * 128 + nloc0;
            int t = m & 2047;
            if (t >= 1920) fdst = p.out + O_KP + (size_t)((m >> 11) * 128 + (t - 1920)) * 128 + nloc0;
          } else {
            int ms = m - TP, b = ms >> 4, t = ms & 15;
            dst = (u16*)(ws + W_KS) + (size_t)(b * 192 + 128 + t) * 128 + nloc0;
            fdst = p.out + O_KS + (size_t)(b * 128 + 112 + t) * 128 + nloc0;
          }
        }
#pragma unroll
        for (int i = 0; i < 2; ++i)
#pragma unroll
          for (int g = 0; g < 4; ++g) {
            int d = i * 32 + 8 * g + 4 * h;
            const float4 gn = *(const float4*)(gain + d);
            float v0 = acc[i][j][4 * g] * sc * gn.x, v1 = acc[i][j][4 * g + 1] * sc * gn.y,
                  v2 = acc[i][j][4 * g + 2] * sc * gn.z, v3 = acc[i][j][4 * g + 3] * sc * gn.w;
            *(uint2*)(dst + d) = make_uint2(pk2(v0, v1), pk2(v2, v3));
            if (fdst) *(float4*)(fdst + d) = make_float4(v0, v1, v2, v3);
          }
      }
    } else {
#pragma unroll
      for (int j = 0; j < 2; ++j) {
        const int m = m_lane[j];
        u16* vt;
        size_t vstride;
        float* fdst = nullptr;
        const int ch0 = ncol0 - 1664;
        if (m < TP) {
          int b = m >> 11, t = m & 2047;
          vt = (u16*)(ws + W_VTP) + (size_t)b * 128 * 2048 + t;
          vstride = 2048;
          if (t >= 1920) fdst = p.out + O_VP + (size_t)(b * 128 + (t - 1920)) * 128;
        } else {
          int ms = m - TP, b = ms >> 4, t = ms & 15;
          vt = (u16*)(ws + W_VTS) + (size_t)b * 128 * 192 + 128 + t;
          vstride = 192;
          fdst = p.out + O_VS + (size_t)(b * 128 + 112 + t) * 128;
        }
#pragma unroll
        for (int i = 0; i < 2; ++i)
#pragma unroll
          for (int g = 0; g < 4; ++g) {
            int ch = ch0 + i * 32 + 8 * g + 4 * h;
            float v0 = acc[i][j][4 * g] * fscale[j], v1 = acc[i][j][4 * g + 1] * fscale[j],
                  v2 = acc[i][j][4 * g + 2] * fscale[j], v3 = acc[i][j][4 * g + 3] * fscale[j];
            unsigned p01 = pk2(v0, v1), p23 = pk2(v2, v3);
            vt[(size_t)(ch + 0) * vstride] = (u16)(p01 & 0xffffu);
            vt[(size_t)(ch + 1) * vstride] = (u16)(p01 >> 16);
            vt[(size_t)(ch + 2) * vstride] = (u16)(p23 & 0xffffu);
            vt[(size_t)(ch + 3) * vstride] = (u16)(p23 >> 16);
            if (fdst) *(float4*)(fdst + ch) = make_float4(v0, v1, v2, v3);
          }
      }
    }
  } else if (MODE == 2) {
#pragma unroll
    for (int j = 0; j < 2; ++j) {
      const int m = m_lane[j];
      const float* xr = (m < TP) ? (p.x_p + (size_t)m * 1024) : (p.x_s + (size_t)(m - TP) * 1024);
      float* yr = p.out + O_Y + (size_t)m * 1024;
      u16* hb = (u16*)(ws + W_HB) + (size_t)m * 1024;
      float ss = 0.f;
#pragma unroll
      for (int i = 0; i < 2; ++i)
#pragma unroll
        for (int g = 0; g < 4; ++g) {
          int n = ncol0 + i * 32 + 8 * g + 4 * h;
          const float4 xv = *(const float4*)(xr + n);
          float v0 = xv.x + acc[i][j][4 * g] * fscale[j], v1 = xv.y + acc[i][j][4 * g + 1] * fscale[j],
                v2 = xv.z + acc[i][j][4 * g + 2] * fscale[j], v3 = xv.w + acc[i][j][4 * g + 3] * fscale[j];
          *(float4*)(yr + n) = make_float4(v0, v1, v2, v3);
          *(uint2*)(hb + n) = make_uint2(pk2(v0, v1), pk2(v2, v3));
          ss += v0 * v0 + v1 * v1 + v2 * v2 + v3 * v3;
        }
      ss += __shfl_xor(ss, 32);
      if (h == 0) ((float*)(ws + W_SSQ2))[(size_t)m * 16 + nt * 2 + wn] = ss;
    }
  } else {
    unsigned* Lx = (unsigned*)smem;
    unsigned topj[2][16];
#pragma unroll
    for (int j = 0; j < 2; ++j) {
      if (nt == 0 && wn == 0 && h == 0) ((float*)(ws + W_RS2))[m_lane[j]] = fscale[j];
      unsigned tmp[16];
#pragma unroll
      for (int r = 0; r < 16; ++r) topj[j][r] = (f2ord(acc[0][j][r] * fscale[j]) & ~127u) | (unsigned)(127 - (wn * 64 + crow(r, h)));
      sort16_desc(topj[j]);
#pragma unroll
      for (int r = 0; r < 16; ++r) tmp[r] = (f2ord(acc[1][j][r] * fscale[j]) & ~127u) | (unsigned)(127 - (wn * 64 + 32 + crow(r, h)));
      sort16_desc(tmp);
      merge_top16(topj[j], tmp);
#pragma unroll
      for (int i = 0; i < 16; ++i) tmp[i] = __shfl_xor(topj[j][i], 32);
      merge_top16(topj[j], tmp);
    }
    __syncthreads();
    if (wn == 1 && h == 0) {
#pragma unroll
      for (int j = 0; j < 2; ++j) {
        u32x4* d4 = (u32x4*)(Lx + ((wm * 2 + j) * 32 + tl) * 16);
#pragma unroll
        for (int q = 0; q < 4; ++q) { u32x4 v4; v4[0] = topj[j][4 * q]; v4[1] = topj[j][4 * q + 1]; v4[2] = topj[j][4 * q + 2]; v4[3] = topj[j][4 * q + 3]; d4[q] = v4; }
      }
    }
    __syncthreads();
    if (wn == 0 && h == 0) {
#pragma unroll
      for (int j = 0; j < 2; ++j) {
        unsigned tmp[16];
        const u32x4* s4 = (const u32x4*)(Lx + ((wm * 2 + j) * 32 + tl) * 16);
#pragma unroll
        for (int q = 0; q < 4; ++q) { const u32x4 v4 = s4[q]; tmp[4 * q] = v4[0]; tmp[4 * q + 1] = v4[1]; tmp[4 * q + 2] = v4[2]; tmp[4 * q + 3] = v4[3]; }
        merge_top16(topj[j], tmp);
        u32x4* g4 = (u32x4*)((unsigned*)(ws + W_TOPL) + ((size_t)m_lane[j] * 16 + nt) * 16);
#pragma unroll
        for (int q = 0; q < 4; ++q) { u32x4 v4; v4[0] = topj[j][4 * q]; v4[1] = topj[j][4 * q + 1]; v4[2] = topj[j][4 * q + 2]; v4[3] = topj[j][4 * q + 3]; g4[q] = v4; }
      }
    }
  }
}

#define SCAN_STEP(CTRL) { \
    const float Ap = __uint_as_float(__builtin_amdgcn_update_dpp(0x3f800000u, __float_as_uint(A), CTRL, 0xF, 0xF, false)); \
    const float Hp = __uint_as_float(__builtin_amdgcn_update_dpp(0u, __float_as_uint(H), CTRL, 0xF, 0xF, false)); \
    H = A * Hp + H; A = A * Ap; }
template <int FINAL>
DI void lru_item(const Params& p, int item, char* smem) {
  char* ws = p.ws;
  const bool samp = item >= 512;
  int b, c, m0, nvalid;
  if (!samp) { b = item >> 6; c = item & 63; m0 = b * 2048 + c * 32; nvalid = 32; }
  else { b = item - 512; c = 0; m0 = TP + b * 16; nvalid = 16; }
  const int tid = threadIdx.x, lane = tid & 63, w = tid >> 6, tl = lane & 31, h = lane >> 5;
  u16* XC = (u16*)smem;
  float* hin = (float*)(smem + 32 * 1040);
  __syncthreads();
  {
    const int ch = 2 * tid;
    const float2 w0 = *(const float2*)(p.conv_w + ch), w1 = *(const float2*)(p.conv_w + 512 + ch),
                 w2 = *(const float2*)(p.conv_w + 1024 + ch), w3 = *(const float2*)(p.conv_w + 1536 + ch),
                 cb = *(const float2*)(p.conv_b + ch);
    float2 r0 = {0.f, 0.f}, r1 = {0.f, 0.f}, r2 = {0.f, 0.f};
    const u16* ub = (const u16*)(ws + W_U);
    if (!samp) {
      if (c > 0) {
        unsigned a0 = *(const unsigned*)(ub + (size_t)(m0 - 3) * 512 + ch), a1 = *(const unsigned*)(ub + (size_t)(m0 - 2) * 512 + ch),
                 a2 = *(const unsigned*)(ub + (size_t)(m0 - 1) * 512 + ch);
        r0 = {bf_lo(a0), bf_hi(a0)}; r1 = {bf_lo(a1), bf_hi(a1)}; r2 = {bf_lo(a2), bf_hi(a2)};
      }
    } else {
      const float* sc = p.state_conv + (size_t)b * 3 * 512 + ch;
      r0 = *(const float2*)(sc); r1 = *(const float2*)(sc + 512); r2 = *(const float2*)(sc + 1024);
    }
    unsigned uraw[32];
#pragma unroll
    for (int t = 0; t < 32; ++t) uraw[t] = (t < nvalid) ? *(const unsigned*)(ub + (size_t)(m0 + t) * 512 + ch) : 0u;
#pragma unroll
    for (int t = 0; t < 32; ++t) {
      float2 cur = {bf_lo(uraw[t]), bf_hi(uraw[t])};
      float x0 = cb.x + w0.x * r0.x + w1.x * r1.x + w2.x * r2.x + w3.x * cur.x;
      float x1 = cb.y + w0.y * r0.y + w1.y * r1.y + w2.y * r2.y + w3.y * cur.y;
      *(unsigned*)(XC + t * 520 + ch) = pk2(x0, x1);
      r0 = r1; r1 = r2; r2 = cur;
    }
    if (FINAL) {
      float2 hh;
      if (samp) hh = *(const float2*)(p.state_lru + (size_t)b * 512 + ch);
      else {
        hh = {0.f, 0.f};
        const float* sA = (const float*)(ws + W_SUMA) + (size_t)(b * 64) * 512 + ch;
        const float* sH = (const float*)(ws + W_SUMH) + (size_t)(b * 64) * 512 + ch;
        int cc = 0;
        for (; cc + 4 <= c; cc += 4) {
          float2 A0 = *(const float2*)(sA + (size_t)(cc + 0) * 512), H0 = *(const float2*)(sH + (size_t)(cc + 0) * 512);
          float2 A1 = *(const float2*)(sA + (size_t)(cc + 1) * 512), H1 = *(const float2*)(sH + (size_t)(cc + 1) * 512);
          float2 A2 = *(const float2*)(sA + (size_t)(cc + 2) * 512), H2 = *(const float2*)(sH + (size_t)(cc + 2) * 512);
          float2 A3 = *(const float2*)(sA + (size_t)(cc + 3) * 512), H3 = *(const float2*)(sH + (size_t)(cc + 3) * 512);
          hh.x = A0.x * hh.x + H0.x; hh.y = A0.y * hh.y + H0.y;
          hh.x = A1.x * hh.x + H1.x; hh.y = A1.y * hh.y + H1.y;
          hh.x = A2.x * hh.x + H2.x; hh.y = A2.y * hh.y + H2.y;
          hh.x = A3.x * hh.x + H3.x; hh.y = A3.y * hh.y + H3.y;
        }
        for (; cc < c; ++cc) {
          float2 A0 = *(const float2*)(sA + (size_t)cc * 512), H0 = *(const float2*)(sH + (size_t)cc * 512);
          hh.x = A0.x * hh.x + H0.x; hh.y = A0.y * hh.y + H0.y;
        }
      }
      hin[ch] = hh.x; hin[ch + 1] = hh.y;
    }
  }
  __syncthreads();
  const u16* WaT = (const u16*)(ws + W_WAT);
  const u16* WiT = (const u16*)(ws + W_WIT);
  const float* c8 = (const float*)(ws + W_C8);
  const int m = m0 + tl;
  const bool valid = tl < nvalid;
  float ssq = 0.f;
#pragma unroll 1
  for (int nbk = 0; nbk < 2; ++nbk) {
    const int n = 2 * w + nbk;
    f32x16 accA[2], accI[2];
#pragma unroll
    for (int i = 0; i < 2; ++i)
#pragma unroll
      for (int r = 0; r < 16; ++r) { accA[i][r] = 0.f; accI[i][r] = 0.f; }
#pragma unroll
    for (int kk = 0; kk < 4; ++kk) {
      const bf16x8 bx = *(const bf16x8*)((const char*)XC + tl * 1040 + (n * 64 + kk * 16 + h * 8) * 2);
#pragma unroll
      for (int i = 0; i < 2; ++i) {
        const bf16x8 aa = *(const bf16x8*)(WaT + (size_t)(n * 64 + i * 32 + tl) * 64 + kk * 16 + h * 8);
        const bf16x8 ai = *(const bf16x8*)(WiT + (size_t)(n * 64 + i * 32 + tl) * 64 + kk * 16 + h * 8);
        accA[i] = MFMA32(aa, bx, accA[i]);
        accI[i] = MFMA32(ai, bx, accI[i]);
      }
    }
#pragma unroll
    for (int i = 0; i < 2; ++i)
#pragma unroll
      for (int g = 0; g < 4; ++g) {
        const int ch = n * 64 + i * 32 + 8 * g + 4 * h;
        const float4 ba4 = *(const float4*)(p.lru_ba + ch), bi4 = *(const float4*)(p.lru_bi + ch), c84 = *(const float4*)(c8 + ch);
        const float bav[4] = {ba4.x, ba4.y, ba4.z, ba4.w}, biv[4] = {bi4.x, bi4.y, bi4.z, bi4.w}, c8v[4] = {c84.x, c84.y, c84.z, c84.w};
        const uint2 xcp = *(const uint2*)(XC + tl * 520 + ch);
        const float xcv[4] = {bf_lo(xcp.x), bf_hi(xcp.x), bf_lo(xcp.y), bf_hi(xcp.y)};
        float hv[4];
#pragma unroll
        for (int q = 0; q < 4; ++q) {
          const int r = 4 * g + q;
          float rr = sigmoidf_(accA[i][r] + bav[q]);
          float ii = sigmoidf_(accI[i][r] + biv[q]);
          float la = c8v[q] * rr;
          float A = __expf(la);
          float x2 = 2.0f * la;
          float em = -x2 * (1.0f + x2 * (0.5f + x2 * (0.16666667f + x2 * (0.041666668f + x2 * (0.0083333333f + x2 * 0.0013888889f)))));
          float H = sqrtf(fmaxf(em, 0.f)) * ii * xcv[q];
          SCAN_STEP(0x111) SCAN_STEP(0x112) SCAN_STEP(0x114) SCAN_STEP(0x118)
          {
            const float Ap = __uint_as_float(__builtin_amdgcn_update_dpp(0x3f800000u, __float_as_uint(A), 0x142, 0xA, 0xF, false));
            const float Hp = __uint_as_float(__builtin_amdgcn_update_dpp(0u, __float_as_uint(H), 0x142, 0xA, 0xF, false));
            H = A * Hp + H; A = A * Ap;
          }
          if (!FINAL) {
            if (tl == 31) {
              ((float*)(ws + W_SUMA))[(size_t)(b * 64 + c) * 512 + ch + q] = A;
              ((float*)(ws + W_SUMH))[(size_t)(b * 64 + c) * 512 + ch + q] = H;
            }
          } else {
            hv[q] = H + A * hin[ch + q];
          }
        }
        if (FINAL) {
          if (tl == nvalid - 1 && (samp || c == 63)) {
            float* dst = p.out + (samp ? O_LRUS : O_LRUP) + (size_t)b * 512 + ch;
            *(float4*)dst = make_float4(hv[0], hv[1], hv[2], hv[3]);
          }
          if (valid) {
            const uint2 gp = *(const uint2*)((const u16*)(ws + W_GG) + (size_t)m * 512 + ch);
            float o0 = hv[0] * bf_lo(gp.x), o1 = hv[1] * bf_hi(gp.x), o2 = hv[2] * bf_lo(gp.y), o3 = hv[3] * bf_hi(gp.y);
            ssq += o0 * o0 + o1 * o1 + o2 * o2 + o3 * o3;
            *(uint2*)((u16*)(ws + W_CAT) + (size_t)m * 1024 + ch) = make_uint2(pk2(o0, o1), pk2(o2, o3));
          }
        }
      }
  }
  if (FINAL) {
    ssq += __shfl_xor(ssq, 32);
    if (valid && h == 0) ((float*)(ws + W_SSQL))[(size_t)m * 4 + w] = ssq;
  }
}

DI void attn_item(const Params& p, int item, char* smem) {
  char* ws = p.ws;
  const int tid = threadIdx.x, lane = tid & 63, w = tid >> 6, tl = lane & 31, h = lane >> 5;
  const bool samp = item >= 512;
  int b, c, g;
  const u16* Kb; const u16* Vt; int vstride, kc_lo, kc_hi, nkeys, mq0; bool qvalid;
  if (!samp) {
    b = item >> 6; c = (item >> 1) & 31; g = item & 1;
    Kb = (const u16*)(ws + W_KP) + (size_t)b * 2048 * 128;
    Vt = (const u16*)(ws + W_VTP) + (size_t)b * 128 * 2048;
    vstride = 2048; kc_lo = (c >= 2) ? c - 2 : 0; kc_hi = c; nkeys = 1 << 30;
    mq0 = b * 2048 + c * 64 + tl; qvalid = true;
  } else {
    int it = item - 512; b = it >> 1; g = it & 1; c = 0;
    Kb = (const u16*)(ws + W_KS) + (size_t)b * 192 * 128;
    Vt = (const u16*)(ws + W_VTS) + (size_t)b * 128 * 192;
    vstride = 192; kc_lo = 0; kc_hi = 2; nkeys = 144;
    mq0 = TP + b * 16 + (tl & 15); qvalid = tl < 16;
  }
  const int hq = g * 4 + w;
  const float sink = p.sinks[hq];
  char* sK = smem;
  char* sV = smem + 192 * 144;
  const int nch = kc_hi - kc_lo + 1;
  const int nj = samp ? 1 : 2;
  bf16x8 bq[2][4];
#pragma unroll
  for (int j = 0; j < 2; ++j)
#pragma unroll
    for (int kk = 0; kk < 4; ++kk)
      bq[j][kk] = *(const bf16x8*)((const u16*)(ws + W_Q) + (size_t)(mq0 + (samp ? 0 : j * 32)) * 512 + hq * 64 + kk * 16 + h * 8);
  __syncthreads();
  {
    u32x4 kr[6], vr[6];
#pragma unroll
    for (int i = 0; i < 6; ++i) {
      const int idx = tid + 256 * i;
      const int key = idx >> 3, part = idx & 7;
      if (key < nch * 64) kr[i] = *(const u32x4*)(Kb + (size_t)(kc_lo * 64 + key) * 128 + g * 64 + part * 8);
      const int d = idx / 24, pv = idx % 24;
      if (pv < nch * 8) vr[i] = *(const u32x4*)(Vt + (size_t)(g * 64 + d) * vstride + kc_lo * 64 + pv * 8);
    }
#pragma unroll
    for (int i = 0; i < 6; ++i) {
      const int idx = tid + 256 * i;
      const int key = idx >> 3, part = idx & 7;
      if (key < nch * 64) *(u32x4*)(sK + key * 144 + part * 16) = kr[i];
      const int d = idx / 24, pv = idx % 24;
      if (pv < nch * 8) *(u32x4*)(sV + d * 400 + pv * 16) = vr[i];
    }
  }
  __syncthreads();
#pragma unroll
  for (int j = 0; j < 2; ++j) {
    if (j < nj) {
    const int mqj = mq0 + j * 32;
    float mrun = sink, lrun = 1.f;
    f32x16 O[2];
#pragma unroll
    for (int i = 0; i < 2; ++i)
#pragma unroll
      for (int r = 0; r < 16; ++r) O[i][r] = 0.f;
#pragma unroll 1
    for (int kc = 0; kc < nch; ++kc) {
      f32x16 S[2];
#pragma unroll
      for (int i = 0; i < 2; ++i)
#pragma unroll
        for (int r = 0; r < 16; ++r) S[i][r] = 0.f;
#pragma unroll
      for (int kk = 0; kk < 4; ++kk)
#pragma unroll
        for (int kt = 0; kt < 2; ++kt) {
          const bf16x8 ak = *(const bf16x8*)(sK + (kc * 64 + kt * 32 + tl) * 144 + kk * 32 + h * 16);
          S[kt] = MFMA32(ak, bq[j][kk], S[kt]);
        }
      if (samp) {
#pragma unroll
        for (int kt = 0; kt < 2; ++kt)
#pragma unroll
          for (int r = 0; r < 16; ++r) {
            int key = kc * 64 + kt * 32 + crow(r, h);
            if (key >= nkeys) S[kt][r] = -INFINITY;
          }
      }
      {
        float mx = -INFINITY;
#pragma unroll
        for (int kt = 0; kt < 2; ++kt)
#pragma unroll
          for (int r = 0; r < 16; ++r) mx = fmaxf(mx, S[kt][r]);
        mx = fmaxf(mx, __shfl_xor(mx, 32));
        const float mnew = fmaxf(mrun, mx);
        const float alpha = __expf(mrun - mnew);
        float ps = 0.f;
#pragma unroll
        for (int kt = 0; kt < 2; ++kt)
#pragma unroll
          for (int r = 0; r < 16; ++r) {
            float pv = __expf(S[kt][r] - mnew);
            S[kt][r] = pv;
            ps += pv;
          }
        ps += __shfl_xor(ps, 32);
        lrun = lrun * alpha + ps;
        mrun = mnew;
#pragma unroll
        for (int dt = 0; dt < 2; ++dt)
#pragma unroll
          for (int r = 0; r < 16; ++r) O[dt][r] *= alpha;
      }
#pragma unroll
      for (int kt = 0; kt < 2; ++kt)
#pragma unroll
        for (int s2 = 0; s2 < 2; ++s2) {
          u32x4 pp;
          pp[0] = pk2(S[kt][8 * s2 + 0], S[kt][8 * s2 + 1]);
          pp[1] = pk2(S[kt][8 * s2 + 2], S[kt][8 * s2 + 3]);
          pp[2] = pk2(S[kt][8 * s2 + 4], S[kt][8 * s2 + 5]);
          pp[3] = pk2(S[kt][8 * s2 + 6], S[kt][8 * s2 + 7]);
          const bf16x8 bp = __builtin_bit_cast(bf16x8, pp);
#pragma unroll
          for (int dt = 0; dt < 2; ++dt) {
            const int d = dt * 32 + tl;
            const uint2 lo = *(const uint2*)(sV + d * 400 + (kc * 64 + kt * 32 + 16 * s2 + 4 * h) * 2);
            const uint2 hi = *(const uint2*)(sV + d * 400 + (kc * 64 + kt * 32 + 16 * s2 + 8 + 4 * h) * 2);
            u32x4 av4;
            av4[0] = lo.x; av4[1] = lo.y; av4[2] = hi.x; av4[3] = hi.y;
            O[dt] = MFMA32(__builtin_bit_cast(bf16x8, av4), bp, O[dt]);
          }
        }
    }
    const float inv = 1.0f / lrun;
    float ss = 0.f;
    u16* dst = (u16*)(ws + W_CAT) + (size_t)mqj * 1024 + 512 + hq * 64;
#pragma unroll
    for (int dt = 0; dt < 2; ++dt)
#pragma unroll
      for (int g4 = 0; g4 < 4; ++g4) {
        int d = dt * 32 + 8 * g4 + 4 * h;
        float v0 = O[dt][4 * g4] * inv, v1 = O[dt][4 * g4 + 1] * inv, v2 = O[dt][4 * g4 + 2] * inv, v3 = O[dt][4 * g4 + 3] * inv;
        ss += v0 * v0 + v1 * v1 + v2 * v2 + v3 * v3;
        if (qvalid) *(uint2*)(dst + d) = make_uint2(pk2(v0, v1), pk2(v2, v3));
      }
    ss += __shfl_xor(ss, 32);
    if (qvalid && h == 0) ((float*)(ws + W_SSQA))[(size_t)mqj * 8 + hq] = ss;
    }
  }
}

struct CandTab { int i[64]; int j[64]; int n; };
constexpr CandTab make_tab() {
  CandTab t{};
  int n = 0;
  for (int i = 0; i < 16; ++i)
    for (int j = 0; j < 16; ++j)
      if ((i + 1) * (j + 1) <= 16) { t.i[n] = i; t.j[n] = j; ++n; }
  t.n = n;
  return t;
}

DI void route2(const Params& p, char* smem) {
  char* ws = p.ws;
  constexpr CandTab CT = make_tab();
  const int tid = threadIdx.x;
  unsigned* Lp = (unsigned*)smem + tid * 33;
  for (int base = blockIdx.x * 256; base < TT * 8; base += gridDim.x * 256) {
    const int it = base + tid;
    const int mm = it >> 3, hd = it & 7;
    unsigned l1[16], l2[16];
    {
      const u32x4* s1 = (const u32x4*)((const unsigned*)(ws + W_TOPL) + ((size_t)mm * 16 + hd * 2) * 16);
#pragma unroll
      for (int q = 0; q < 4; ++q) {
        const u32x4 a = s1[q], b = s1[4 + q];
        l1[4 * q] = a[0]; l1[4 * q + 1] = a[1]; l1[4 * q + 2] = a[2]; l1[4 * q + 3] = a[3];
        l2[4 * q] = b[0]; l2[4 * q + 1] = b[1]; l2[4 * q + 2] = b[2]; l2[4 * q + 3] = b[3];
      }
    }
#pragma unroll
    for (int i = 0; i < 16; ++i) { Lp[i] = l1[i]; Lp[16 + i] = l2[i]; }
    float f1[16], f2[16];
#pragma unroll
    for (int i = 0; i < 16; ++i) { f1[i] = ord2f(l1[i] & ~127u); f2[i] = ord2f(l2[i] & ~127u); }
    unsigned top[16], tmp[16];
#pragma unroll
    for (int grp = 0; grp < 4; ++grp) {
#pragma unroll
      for (int q = 0; q < 16; ++q) {
        const int cidx = grp * 16 + q;
        unsigned key = 0;
        if (cidx < CT.n) {
          const int ci = CT.i[cidx], cj = CT.j[cidx];
          key = (f2ord(f1[ci] + f2[cj]) & ~255u) | (unsigned)(255 - (ci * 16 + cj));
        }
        if (grp == 0) top[q] = key; else tmp[q] = key;
      }
      if (grp == 0) sort16_desc(top);
      else { sort16_desc(tmp); merge_top16(top, tmp); }
    }
    float sv[16]; int ex[16];
    float smax = -INFINITY;
#pragma unroll
    for (int q = 0; q < 16; ++q) {
      const int code = 255 - (int)(top[q] & 255u);
      const int ci = code >> 4, cj = code & 15;
      const unsigned a = Lp[ci], bb = Lp[16 + cj];
      const int i1 = 127 - (int)(a & 127u), i2 = 127 - (int)(bb & 127u);
      sv[q] = ord2f(a & ~127u) + ord2f(bb & ~127u);
      ex[q] = i1 * 128 + i2;
      smax = fmaxf(smax, sv[q]);
    }
    float sum = 0.f;
#pragma unroll
    for (int q = 0; q < 16; ++q) { sv[q] = __expf(sv[q] - smax); sum += sv[q]; }
    const float inv = 1.0f / sum;
    int4* di = (int4*)((int*)(ws + W_SIDX) + (size_t)mm * 128 + hd * 16);
    float4* dg = (float4*)((float*)(ws + W_SGATE) + (size_t)mm * 128 + hd * 16);
#pragma unroll
    for (int q = 0; q < 4; ++q) {
      di[q] = make_int4(ex[4 * q], ex[4 * q + 1], ex[4 * q + 2], ex[4 * q + 3]);
      dg[q] = make_float4(sv[4 * q] * inv, sv[4 * q + 1] * inv, sv[4 * q + 2] * inv, sv[4 * q + 3] * inv);
    }
  }
}

DI void peer_u_phase(const Params& p) {
  char* ws = p.ws;
  const int lane = threadIdx.x & 63, w = threadIdx.x >> 6, g = lane >> 3, li = lane & 7;
  const int v = blockIdx.x & 7, bx = blockIdx.x >> 3, nbx = (gridDim.x - v + 7) >> 3;
  const int gwx = bx * 4 + w, nwx = nbx * 4;
  const char* Us = ws + W_UB + (size_t)v * 16384 * 128 + li * 16;
  const int* sidx = (const int*)(ws + W_SIDX) + g * 16;
  int4 ix[4];
  u32x4 hq0, hq1;
  int m = gwx;
  if (m < TT) {
#pragma unroll
    for (int q = 0; q < 4; ++q) ix[q] = ((const int4*)(sidx + (size_t)m * 128))[q];
    const u32x4* hp = (const u32x4*)(ws + W_HB + (size_t)m * 2048 + v * 256 + li * 32);
    hq0 = hp[0]; hq1 = hp[1];
  }
  for (; m < TT; m += nwx) {
    const int idx[16] = {ix[0].x, ix[0].y, ix[0].z, ix[0].w, ix[1].x, ix[1].y, ix[1].z, ix[1].w,
                         ix[2].x, ix[2].y, ix[2].z, ix[2].w, ix[3].x, ix[3].y, ix[3].z, ix[3].w};
    u32x4 rows[16];
#pragma unroll
    for (int s2 = 0; s2 < 16; ++s2) rows[s2] = *(const u32x4*)(Us + (size_t)idx[s2] * 128);
    fl2_t hv[8];
    hv[0] = {bf_lo(hq0[0]), bf_hi(hq0[0])}; hv[1] = {bf_lo(hq0[1]), bf_hi(hq0[1])};
    hv[2] = {bf_lo(hq0[2]), bf_hi(hq0[2])}; hv[3] = {bf_lo(hq0[3]), bf_hi(hq0[3])};
    hv[4] = {bf_lo(hq1[0]), bf_hi(hq1[0])}; hv[5] = {bf_lo(hq1[1]), bf_hi(hq1[1])};
    hv[6] = {bf_lo(hq1[2]), bf_hi(hq1[2])}; hv[7] = {bf_lo(hq1[3]), bf_hi(hq1[3])};
    const int mn = m + nwx;
    if (mn < TT) {
#pragma unroll
      for (int q = 0; q < 4; ++q) ix[q] = ((const int4*)(sidx + (size_t)mn * 128))[q];
      const u32x4* hp = (const u32x4*)(ws + W_HB + (size_t)mn * 2048 + v * 256 + li * 32);
      hq0 = hp[0]; hq1 = hp[1];
    }
    float ps[16];
#pragma unroll
    for (int s2 = 0; s2 < 16; ++s2) {
      fl2_t acc = {0.f, 0.f};
#pragma unroll
      for (int d = 0; d < 4; ++d) {
        const fl2_t lo = __builtin_amdgcn_cvt_pk_f32_fp8((int)rows[s2][d], false);
        const fl2_t hi = __builtin_amdgcn_cvt_pk_f32_fp8((int)rows[s2][d], true);
        acc = __builtin_elementwise_fma(lo, hv[2 * d], acc);
        acc = __builtin_elementwise_fma(hi, hv[2 * d + 1], acc);
      }
      ps[s2] = acc.x + acc.y;
    }
#pragma unroll
    for (int st = 0; st < 3; ++st) {
      const int bit = 4 >> st, half = 8 >> st;
      const bool upper = (li & bit) != 0;
#pragma unroll
      for (int i = 0; i < half; ++i) {
        const float send = upper ? ps[i] : ps[i + half];
        const float keep = upper ? ps[i + half] : ps[i];
        ps[i] = keep + __shfl_xor(send, bit);
      }
    }
    const int sl = ((li >> 2) & 1) * 8 + ((li >> 1) & 1) * 4 + (li & 1) * 2;
    *(float2*)((float*)(ws + W_PART) + ((size_t)m * 8 + v) * 128 + g * 16 + sl) = make_float2(ps[0], ps[1]);
  }
}

DI void peer_combine(const Params& p) {
  char* ws = p.ws;
  const size_t gt = (size_t)blockIdx.x * 256 + threadIdx.x, gstride = (size_t)gridDim.x * 256;
  for (size_t i = gt; i < (size_t)TT * 128; i += gstride) {
    const size_t m = i >> 7, sl = i & 127;
    const float* pp = (const float*)(ws + W_PART) + m * 1024 + sl;
    float d = 0.f;
#pragma unroll
    for (int v = 0; v < 8; ++v) d += pp[v * 128];
    const float rs2 = ((const float*)(ws + W_RS2))[m];
    const float gate = ((const float*)(ws + W_SGATE))[i];
    ((float*)(ws + W_WTS))[i] = gelu_(d * rs2 * (1.0f / USCALE)) * gate * (1.0f / VSCALE);
  }
}

DI void peer_v_phase(const Params& p) {
  char* ws = p.ws;
  const int lane = threadIdx.x & 63, w = threadIdx.x >> 6, g = lane >> 3, li = lane & 7;
  const int v = blockIdx.x & 7, bx = blockIdx.x >> 3, nbx = (gridDim.x - v + 7) >> 3;
  const int gwx = bx * 4 + w, nwx = nbx * 4;
  const char* Vs = ws + W_VB + (size_t)v * 16384 * 128 + li * 16;
  const int* sidx = (const int*)(ws + W_SIDX) + g * 16;
  const float* wts = (const float*)(ws + W_WTS) + g * 16;
  int4 ix[4];
  float4 wx[4];
  int m = gwx;
  if (m < TT) {
#pragma unroll
    for (int q = 0; q < 4; ++q) { ix[q] = ((const int4*)(sidx + (size_t)m * 128))[q]; wx[q] = ((const float4*)(wts + (size_t)m * 128))[q]; }
  }
  for (; m < TT; m += nwx) {
    const int idx[16] = {ix[0].x, ix[0].y, ix[0].z, ix[0].w, ix[1].x, ix[1].y, ix[1].z, ix[1].w,
                         ix[2].x, ix[2].y, ix[2].z, ix[2].w, ix[3].x, ix[3].y, ix[3].z, ix[3].w};
    const float wt[16] = {wx[0].x, wx[0].y, wx[0].z, wx[0].w, wx[1].x, wx[1].y, wx[1].z, wx[1].w,
                          wx[2].x, wx[2].y, wx[2].z, wx[2].w, wx[3].x, wx[3].y, wx[3].z, wx[3].w};
    u32x4 rows[16];
#pragma unroll
    for (int s2 = 0; s2 < 16; ++s2) rows[s2] = *(const u32x4*)(Vs + (size_t)idx[s2] * 128);
    const int mn = m + nwx;
    if (mn < TT) {
#pragma unroll
      for (int q = 0; q < 4; ++q) { ix[q] = ((const int4*)(sidx + (size_t)mn * 128))[q]; wx[q] = ((const float4*)(wts + (size_t)mn * 128))[q]; }
    }
    fl2_t acc[8];
#pragma unroll
    for (int q = 0; q < 8; ++q) acc[q] = {0.f, 0.f};
#pragma unroll
    for (int s2 = 0; s2 < 16; ++s2) {
      const fl2_t ww = {wt[s2], wt[s2]};
#pragma unroll
      for (int d = 0; d < 4; ++d) {
        const fl2_t lo = __builtin_amdgcn_cvt_pk_f32_fp8((int)rows[s2][d], false);
        const fl2_t hi = __builtin_amdgcn_cvt_pk_f32_fp8((int)rows[s2][d], true);
        acc[2 * d] = __builtin_elementwise_fma(lo, ww, acc[2 * d]);
        acc[2 * d + 1] = __builtin_elementwise_fma(hi, ww, acc[2 * d + 1]);
      }
    }
    float ps[16];
#pragma unroll
    for (int q = 0; q < 8; ++q) { ps[2 * q] = acc[q].x; ps[2 * q + 1] = acc[q].y; }
#pragma unroll
    for (int st = 0; st < 3; ++st) {
      const int bit = 32 >> st, half = 8 >> st;
      const bool upper = (lane & bit) != 0;
#pragma unroll
      for (int i = 0; i < half; ++i) {
        const float send = upper ? ps[i] : ps[i + half];
        const float keep = upper ? ps[i + half] : ps[i];
        ps[i] = keep + __shfl_xor(send, bit);
      }
    }
    const int cl = ((g >> 2) & 1) * 8 + ((g >> 1) & 1) * 4 + (g & 1) * 2;
    float2* yp = (float2*)(p.out + O_Y + (size_t)m * 1024 + v * 128 + li * 16 + cl);
    float2 yv = *yp;
    yv.x += ps[0]; yv.y += ps[1];
    *yp = yv;
  }
}

#define XB_TMO      128
#define XB_XCNT(j)  (256  + 64 * (j))
#define XB_XSUB(j)  (1280 + 64 * (j))
#define XB_XGEN(j)  (2304 + 64 * (j))
#define XB_TOP      3328
#define XB_TOPGEN   3392
#define XCD_BAR_WORDS 3456
#define XB_SPIN_CAP (1u << 18)
#define LAS __attribute__((address_space(3)))
DI unsigned xb_ld(unsigned* p) { return __hip_atomic_load(p, __ATOMIC_RELAXED, __HIP_MEMORY_SCOPE_AGENT); }
DI unsigned xb_add(unsigned* p, unsigned v) { return __hip_atomic_fetch_add(p, v, __ATOMIC_RELAXED, __HIP_MEMORY_SCOPE_AGENT); }
DI unsigned xb_xcc_id() { return (unsigned)__builtin_amdgcn_s_getreg((3 << 11) | 20) & 0xFu; }
#define XB_SPIN(cond, bar) do { unsigned _sp = 0; while (cond) { __builtin_amdgcn_s_sleep(1); \
    if ((++_sp & 255u) == 0u) { if (xb_ld(&(bar)[XB_TMO])) break; if (_sp > XB_SPIN_CAP) { atomicAdd(&(bar)[XB_TMO], 1u); break; } } } } while (0)
struct XcdBarrier { unsigned* bar; unsigned x; volatile LAS unsigned* st; };
DI XcdBarrier xcd_barrier_post(unsigned* bar, volatile LAS unsigned* st) {
  XcdBarrier b; b.bar = bar; b.x = xb_xcc_id(); b.st = st;
  if (threadIdx.x == 0) (void)xb_add(&bar[XB_XCNT(b.x)], 1u);
  return b;
}
DI void xcd_barrier_complete(unsigned* bar, unsigned x, unsigned& nloc, unsigned& nx) {
  const unsigned G = gridDim.x * gridDim.y * gridDim.z;
  unsigned sum, cnt, mine, sp = 0u;
  for (;;) {
    sum = 0u; cnt = 0u; mine = 0u;
#pragma unroll
    for (unsigned j = 0; j < 16; ++j) { const unsigned c = xb_ld(&bar[XB_XCNT(j)]); sum += c; cnt += (c > 0u) ? 1u : 0u; mine = (j == x) ? c : mine; }
    if (sum == G) break;
    __builtin_amdgcn_s_sleep(1);
    if ((++sp & 255u) == 0u) { if (xb_ld(&bar[XB_TMO])) break; if (sp > XB_SPIN_CAP) { atomicAdd(&bar[XB_TMO], 1u); break; } }
  }
  nloc = mine > 0u ? mine : 1u; nx = cnt > 0u ? cnt : 1u;
}
DI void xcd_barrier(const XcdBarrier& b) {
  asm volatile("s_waitcnt vmcnt(0)" ::: "memory");
  __syncthreads();
  if (threadIdx.x == 0) {
    unsigned* bar = b.bar;
    __builtin_amdgcn_s_waitcnt(0);
    unsigned nloc = b.st[0], nx = b.st[1];
    if (nloc == 0u) { xcd_barrier_complete(bar, b.x, nloc, nx); b.st[0] = nloc; b.st[1] = nx; }
    const unsigned old = xb_add(&bar[XB_XSUB(b.x)], 1u);
    const unsigned gen = old / nloc;
    if (old + 1u == (gen + 1u) * nloc) {
      __builtin_amdgcn_fence(__ATOMIC_RELEASE, "agent");
      asm volatile("s_waitcnt vmcnt(0)" ::: "memory");
      const unsigned og = xb_add(&bar[XB_TOP], 1u);
      const unsigned tg = og / nx;
      if (og + 1u == (tg + 1u) * nx) xb_add(&bar[XB_TOPGEN], 1u);
      else XB_SPIN(xb_ld(&bar[XB_TOPGEN]) == tg, bar);
      __builtin_amdgcn_fence(__ATOMIC_ACQUIRE, "agent");
      xb_add(&bar[XB_XGEN(b.x)], 1u);
      asm volatile("s_waitcnt vmcnt(0)" ::: "memory");
    } else {
      XB_SPIN(xb_ld(&bar[XB_XGEN(b.x)]) == gen, bar);
      __builtin_amdgcn_fence(__ATOMIC_ACQUIRE, "agent");
      asm volatile("s_waitcnt vmcnt(0)" ::: "memory");
    }
  }
  __syncthreads();
}

__global__ void __launch_bounds__(256, 2) hymba_mega(Params p) {
  __shared__ __attribute__((aligned(16))) char smem[53248];
  __shared__ uint4 xb_words;
  cg::grid_group grid = cg::this_grid();
  const int nb = gridDim.x, bid = blockIdx.x;
  if (threadIdx.x == 0) xb_words = make_uint4(0u, 0u, 0u, 0u);
  __syncthreads();
  XcdBarrier xb = xcd_barrier_post((unsigned*)(p.ws + W_BAR), (volatile LAS unsigned*)&xb_words);
  if (p.out == nullptr) grid.sync();
  phase0(p, smem);
  xcd_barrier(xb);
  for (int t = bid; t < 130 * 14; t += nb) gemm_tile<1>(p, t / 14, t % 14, smem);
  xcd_barrier(xb);
  for (int it = bid; it < 512; it += nb) lru_item<0>(p, it, smem);
  xcd_barrier(xb);
  for (int it = bid; it < 528 + 544; it += nb) {
    if (it < 528) lru_item<1>(p, it, smem);
    else attn_item(p, it - 528, smem);
  }
  xcd_barrier(xb);
  for (int t = bid; t < 130 * 8; t += nb) gemm_tile<2>(p, t >> 3, t & 7, smem);
  xcd_barrier(xb);
  for (int t = bid; t < 130 * 16; t += nb) gemm_tile<3>(p, t >> 4, t & 15, smem);
  xcd_barrier(xb);
  __syncthreads();
  route2(p, smem);
  xcd_barrier(xb);
  peer_u_phase(p);
  xcd_barrier(xb);
  peer_combine(p);
  xcd_barrier(xb);
  peer_v_phase(p);
}

extern "C" void kernel_launch(void* const* d_in, const int* in_sizes, int n_in, void* d_out, int out_size, void* d_ws,
                              size_t ws_size, hipStream_t stream) {
  static int grid_blocks = 0;
  if (!grid_blocks) {
    int dev = 0, cus = 0, per_cu = 0;
    (void)hipGetDevice(&dev);
    (void)hipDeviceGetAttribute(&cus, hipDeviceAttributeMultiprocessorCount, dev);
    (void)hipOccupancyMaxActiveBlocksPerMultiprocessor(&per_cu, hymba_mega, 256, 0);
    if (per_cu > 2) per_cu = 2;
    if (per_cu < 1) per_cu = 1;
    grid_blocks = cus * per_cu;
  }
  if (ws_size < W_END) fprintf(stderr, "workspace too small: %zu < %zu\n", ws_size, (size_t)W_END);
  Params p{};
  const float** pp = (const float**)&p;
  for (int i = 0; i < 27; ++i) pp[i] = (const float*)d_in[i];
  p.out = (float*)d_out;
  p.ws = (char*)d_ws;
  (void)hipMemsetAsync((char*)d_ws + W_BAR, 0, XCD_BAR_WORDS * 4, stream);
  void* args[] = {&p};
  hipError_t e = hipLaunchCooperativeKernel((void*)hymba_mega, dim3(grid_blocks), dim3(256), args, 0, stream);
  if (e != hipSuccess) fprintf(stderr, "cooperative launch failed: %s (grid %d)\n", hipGetErrorString(e), grid_blocks);
}
```

```cpp
#include <hip/hip_runtime.h>
#include <hip/hip_cooperative_groups.h>
#include <cstdio>
namespace cg = cooperative_groups;

#define DI __device__ __forceinline__
typedef __bf16 bf2_t __attribute__((ext_vector_type(2)));
typedef float fl2_t __attribute__((ext_vector_type(2)));
typedef short bf16x8 __attribute__((ext_vector_type(8)));
typedef float f32x16 __attribute__((ext_vector_type(16)));
typedef unsigned short u16;
typedef unsigned u32x4 __attribute__((ext_vector_type(4)));
#define MFMA32(a, b, c) __builtin_amdgcn_mfma_f32_32x32x16_bf16((a), (b), (c), 0, 0, 0)

constexpr int TP = 16384, TS = 256, TT = 16640;
constexpr float EPS = 1e-6f;
constexpr float USCALE = 512.0f, VSCALE = 64.0f;

constexpr size_t O_Y = 0;
constexpr size_t O_KP = 17039360, O_VP = 17170432, O_CONVP = 17301504, O_LRUP = 17313792;
constexpr size_t O_KS = 17317888, O_VS = 17580032, O_CONVS = 17842176, O_LRUS = 17866752;

constexpr size_t al(size_t x) { return (x + 255) & ~size_t(255); }
constexpr size_t W_WTIN = 0;
constexpr size_t W_WTOUT = W_WTIN + al(1792ull * 1024 * 2);
constexpr size_t W_WTQ = W_WTOUT + al(1024ull * 1024 * 2);
constexpr size_t W_K1B = W_WTQ + al(2048ull * 1024 * 2);
constexpr size_t W_K2B = W_K1B + al(128 * 128 * 2);
constexpr size_t W_WAT = W_K2B + al(128 * 128 * 2);
constexpr size_t W_WIT = W_WAT + al(8 * 64 * 64 * 2);
constexpr size_t W_C8 = W_WIT + al(8 * 64 * 64 * 2);
constexpr size_t W_UB = W_C8 + al(512 * 4);
constexpr size_t W_VB = W_UB + al(16384ull * 1024 * 2);
constexpr size_t W_RB = W_VB + al(16384ull * 1024 * 2);
constexpr size_t W_XB = W_RB;
constexpr size_t W_CAT = W_RB;
constexpr size_t W_SIDX = W_RB;
constexpr size_t W_SGATE = W_RB + al(TT * 128ull * 4);
constexpr size_t W_RC = W_RB + al(TT * 1024ull * 2);
constexpr size_t W_U = W_RC;
constexpr size_t W_GG = W_RC + TT * 512ull * 2;
constexpr size_t W_HB = W_RC;
constexpr size_t W_Q = W_RC + al(TT * 1024ull * 2);
constexpr size_t W_KP = W_Q + al(TT * 512ull * 2);
constexpr size_t W_KS = W_KP + al(TP * 128ull * 2);
constexpr size_t W_VTP = W_KS + al(16 * 192 * 128 * 2);
constexpr size_t W_VTS = W_VTP + al(8 * 128 * 2048ull * 2);
constexpr size_t W_SUMA = W_VTS + al(16 * 128 * 192 * 2);
constexpr size_t W_SUMH = W_SUMA + al(512 * 512 * 4);
constexpr size_t W_RS1 = W_SUMH + al(512 * 512 * 4);
constexpr size_t W_SSQL = W_RS1 + al(TT * 4);
constexpr size_t W_SSQA = W_SSQL + al(TT * 4 * 4);
constexpr size_t W_SSQ2 = W_SSQA + al(TT * 8 * 4);
constexpr size_t W_PQ = W_SSQ2 + al(TT * 16 * 4);
constexpr size_t W_TOPL = W_PQ;
constexpr size_t W_PART = W_PQ;
constexpr size_t W_WTS = W_SGATE + al(TT * 128ull * 4);
constexpr size_t W_RS2 = W_PQ + al(TT * 2048ull * 2);
constexpr size_t W_BAR = W_RS2 + al(TT * 4);
constexpr size_t W_END = W_BAR + al(3456 * 4);

struct Params {
  const float *x_p, *x_s, *cache_k, *cache_v, *state_conv, *state_lru, *ln1_g, *w_in, *conv_w, *conv_b,
      *lru_wa, *lru_ba, *lru_wi, *lru_bi, *lru_lambda, *q_g, *k_g, *sinks, *g_lru, *g_attn, *w_out, *ln2_g,
      *w_query, *sk1, *sk2, *peer_u, *peer_v;
  float* out;
  char* ws;
};

DI unsigned pk2(float a, float b) {
  fl2_t f = {a, b};
  return __builtin_bit_cast(unsigned, __builtin_convertvector(f, bf2_t));
}
DI float bf_lo(unsigned u) { return __uint_as_float(u << 16); }
DI float bf_hi(unsigned u) { return __uint_as_float(u & 0xffff0000u); }
DI float bf1(u16 v) { return __uint_as_float(((unsigned)v) << 16); }
DI float sigmoidf_(float x) { return 1.0f / (1.0f + __expf(-x)); }
DI float gelu_(float x) {
  float z = 0.7978845608028654f * (x + 0.044715f * x * x * x);
  return x / (1.0f + __expf(-2.0f * z));
}
DI int crow(int r, int h) { return (r & 3) + 8 * (r >> 2) + 4 * h; }

DI void transpose_tile(const float* __restrict__ src, int ld_src, u16* __restrict__ dst, int ld_dst, int k0, int n0,
                       const float* __restrict__ gain, float* tile) {
  const int tid = threadIdx.x;
  const int c = tid & 63, r0 = tid >> 6;
  __syncthreads();
#pragma unroll 4
  for (int rr = 0; rr < 16; ++rr) {
    int r = rr * 4 + r0;
    float v = src[(size_t)(k0 + r) * ld_src + n0 + c];
    if (gain) v *= gain[k0 + r];
    tile[r * 65 + c] = v;
  }
  __syncthreads();
  const int n = tid >> 2, kq = (tid & 3) * 16;
  unsigned pk[8];
#pragma unroll
  for (int i = 0; i < 8; ++i) pk[i] = pk2(tile[(kq + 2 * i) * 65 + n], tile[(kq + 2 * i + 1) * 65 + n]);
  uint4* d = (uint4*)(dst + (size_t)(n0 + n) * ld_dst + k0 + kq);
  d[0] = make_uint4(pk[0], pk[1], pk[2], pk[3]);
  d[1] = make_uint4(pk[4], pk[5], pk[6], pk[7]);
}

DI void wf_tile(const Params& p, int hh, int ktile) {
  const int tid = threadIdx.x, lane = tid & 63, w = tid >> 6, wn = w & 1, wm = w >> 1, tl = lane & 31, h = lane >> 5;
  const float* sk = (hh & 1) ? p.sk2 : p.sk1;
  f32x16 acc[2][2];
#pragma unroll
  for (int i = 0; i < 2; ++i)
#pragma unroll
    for (int j = 0; j < 2; ++j)
#pragma unroll
      for (int r = 0; r < 16; ++r) acc[i][j][r] = 0.f;
  const int kcol0 = ktile * 128 + wm * 64 + tl;
  const float g2a = p.ln2_g[kcol0], g2b = p.ln2_g[kcol0 + 32];
#pragma unroll 2
  for (int kk = 0; kk < 8; ++kk) {
    bf16x8 a[2], b[2];
#pragma unroll
    for (int i = 0; i < 2; ++i) {
      const float4* sp = (const float4*)(sk + (size_t)(wn * 64 + i * 32 + tl) * 128 + kk * 16 + h * 8);
      const float4 x = sp[0], y = sp[1];
      u32x4 t; t[0] = pk2(x.x, x.y); t[1] = pk2(x.z, x.w); t[2] = pk2(y.x, y.y); t[3] = pk2(y.z, y.w);
      a[i] = __builtin_bit_cast(bf16x8, t);
    }
#pragma unroll
    for (int j = 0; j < 2; ++j) {
      const float gg = j ? g2b : g2a;
      const float4* sp = (const float4*)(p.w_query + (size_t)(kcol0 + j * 32) * 2048 + hh * 128 + kk * 16 + h * 8);
      const float4 x = sp[0], y = sp[1];
      u32x4 t; t[0] = pk2(x.x * gg, x.y * gg); t[1] = pk2(x.z * gg, x.w * gg); t[2] = pk2(y.x * gg, y.y * gg); t[3] = pk2(y.z * gg, y.w * gg);
      b[j] = __builtin_bit_cast(bf16x8, t);
    }
#pragma unroll
    for (int i = 0; i < 2; ++i)
#pragma unroll
      for (int j = 0; j < 2; ++j) acc[i][j] = MFMA32(a[i], b[j], acc[i][j]);
  }
  u16* dst = (u16*)(p.ws + W_WTQ);
#pragma unroll
  for (int i = 0; i < 2; ++i)
#pragma unroll
    for (int j = 0; j < 2; ++j)
#pragma unroll
      for (int r = 0; r < 16; r += 2) {
        const int key = wn * 64 + i * 32 + crow(r, h);
        const unsigned pkv = pk2(acc[i][j][r], acc[i][j][r + 1]);
        dst[(size_t)(hh * 128 + key) * 1024 + kcol0 + j * 32] = (u16)(pkv & 0xffffu);
        dst[(size_t)(hh * 128 + key + 1) * 1024 + kcol0 + j * 32] = (u16)(pkv >> 16);
      }
}

DI void conv_table(const Params& p, bool isU, int part, int nparts) {
  char* ws = p.ws;
  const float* src = isU ? p.peer_u : p.peer_v;
  char* dstb = ws + (isU ? W_UB : W_VB);
  const float scale = isU ? USCALE : VSCALE;
  for (size_t i = (size_t)part * 256 + threadIdx.x; i < 16384ull * 64; i += (size_t)nparts * 256) {
    const int e = (int)(i >> 6), c16 = (int)(i & 63);
    const float4* su = (const float4*)(src + (size_t)e * 1024 + c16 * 16);
    const float4* g2 = (const float4*)(p.ln2_g + c16 * 16);
    u32x4 ou;
#pragma unroll
    for (int q = 0; q < 4; ++q) {
      float4 a = su[q];
      if (isU) { const float4 g = g2[q]; a.x *= g.x; a.y *= g.y; a.z *= g.z; a.w *= g.w; }
      int pu = 0;
      pu = __builtin_amdgcn_cvt_pk_fp8_f32(a.x * scale, a.y * scale, pu, false);
      pu = __builtin_amdgcn_cvt_pk_fp8_f32(a.z * scale, a.w * scale, pu, true);
      ou[q] = (unsigned)pu;
    }
    const size_t off = ((size_t)((c16 >> 3) * 16384 + e)) * 128 + (c16 & 7) * 16;
    *(u32x4*)(dstb + off) = ou;
  }
}

DI void phase0(const Params& p, char* smem) {
  const int nb = gridDim.x, bid = blockIdx.x, tid = threadIdx.x;
  char* ws = p.ws;
  float* tile = (float*)smem;
  for (int it = bid; it < 848; it += nb) {
    if (it < 448) {
      int kt = it / 28, nt = it % 28;
      transpose_tile(p.w_in, 1792, (u16*)(ws + W_WTIN), 1024, kt * 64, nt * 64, p.ln1_g, tile);
    } else if (it < 704) {
      int j = it - 448;
      int kt = j >> 4, nt = j & 15;
      const float* gain = (kt < 8) ? p.g_lru : (p.g_attn - 512);
      transpose_tile(p.w_out, 1024, (u16*)(ws + W_WTOUT), 1024, kt * 64, nt * 64, gain, tile);
    } else if (it < 832) {
      wf_tile(p, (it - 704) >> 3, (it - 704) & 7);
    } else {
      int j = it - 832;
      int n = j & 7;
      if (j < 8) transpose_tile(p.lru_wa + n * 4096, 64, (u16*)(ws + W_WAT) + n * 4096, 64, 0, 0, nullptr, tile);
      else transpose_tile(p.lru_wi + n * 4096, 64, (u16*)(ws + W_WIT) + n * 4096, 64, 0, 0, nullptr, tile);
    }
  }
  const size_t gt = (size_t)bid * 256 + tid, gstride = (size_t)nb * 256;
  for (size_t i = gt; i < 4096; i += gstride) {
    const float* s = (i < 2048) ? p.sk1 : p.sk2;
    size_t j = (i & 2047);
    const float4* sp = (const float4*)s + j * 2;
    float4 a = sp[0], b = sp[1];
    uint4 o = make_uint4(pk2(a.x, a.y), pk2(a.z, a.w), pk2(b.x, b.y), pk2(b.z, b.w));
    ((uint4*)(ws + ((i < 2048) ? W_K1B : W_K2B)))[j] = o;
  }
  for (size_t i = gt; i < 512; i += gstride) {
    float l = p.lru_lambda[i];
    float sp = (l < -15.f) ? -l : log1pf(expf(-l));
    ((float*)(ws + W_C8))[i] = -8.0f * sp;
  }
  for (size_t i = gt; i < 16 * 128 * 16; i += gstride) {
    int b = (int)(i >> 11), rem = (int)(i & 2047);
    int t = rem >> 4, c8i = rem & 15;
    const float4* sk = (const float4*)(p.cache_k + ((size_t)(b * 128 + t) * 128 + c8i * 8));
    float4 a = sk[0], bb = sk[1];
    uint4 o = make_uint4(pk2(a.x, a.y), pk2(a.z, a.w), pk2(bb.x, bb.y), pk2(bb.z, bb.w));
    *(uint4*)(ws + W_KS + ((size_t)(b * 192 + t) * 128 + c8i * 8) * 2) = o;
    const float4* sv = (const float4*)(p.cache_v + ((size_t)(b * 128 + t) * 128 + c8i * 8));
    float4 va = sv[0], vb = sv[1];
    if (t >= 16) {
      float4* dk = (float4*)(p.out + O_KS + ((size_t)(b * 128 + t - 16) * 128 + c8i * 8));
      dk[0] = a; dk[1] = bb;
      float4* dv = (float4*)(p.out + O_VS + ((size_t)(b * 128 + t - 16) * 128 + c8i * 8));
      dv[0] = va; dv[1] = vb;
    }
    u16* vt = (u16*)(ws + W_VTS) + (size_t)b * 128 * 192;
    float vv[8] = {va.x, va.y, va.z, va.w, vb.x, vb.y, vb.z, vb.w};
#pragma unroll
    for (int q = 0; q < 8; ++q) vt[(size_t)(c8i * 8 + q) * 192 + t] = (u16)(pk2(vv[q], 0.f) & 0xffffu);
  }
  for (size_t i = gt; i < 16 * 48 * 128; i += gstride) {
    int b = (int)(i / (48 * 128)), rem = (int)(i % (48 * 128));
    ((u16*)(ws + W_KS))[(size_t)(b * 192 + 144) * 128 + rem] = 0;
    int ch = rem / 48, tt = rem % 48;
    ((u16*)(ws + W_VTS))[(size_t)(b * 128 + ch) * 192 + 144 + tt] = 0;
  }
  {
    const int lane = tid & 63;
    const int gw = bid * 4 + (tid >> 6), nw = nb * 4;
    for (int m = gw; m < TT; m += nw) {
      const float* xr = (m < TP) ? (p.x_p + (size_t)m * 1024) : (p.x_s + (size_t)(m - TP) * 1024);
      const float4* xp = (const float4*)xr;
      float ss = 0.f;
      uint4* dst = (uint4*)(ws + W_XB + (size_t)m * 2048);
#pragma unroll
      for (int q = 0; q < 2; ++q) {
        float4 a = xp[q * 128 + lane * 2], b = xp[q * 128 + lane * 2 + 1];
        ss += a.x * a.x + a.y * a.y + a.z * a.z + a.w * a.w + b.x * b.x + b.y * b.y + b.z * b.z + b.w * b.w;
        dst[q * 64 + lane] = make_uint4(pk2(a.x, a.y), pk2(a.z, a.w), pk2(b.x, b.y), pk2(b.z, b.w));
      }
#pragma unroll
      for (int s = 32; s >= 1; s >>= 1) ss += __shfl_xor(ss, s);
      if (lane == 0) ((float*)(ws + W_RS1))[m] = rsqrtf(ss * (1.0f / 1024.0f) + EPS);
    }
  }
}

DI unsigned f2ord(float f) { unsigned u = __float_as_uint(f); return u ^ ((unsigned)((int)u >> 31) | 0x80000000u); }
DI float ord2f(unsigned u) { return __uint_as_float((u & 0x80000000u) ? (u ^ 0x80000000u) : ~u); }
DI void cas_desc(unsigned& a, unsigned& b) { unsigned mx = a > b ? a : b, mn = a > b ? b : a; a = mx; b = mn; }
DI void sort16_desc(unsigned (&v)[16]) {
#pragma unroll
  for (int k = 2; k <= 16; k <<= 1)
#pragma unroll
    for (int j = k >> 1; j > 0; j >>= 1)
#pragma unroll
      for (int i = 0; i < 16; ++i) {
        int l = i ^ j;
        if (l > i) {
          if ((i & k) == 0) cas_desc(v[i], v[l]); else cas_desc(v[l], v[i]);
        }
      }
}
DI void merge16_desc(unsigned (&v)[16]) {
#pragma unroll
  for (int j = 8; j > 0; j >>= 1)
#pragma unroll
    for (int i = 0; i < 16; ++i) {
      int l = i ^ j;
      if (l > i) cas_desc(v[i], v[l]);
    }
}
DI void merge_top16(unsigned (&a)[16], unsigned (&b)[16]) {
#pragma unroll
  for (int i = 0; i < 16; ++i) a[i] = a[i] > b[15 - i] ? a[i] : b[15 - i];
  merge16_desc(a);
}


template <int MODE>
DI void gemm_tile(const Params& p, int mt, int nt, char* smem) {
  constexpr int LROW = 144;
  char* ws = p.ws;
  const char* Wt = ws + (MODE == 1 ? W_WTIN : (MODE == 2 ? W_WTOUT : W_WTQ));
  const char* X = ws + (MODE == 1 ? W_XB : (MODE == 2 ? W_CAT : W_HB));
  char* sW = smem;
  char* sX = smem + 128 * LROW;
  const int tid = threadIdx.x, lane = tid & 63, w = tid >> 6, wn = w & 1, wm = w >> 1;
  const int tl = lane & 31, h = lane >> 5;
  const char* gW = Wt + (size_t)(nt * 128) * 2048;
  const char* gX = X + (size_t)(mt * 128) * 2048;
  u32x4 rW[4], rX[4];
  f32x16 acc[2][2];
#pragma unroll
  for (int i = 0; i < 2; ++i)
#pragma unroll
    for (int j = 0; j < 2; ++j)
#pragma unroll
      for (int r = 0; r < 16; ++r) acc[i][j][r] = 0.f;

  const int m_lane[2] = {mt * 128 + wm * 64 + tl, mt * 128 + wm * 64 + 32 + tl};
  float ratio[2] = {1.f, 1.f}, fscale[2] = {1.f, 1.f};
  if (MODE == 2) {
#pragma unroll
    for (int j = 0; j < 2; ++j) {
      const float4 sl = *(const float4*)(ws + W_SSQL + (size_t)m_lane[j] * 16);
      const float4 sa0 = *(const float4*)(ws + W_SSQA + (size_t)m_lane[j] * 32);
      const float4 sa1 = *(const float4*)(ws + W_SSQA + (size_t)m_lane[j] * 32 + 16);
      float rsl = rsqrtf((sl.x + sl.y + sl.z + sl.w) * (1.0f / 512.0f) + EPS);
      float rsa = rsqrtf((sa0.x + sa0.y + sa0.z + sa0.w + sa1.x + sa1.y + sa1.z + sa1.w) * (1.0f / 512.0f) + EPS);
      ratio[j] = rsl / rsa;
      fscale[j] = rsa;
    }
  } else if (MODE == 1) {
#pragma unroll
    for (int j = 0; j < 2; ++j) fscale[j] = ((const float*)(ws + W_RS1))[m_lane[j]];
  } else {
#pragma unroll
    for (int j = 0; j < 2; ++j) {
      const float4* sp = (const float4*)(ws + W_SSQ2 + (size_t)m_lane[j] * 64);
      float4 a = sp[0], b = sp[1], c = sp[2], d = sp[3];
      float s = a.x + a.y + a.z + a.w + b.x + b.y + b.z + b.w + c.x + c.y + c.z + c.w + d.x + d.y + d.z + d.w;
      fscale[j] = rsqrtf(s * (1.0f / 1024.0f) + EPS);
    }
  }

#pragma unroll
  for (int i = 0; i < 4; ++i) {
    int c = tid + 256 * i, row = c >> 3, kc = c & 7;
    rW[i] = *(const u32x4*)(gW + (size_t)row * 2048 + kc * 16);
    rX[i] = *(const u32x4*)(gX + (size_t)row * 2048 + kc * 16);
  }
  for (int ks = 0; ks < 16; ++ks) {
    __syncthreads();
#pragma unroll
    for (int i = 0; i < 4; ++i) {
      int c = tid + 256 * i, row = c >> 3, kc = c & 7;
      *(u32x4*)(sW + row * LROW + kc * 16) = rW[i];
      *(u32x4*)(sX + row * LROW + kc * 16) = rX[i];
    }
    __syncthreads();
    if (ks + 1 < 16) {
#pragma unroll
      for (int i = 0; i < 4; ++i) {
        int c = tid + 256 * i, row = c >> 3, kc = c & 7;
        rW[i] = *(const u32x4*)(gW + (size_t)row * 2048 + (ks + 1) * 128 + kc * 16);
        rX[i] = *(const u32x4*)(gX + (size_t)row * 2048 + (ks + 1) * 128 + kc * 16);
      }
    }
    if (MODE == 2 && ks == 8) {
#pragma unroll
      for (int i = 0; i < 2; ++i)
#pragma unroll
        for (int j = 0; j < 2; ++j)
#pragma unroll
          for (int r = 0; r < 16; ++r) acc[i][j][r] *= ratio[j];
    }
#pragma unroll
    for (int kk = 0; kk < 4; ++kk) {
      bf16x8 a[2], b[2];
#pragma unroll
      for (int i = 0; i < 2; ++i) a[i] = *(const bf16x8*)(sW + (wn * 64 + i * 32 + tl) * LROW + kk * 32 + h * 16);
#pragma unroll
      for (int j = 0; j < 2; ++j) b[j] = *(const bf16x8*)(sX + (wm * 64 + j * 32 + tl) * LROW + kk * 32 + h * 16);
#pragma unroll
      for (int i = 0; i < 2; ++i)
#pragma unroll
        for (int j = 0; j < 2; ++j) acc[i][j] = MFMA32(a[i], b[j], acc[i][j]);
    }
  }

  const int ncol0 = nt * 128 + wn * 64;
  if (MODE == 1) {
    if (ncol0 < 512) {
#pragma unroll
      for (int j = 0; j < 2; ++j) {
        const int m = m_lane[j];
        float* convdst = nullptr;
        if (m < TP) {
          int t = m & 2047;
          if (t >= 2045) convdst = p.out + O_CONVP + (size_t)((m >> 11) * 3 + (t - 2045)) * 512;
        } else {
          int ms = m - TP, t = ms & 15;
          if (t >= 13) convdst = p.out + O_CONVS + (size_t)((ms >> 4) * 3 + (t - 13)) * 512;
        }
        u16* ub = (u16*)(ws + W_U) + (size_t)m * 512;
#pragma unroll
        for (int i = 0; i < 2; ++i)
#pragma unroll
          for (int g = 0; g < 4; ++g) {
            int n = ncol0 + i * 32 + 8 * g + 4 * h;
            float v0 = acc[i][j][4 * g] * fscale[j], v1 = acc[i][j][4 * g + 1] * fscale[j],
                  v2 = acc[i][j][4 * g + 2] * fscale[j], v3 = acc[i][j][4 * g + 3] * fscale[j];
            *(uint2*)(ub + n) = make_uint2(pk2(v0, v1), pk2(v2, v3));
            if (convdst) *(float4*)(convdst + n) = make_float4(v0, v1, v2, v3);
          }
      }
    } else if (ncol0 < 1024) {
#pragma unroll
      for (int j = 0; j < 2; ++j) {
        u16* gb = (u16*)(ws + W_GG) + (size_t)m_lane[j] * 512;
#pragma unroll
        for (int i = 0; i < 2; ++i)
#pragma unroll
          for (int g = 0; g < 4; ++g) {
            int n = ncol0 - 512 + i * 32 + 8 * g + 4 * h;
            float v0 = gelu_(acc[i][j][4 * g] * fscale[j]), v1 = gelu_(acc[i][j][4 * g + 1] * fscale[j]),
                  v2 = gelu_(acc[i][j][4 * g + 2] * fscale[j]), v3 = gelu_(acc[i][j][4 * g + 3] * fscale[j]);
            *(uint2*)(gb + n) = make_uint2(pk2(v0, v1), pk2(v2, v3));
          }
      }
    } else if (ncol0 < 1664) {
      const bool isq = ncol0 < 1536;
      const float* gain = isq ? p.q_g : p.k_g;
      const float post = isq ? 0.125f : 1.0f;
#pragma unroll
      for (int j = 0; j < 2; ++j) {
        const int m = m_lane[j];
        float ss = 0.f;
#pragma unroll
        for (int i = 0; i < 2; ++i)
#pragma unroll
          for (int r = 0; r < 16; ++r) {
            float v = acc[i][j][r] * fscale[j];
            ss += v * v;
          }
        ss += __shfl_xor(ss, 32);
        const float sc = fscale[j] * rsqrtf(ss * (1.0f / 64.0f) + EPS) * post;
        u16* dst;
        float* fdst = nullptr;
        int nloc0;
        if (isq) {
          nloc0 = ncol0 - 1024;
          dst = (u16*)(ws + W_Q) + (size_t)m * 512 + nloc0;
        } else {
          nloc0 = ncol0 - 1536;
          if (m < TP) {
            dst = (u16*)(ws + W_KP) + (size_t)m * 128 + nloc0;
            int t = m & 2047;
            if (t >= 1920) fdst = p.out + O_KP + (size_t)((m >> 11) * 128 + (t - 1920)) * 128 + nloc0;
          } else {
            int ms = m - TP, b = ms >> 4, t = ms & 15;
            dst = (u16*)(ws + W_KS) + (size_t)(b * 192 + 128 + t) * 128 + nloc0;
            fdst = p.out + O_KS + (size_t)(b * 128 + 112 + t) * 128 + nloc0;
          }
        }
#pragma unroll
        for (int i = 0; i < 2; ++i)
#pragma unroll
          for (int g = 0; g < 4; ++g) {
            int d = i * 32 + 8 * g + 4 * h;
            const float4 gn = *(const float4*)(gain + d);
            float v0 = acc[i][j][4 * g] * sc * gn.x, v1 = acc[i][j][4 * g + 1] * sc * gn.y,
                  v2 = acc[i][j][4 * g + 2] * sc * gn.z, v3 = acc[i][j][4 * g + 3] * sc * gn.w;
            *(uint2*)(dst + d) = make_uint2(pk2(v0, v1), pk2(v2, v3));
            if (fdst) *(float4*)(fdst + d) = make_float4(v0, v1, v2, v3);
          }
      }
    } else {
#pragma unroll
      for (int j = 0; j < 2; ++j) {
        const int m = m_lane[j];
        u16* vt;
        size_t vstride;
        float* fdst = nullptr;
        const int ch0 = ncol0 - 1664;
        if (m < TP) {
          int b = m >> 11, t = m & 2047;
          vt = (u16*)(ws + W_VTP) + (size_t)b * 128 * 2048 + t;
          vstride = 2048;
          if (t >= 1920) fdst = p.out + O_VP + (size_t)(b * 128 + (t - 1920)) * 128;
        } else {
          int ms = m - TP, b = ms >> 4, t = ms & 15;
          vt = (u16*)(ws + W_VTS) + (size_t)b * 128 * 192 + 128 + t;
          vstride = 192;
          fdst = p.out + O_VS + (size_t)(b * 128 + 112 + t) * 128;
        }
#pragma unroll
        for (int i = 0; i < 2; ++i)
#pragma unroll
          for (int g = 0; g < 4; ++g) {
            int ch = ch0 + i * 32 + 8 * g + 4 * h;
            float v0 = acc[i][j][4 * g] * fscale[j], v1 = acc[i][j][4 * g + 1] * fscale[j],
                  v2 = acc[i][j][4 * g + 2] * fscale[j], v3 = acc[i][j][4 * g + 3] * fscale[j];
            unsigned p01 = pk2(v0, v1), p23 = pk2(v2, v3);
            vt[(size_t)(ch + 0) * vstride] = (u16)(p01 & 0xffffu);
            vt[(size_t)(ch + 1) * vstride] = (u16)(p01 >> 16);
            vt[(size_t)(ch + 2) * vstride] = (u16)(p23 & 0xffffu);
            vt[(size_t)(ch + 3) * vstride] = (u16)(p23 >> 16);
            if (fdst) *(float4*)(fdst + ch) = make_float4(v0, v1, v2, v3);
          }
      }
    }
  } else if (MODE == 2) {
#pragma unroll
    for (int j = 0; j < 2; ++j) {
      const int m = m_lane[j];
      const float* xr = (m < TP) ? (p.x_p + (size_t)m * 1024) : (p.x_s + (size_t)(m - TP) * 1024);
      float* yr = p.out + O_Y + (size_t)m * 1024;
      u16* hb = (u16*)(ws + W_HB) + (size_t)m * 1024;
      float ss = 0.f;
#pragma unroll
      for (int i = 0; i < 2; ++i)
#pragma unroll
        for (int g = 0; g < 4; ++g) {
          int n = ncol0 + i * 32 + 8 * g + 4 * h;
          const float4 xv = *(const float4*)(xr + n);
          float v0 = xv.x + acc[i][j][4 * g] * fscale[j], v1 = xv.y + acc[i][j][4 * g + 1] * fscale[j],
                v2 = xv.z + acc[i][j][4 * g + 2] * fscale[j], v3 = xv.w + acc[i][j][4 * g + 3] * fscale[j];
          *(float4*)(yr + n) = make_float4(v0, v1, v2, v3);
          *(uint2*)(hb + n) = make_uint2(pk2(v0, v1), pk2(v2, v3));
          ss += v0 * v0 + v1 * v1 + v2 * v2 + v3 * v3;
        }
      ss += __shfl_xor(ss, 32);
      if (h == 0) ((float*)(ws + W_SSQ2))[(size_t)m * 16 + nt * 2 + wn] = ss;
    }
  } else {
    unsigned* Lx = (unsigned*)smem;
    unsigned topj[2][16];
#pragma unroll
    for (int j = 0; j < 2; ++j) {
      if (nt == 0 && wn == 0 && h == 0) ((float*)(ws + W_RS2))[m_lane[j]] = fscale[j];
      unsigned tmp[16];
#pragma unroll
      for (int r = 0; r < 16; ++r) topj[j][r] = (f2ord(acc[0][j][r] * fscale[j]) & ~127u) | (unsigned)(127 - (wn * 64 + crow(r, h)));
      sort16_desc(topj[j]);
#pragma unroll
      for (int r = 0; r < 16; ++r) tmp[r] = (f2ord(acc[1][j][r] * fscale[j]) & ~127u) | (unsigned)(127 - (wn * 64 + 32 + crow(r, h)));
      sort16_desc(tmp);
      merge_top16(topj[j], tmp);
#pragma unroll
      for (int i = 0; i < 16; ++i) tmp[i] = __shfl_xor(topj[j][i], 32);
      merge_top16(topj[j], tmp);
    }
    __syncthreads();
    if (wn == 1 && h == 0) {
#pragma unroll
      for (int j = 0; j < 2; ++j) {
        u32x4* d4 = (u32x4*)(Lx + ((wm * 2 + j) * 32 + tl) * 16);
#pragma unroll
        for (int q = 0; q < 4; ++q) { u32x4 v4; v4[0] = topj[j][4 * q]; v4[1] = topj[j][4 * q + 1]; v4[2] = topj[j][4 * q + 2]; v4[3] = topj[j][4 * q + 3]; d4[q] = v4; }
      }
    }
    __syncthreads();
    if (wn == 0 && h == 0) {
#pragma unroll
      for (int j = 0; j < 2; ++j) {
        unsigned tmp[16];
        const u32x4* s4 = (const u32x4*)(Lx + ((wm * 2 + j) * 32 + tl) * 16);
#pragma unroll
        for (int q = 0; q < 4; ++q) { const u32x4 v4 = s4[q]; tmp[4 * q] = v4[0]; tmp[4 * q + 1] = v4[1]; tmp[4 * q + 2] = v4[2]; tmp[4 * q + 3] = v4[3]; }
        merge_top16(topj[j], tmp);
        u32x4* g4 = (u32x4*)((unsigned*)(ws + W_TOPL) + ((size_t)m_lane[j] * 16 + nt) * 16);
#pragma unroll
        for (int q = 0; q < 4; ++q) { u32x4 v4; v4[0] = topj[j][4 * q]; v4[1] = topj[j][4 * q + 1]; v4[2] = topj[j][4 * q + 2]; v4[3] = topj[j][4 * q + 3]; g4[q] = v4; }
      }
    }
  }
}

#define SCAN_STEP(CTRL) { \
    const float Ap = __uint_as_float(__builtin_amdgcn_update_dpp(0x3f800000u, __float_as_uint(A), CTRL, 0xF, 0xF, false)); \
    const float Hp = __uint_as_float(__builtin_amdgcn_update_dpp(0u, __float_as_uint(H), CTRL, 0xF, 0xF, false)); \
    H = A * Hp + H; A = A * Ap; }
template <int FINAL>
DI void lru_item(const Params& p, int item, char* smem) {
  char* ws = p.ws;
  const bool samp = item >= 512;
  int b, c, m0, nvalid;
  if (!samp) { b = item >> 6; c = item & 63; m0 = b * 2048 + c * 32; nvalid = 32; }
  else { b = item - 512; c = 0; m0 = TP + b * 16; nvalid = 16; }
  const int tid = threadIdx.x, lane = tid & 63, w = tid >> 6, tl = lane & 31, h = lane >> 5;
  u16* XC = (u16*)smem;
  float* hin = (float*)(smem + 32 * 1040);
  __syncthreads();
  {
    const int ch = 2 * tid;
    const float2 w0 = *(const float2*)(p.conv_w + ch), w1 = *(const float2*)(p.conv_w + 512 + ch),
                 w2 = *(const float2*)(p.conv_w + 1024 + ch), w3 = *(const float2*)(p.conv_w + 1536 + ch),
                 cb = *(const float2*)(p.conv_b + ch);
    float2 r0 = {0.f, 0.f}, r1 = {0.f, 0.f}, r2 = {0.f, 0.f};
    const u16* ub = (const u16*)(ws + W_U);
    if (!samp) {
      if (c > 0) {
        unsigned a0 = *(const unsigned*)(ub + (size_t)(m0 - 3) * 512 + ch), a1 = *(const unsigned*)(ub + (size_t)(m0 - 2) * 512 + ch),
                 a2 = *(const unsigned*)(ub + (size_t)(m0 - 1) * 512 + ch);
        r0 = {bf_lo(a0), bf_hi(a0)}; r1 = {bf_lo(a1), bf_hi(a1)}; r2 = {bf_lo(a2), bf_hi(a2)};
      }
    } else {
      const float* sc = p.state_conv + (size_t)b * 3 * 512 + ch;
      r0 = *(const float2*)(sc); r1 = *(const float2*)(sc + 512); r2 = *(const float2*)(sc + 1024);
    }
    unsigned uraw[32];
#pragma unroll
    for (int t = 0; t < 32; ++t) uraw[t] = (t < nvalid) ? *(const unsigned*)(ub + (size_t)(m0 + t) * 512 + ch) : 0u;
#pragma unroll
    for (int t = 0; t < 32; ++t) {
      float2 cur = {bf_lo(uraw[t]), bf_hi(uraw[t])};
      float x0 = cb.x + w0.x * r0.x + w1.x * r1.x + w2.x * r2.x + w3.x * cur.x;
      float x1 = cb.y + w0.y * r0.y + w1.y * r1.y + w2.y * r2.y + w3.y * cur.y;
      *(unsigned*)(XC + t * 520 + ch) = pk2(x0, x1);
      r0 = r1; r1 = r2; r2 = cur;
    }
    if (FINAL) {
      float2 hh;
      if (samp) hh = *(const float2*)(p.state_lru + (size_t)b * 512 + ch);
      else {
        hh = {0.f, 0.f};
        const float* sA = (const float*)(ws + W_SUMA) + (size_t)(b * 64) * 512 + ch;
        const float* sH = (const float*)(ws + W_SUMH) + (size_t)(b * 64) * 512 + ch;
        int cc = 0;
        for (; cc + 4 <= c; cc += 4) {
          float2 A0 = *(const float2*)(sA + (size_t)(cc + 0) * 512), H0 = *(const float2*)(sH + (size_t)(cc + 0) * 512);
          float2 A1 = *(const float2*)(sA + (size_t)(cc + 1) * 512), H1 = *(const float2*)(sH + (size_t)(cc + 1) * 512);
          float2 A2 = *(const float2*)(sA + (size_t)(cc + 2) * 512), H2 = *(const float2*)(sH + (size_t)(cc + 2) * 512);
          float2 A3 = *(const float2*)(sA + (size_t)(cc + 3) * 512), H3 = *(const float2*)(sH + (size_t)(cc + 3) * 512);
          hh.x = A0.x * hh.x + H0.x; hh.y = A0.y * hh.y + H0.y;
          hh.x = A1.x * hh.x + H1.x; hh.y = A1.y * hh.y + H1.y;
          hh.x = A2.x * hh.x + H2.x; hh.y = A2.y * hh.y + H2.y;
          hh.x = A3.x * hh.x + H3.x; hh.y = A3.y * hh.y + H3.y;
        }
        for (; cc < c; ++cc) {
          float2 A0 = *(const float2*)(sA + (size_t)cc * 512), H0 = *(const float2*)(sH + (size_t)cc * 512);
          hh.x = A0.x * hh.x + H0.x; hh.y = A0.y * hh.y + H0.y;
        }
      }
      hin[ch] = hh.x; hin[ch + 1] = hh.y;
    }
  }
  __syncthreads();
  const u16* WaT = (const u16*)(ws + W_WAT);
  const u16* WiT = (const u16*)(ws + W_WIT);
  const float* c8 = (const float*)(ws + W_C8);
  const int m = m0 + tl;
  const bool valid = tl < nvalid;
  float ssq = 0.f;
#pragma unroll 1
  for (int nbk = 0; nbk < 2; ++nbk) {
    const int n = 2 * w + nbk;
    f32x16 accA[2], accI[2];
#pragma unroll
    for (int i = 0; i < 2; ++i)
#pragma unroll
      for (int r = 0; r < 16; ++r) { accA[i][r] = 0.f; accI[i][r] = 0.f; }
#pragma unroll
    for (int kk = 0; kk < 4; ++kk) {
      const bf16x8 bx = *(const bf16x8*)((const char*)XC + tl * 1040 + (n * 64 + kk * 16 + h * 8) * 2);
#pragma unroll
      for (int i = 0; i < 2; ++i) {
        const bf16x8 aa = *(const bf16x8*)(WaT + (size_t)(n * 64 + i * 32 + tl) * 64 + kk * 16 + h * 8);
        const bf16x8 ai = *(const bf16x8*)(WiT + (size_t)(n * 64 + i * 32 + tl) * 64 + kk * 16 + h * 8);
        accA[i] = MFMA32(aa, bx, accA[i]);
        accI[i] = MFMA32(ai, bx, accI[i]);
      }
    }
#pragma unroll
    for (int i = 0; i < 2; ++i)
#pragma unroll
      for (int g = 0; g < 4; ++g) {
        const int ch = n * 64 + i * 32 + 8 * g + 4 * h;
        const float4 ba4 = *(const float4*)(p.lru_ba + ch), bi4 = *(const float4*)(p.lru_bi + ch), c84 = *(const float4*)(c8 + ch);
        const float bav[4] = {ba4.x, ba4.y, ba4.z, ba4.w}, biv[4] = {bi4.x, bi4.y, bi4.z, bi4.w}, c8v[4] = {c84.x, c84.y, c84.z, c84.w};
        const uint2 xcp = *(const uint2*)(XC + tl * 520 + ch);
        const float xcv[4] = {bf_lo(xcp.x), bf_hi(xcp.x), bf_lo(xcp.y), bf_hi(xcp.y)};
        float hv[4];
#pragma unroll
        for (int q = 0; q < 4; ++q) {
          const int r = 4 * g + q;
          float rr = sigmoidf_(accA[i][r] + bav[q]);
          float ii = sigmoidf_(accI[i][r] + biv[q]);
          float la = c8v[q] * rr;
          float A = __expf(la);
          float x2 = 2.0f * la;
          float em = -x2 * (1.0f + x2 * (0.5f + x2 * (0.16666667f + x2 * (0.041666668f + x2 * (0.0083333333f + x2 * 0.0013888889f)))));
          float H = sqrtf(fmaxf(em, 0.f)) * ii * xcv[q];
          SCAN_STEP(0x111) SCAN_STEP(0x112) SCAN_STEP(0x114) SCAN_STEP(0x118)
          {
            const float Ap = __uint_as_float(__builtin_amdgcn_update_dpp(0x3f800000u, __float_as_uint(A), 0x142, 0xA, 0xF, false));
            const float Hp = __uint_as_float(__builtin_amdgcn_update_dpp(0u, __float_as_uint(H), 0x142, 0xA, 0xF, false));
            H = A * Hp + H; A = A * Ap;
          }
          if (!FINAL) {
            if (tl == 31) {
              ((float*)(ws + W_SUMA))[(size_t)(b * 64 + c) * 512 + ch + q] = A;
              ((float*)(ws + W_SUMH))[(size_t)(b * 64 + c) * 512 + ch + q] = H;
            }
          } else {
            hv[q] = H + A * hin[ch + q];
          }
        }
        if (FINAL) {
          if (tl == nvalid - 1 && (samp || c == 63)) {
            float* dst = p.out + (samp ? O_LRUS : O_LRUP) + (size_t)b * 512 + ch;
            *(float4*)dst = make_float4(hv[0], hv[1], hv[2], hv[3]);
          }
          if (valid) {
            const uint2 gp = *(const uint2*)((const u16*)(ws + W_GG) + (size_t)m * 512 + ch);
            float o0 = hv[0] * bf_lo(gp.x), o1 = hv[1] * bf_hi(gp.x), o2 = hv[2] * bf_lo(gp.y), o3 = hv[3] * bf_hi(gp.y);
            ssq += o0 * o0 + o1 * o1 + o2 * o2 + o3 * o3;
            *(uint2*)((u16*)(ws + W_CAT) + (size_t)m * 1024 + ch) = make_uint2(pk2(o0, o1), pk2(o2, o3));
          }
        }
      }
  }
  if (FINAL) {
    ssq += __shfl_xor(ssq, 32);
    if (valid && h == 0) ((float*)(ws + W_SSQL))[(size_t)m * 4 + w] = ssq;
  }
}

DI void attn_item(const Params& p, int item, char* smem) {
  char* ws = p.ws;
  const int tid = threadIdx.x, lane = tid & 63, w = tid >> 6, tl = lane & 31, h = lane >> 5;
  const bool samp = item >= 512;
  int b, c, g;
  const u16* Kb; const u16* Vt; int vstride, kc_lo, kc_hi, nkeys, mq0; bool qvalid;
  if (!samp) {
    b = item >> 6; c = (item >> 1) & 31; g = item & 1;
    Kb = (const u16*)(ws + W_KP) + (size_t)b * 2048 * 128;
    Vt = (const u16*)(ws + W_VTP) + (size_t)b * 128 * 2048;
    vstride = 2048; kc_lo = (c >= 2) ? c - 2 : 0; kc_hi = c; nkeys = 1 << 30;
    mq0 = b * 2048 + c * 64 + tl; qvalid = true;
  } else {
    int it = item - 512; b = it >> 1; g = it & 1; c = 0;
    Kb = (const u16*)(ws + W_KS) + (size_t)b * 192 * 128;
    Vt = (const u16*)(ws + W_VTS) + (size_t)b * 128 * 192;
    vstride = 192; kc_lo = 0; kc_hi = 2; nkeys = 144;
    mq0 = TP + b * 16 + (tl & 15); qvalid = tl < 16;
  }
  const int hq = g * 4 + w;
  const float sink = p.sinks[hq];
  char* sK = smem;
  char* sV = smem + 192 * 144;
  const int nch = kc_hi - kc_lo + 1;
  const int nj = samp ? 1 : 2;
  bf16x8 bq[2][4];
#pragma unroll
  for (int j = 0; j < 2; ++j)
#pragma unroll
    for (int kk = 0; kk < 4; ++kk)
      bq[j][kk] = *(const bf16x8*)((const u16*)(ws + W_Q) + (size_t)(mq0 + (samp ? 0 : j * 32)) * 512 + hq * 64 + kk * 16 + h * 8);
  __syncthreads();
  {
    u32x4 kr[6], vr[6];
#pragma unroll
    for (int i = 0; i < 6; ++i) {
      const int idx = tid + 256 * i;
      const int key = idx >> 3, part = idx & 7;
      if (key < nch * 64) kr[i] = *(const u32x4*)(Kb + (size_t)(kc_lo * 64 + key) * 128 + g * 64 + part * 8);
      const int d = idx / 24, pv = idx % 24;
      if (pv < nch * 8) vr[i] = *(const u32x4*)(Vt + (size_t)(g * 64 + d) * vstride + kc_lo * 64 + pv * 8);
    }
#pragma unroll
    for (int i = 0; i < 6; ++i) {
      const int idx = tid + 256 * i;
      const int key = idx >> 3, part = idx & 7;
      if (key < nch * 64) *(u32x4*)(sK + key * 144 + part * 16) = kr[i];
      const int d = idx / 24, pv = idx % 24;
      if (pv < nch * 8) *(u32x4*)(sV + d * 400 + pv * 16) = vr[i];
    }
  }
  __syncthreads();
#pragma unroll
  for (int j = 0; j < 2; ++j) {
    if (j < nj) {
    const int mqj = mq0 + j * 32;
    float mrun = sink, lrun = 1.f;
    f32x16 O[2];
#pragma unroll
    for (int i = 0; i < 2; ++i)
#pragma unroll
      for (int r = 0; r < 16; ++r) O[i][r] = 0.f;
#pragma unroll 1
    for (int kc = 0; kc < nch; ++kc) {
      f32x16 S[2];
#pragma unroll
      for (int i = 0; i < 2; ++i)
#pragma unroll
        for (int r = 0; r < 16; ++r) S[i][r] = 0.f;
#pragma unroll
      for (int kk = 0; kk < 4; ++kk)
#pragma unroll
        for (int kt = 0; kt < 2; ++kt) {
          const bf16x8 ak = *(const bf16x8*)(sK + (kc * 64 + kt * 32 + tl) * 144 + kk * 32 + h * 16);
          S[kt] = MFMA32(ak, bq[j][kk], S[kt]);
        }
      if (samp) {
#pragma unroll
        for (int kt = 0; kt < 2; ++kt)
#pragma unroll
          for (int r = 0; r < 16; ++r) {
            int key = kc * 64 + kt * 32 + crow(r, h);
            if (key >= nkeys) S[kt][r] = -INFINITY;
          }
      }
      {
        float mx = -INFINITY;
#pragma unroll
        for (int kt = 0; kt < 2; ++kt)
#pragma unroll
          for (int r = 0; r < 16; ++r) mx = fmaxf(mx, S[kt][r]);
        mx = fmaxf(mx, __shfl_xor(mx, 32));
        const float mnew = fmaxf(mrun, mx);
        const float alpha = __expf(mrun - mnew);
        float ps = 0.f;
#pragma unroll
        for (int kt = 0; kt < 2; ++kt)
#pragma unroll
          for (int r = 0; r < 16; ++r) {
            float pv = __expf(S[kt][r] - mnew);
            S[kt][r] = pv;
            ps += pv;
          }
        ps += __shfl_xor(ps, 32);
        lrun = lrun * alpha + ps;
        mrun = mnew;
#pragma unroll
        for (int dt = 0; dt < 2; ++dt)
#pragma unroll
          for (int r = 0; r < 16; ++r) O[dt][r] *= alpha;
      }
#pragma unroll
      for (int kt = 0; kt < 2; ++kt)
#pragma unroll
        for (int s2 = 0; s2 < 2; ++s2) {
          u32x4 pp;
          pp[0] = pk2(S[kt][8 * s2 + 0], S[kt][8 * s2 + 1]);
          pp[1] = pk2(S[kt][8 * s2 + 2], S[kt][8 * s2 + 3]);
          pp[2] = pk2(S[kt][8 * s2 + 4], S[kt][8 * s2 + 5]);
          pp[3] = pk2(S[kt][8 * s2 + 6], S[kt][8 * s2 + 7]);
          const bf16x8 bp = __builtin_bit_cast(bf16x8, pp);
#pragma unroll
          for (int dt = 0; dt < 2; ++dt) {
            const int d = dt * 32 + tl;
            const uint2 lo = *(const uint2*)(sV + d * 400 + (kc * 64 + kt * 32 + 16 * s2 + 4 * h) * 2);
            const uint2 hi = *(const uint2*)(sV + d * 400 + (kc * 64 + kt * 32 + 16 * s2 + 8 + 4 * h) * 2);
            u32x4 av4;
            av4[0] = lo.x; av4[1] = lo.y; av4[2] = hi.x; av4[3] = hi.y;
            O[dt] = MFMA32(__builtin_bit_cast(bf16x8, av4), bp, O[dt]);
          }
        }
    }
    const float inv = 1.0f / lrun;
    float ss = 0.f;
    u16* dst = (u16*)(ws + W_CAT) + (size_t)mqj * 1024 + 512 + hq * 64;
#pragma unroll
    for (int dt = 0; dt < 2; ++dt)
#pragma unroll
      for (int g4 = 0; g4 < 4; ++g4) {
        int d = dt * 32 + 8 * g4 + 4 * h;
        float v0 = O[dt][4 * g4] * inv, v1 = O[dt][4 * g4 + 1] * inv, v2 = O[dt][4 * g4 + 2] * inv, v3 = O[dt][4 * g4 + 3] * inv;
        ss += v0 * v0 + v1 * v1 + v2 * v2 + v3 * v3;
        if (qvalid) *(uint2*)(dst + d) = make_uint2(pk2(v0, v1), pk2(v2, v3));
      }
    ss += __shfl_xor(ss, 32);
    if (qvalid && h == 0) ((float*)(ws + W_SSQA))[(size_t)mqj * 8 + hq] = ss;
    }
  }
}

struct CandTab { int i[64]; int j[64]; int n; };
constexpr CandTab make_tab() {
  CandTab t{};
  int n = 0;
  for (int i = 0; i < 16; ++i)
    for (int j = 0; j < 16; ++j)
      if ((i + 1) * (j + 1) <= 16) { t.i[n] = i; t.j[n] = j; ++n; }
  t.n = n;
  return t;
}

DI void route2(const Params& p, char* smem) {
  char* ws = p.ws;
  constexpr CandTab CT = make_tab();
  const int tid = threadIdx.x;
  unsigned* Lp = (unsigned*)smem + tid * 33;
  for (int base = blockIdx.x * 256; base < TT * 8; base += gridDim.x * 256) {
    const int it = base + tid;
    const int mm = it >> 3, hd = it & 7;
    unsigned l1[16], l2[16];
    {
      const u32x4* s1 = (const u32x4*)((const unsigned*)(ws + W_TOPL) + ((size_t)mm * 16 + hd * 2) * 16);
#pragma unroll
      for (int q = 0; q < 4; ++q) {
        const u32x4 a = s1[q], b = s1[4 + q];
        l1[4 * q] = a[0]; l1[4 * q + 1] = a[1]; l1[4 * q + 2] = a[2]; l1[4 * q + 3] = a[3];
        l2[4 * q] = b[0]; l2[4 * q + 1] = b[1]; l2[4 * q + 2] = b[2]; l2[4 * q + 3] = b[3];
      }
    }
#pragma unroll
    for (int i = 0; i < 16; ++i) { Lp[i] = l1[i]; Lp[16 + i] = l2[i]; }
    float f1[16], f2[16];
#pragma unroll
    for (int i = 0; i < 16; ++i) { f1[i] = ord2f(l1[i] & ~127u); f2[i] = ord2f(l2[i] & ~127u); }
    unsigned top[16], tmp[16];
#pragma unroll
    for (int grp = 0; grp < 4; ++grp) {
#pragma unroll
      for (int q = 0; q < 16; ++q) {
        const int cidx = grp * 16 + q;
        unsigned key = 0;
        if (cidx < CT.n) {
          const int ci = CT.i[cidx], cj = CT.j[cidx];
          key = (f2ord(f1[ci] + f2[cj]) & ~255u) | (unsigned)(255 - (ci * 16 + cj));
        }
        if (grp == 0) top[q] = key; else tmp[q] = key;
      }
      if (grp == 0) sort16_desc(top);
      else { sort16_desc(tmp); merge_top16(top, tmp); }
    }
    float sv[16]; int ex[16];
    float smax = -INFINITY;
#pragma unroll
    for (int q = 0; q < 16; ++q) {
      const int code = 255 - (int)(top[q] & 255u);
      const int ci = code >> 4, cj = code & 15;
      const unsigned a = Lp[ci], bb = Lp[16 + cj];
      const int i1 = 127 - (int)(a & 127u), i2 = 127 - (int)(bb & 127u);
      sv[q] = ord2f(a & ~127u) + ord2f(bb & ~127u);
      ex[q] = i1 * 128 + i2;
      smax = fmaxf(smax, sv[q]);
    }
    float sum = 0.f;
#pragma unroll
    for (int q = 0; q < 16; ++q) { sv[q] = __expf(sv[q] - smax); sum += sv[q]; }
    const float inv = 1.0f / sum;
    int4* di = (int4*)((int*)(ws + W_SIDX) + (size_t)mm * 128 + hd * 16);
    float4* dg = (float4*)((float*)(ws + W_SGATE) + (size_t)mm * 128 + hd * 16);
#pragma unroll
    for (int q = 0; q < 4; ++q) {
      di[q] = make_int4(ex[4 * q], ex[4 * q + 1], ex[4 * q + 2], ex[4 * q + 3]);
      dg[q] = make_float4(sv[4 * q] * inv, sv[4 * q + 1] * inv, sv[4 * q + 2] * inv, sv[4 * q + 3] * inv);
    }
  }
}

DI void peer_u_phase(const Params& p) {
  char* ws = p.ws;
  const int lane = threadIdx.x & 63, w = threadIdx.x >> 6, g = lane >> 3, li = lane & 7;
  const int v = blockIdx.x & 7, bx = blockIdx.x >> 3, nbx = (gridDim.x - v + 7) >> 3;
  const int gwx = bx * 4 + w, nwx = nbx * 4;
  const char* Us = ws + W_UB + (size_t)v * 16384 * 128;
  const unsigned loff = li * 16;
  const int* sidx = (const int*)(ws + W_SIDX) + g * 16;
  int4 ix[4];
  u32x4 hq0, hq1;
  int m = gwx;
  if (m < TT) {
#pragma unroll
    for (int q = 0; q < 4; ++q) ix[q] = ((const int4*)(sidx + (size_t)m * 128))[q];
    const u32x4* hp = (const u32x4*)(ws + W_HB + (size_t)m * 2048 + v * 256 + li * 32);
    hq0 = hp[0]; hq1 = hp[1];
  }
  for (; m < TT; m += nwx) {
    const int idx[16] = {ix[0].x, ix[0].y, ix[0].z, ix[0].w, ix[1].x, ix[1].y, ix[1].z, ix[1].w,
                         ix[2].x, ix[2].y, ix[2].z, ix[2].w, ix[3].x, ix[3].y, ix[3].z, ix[3].w};
    u32x4 rows[16];
#pragma unroll
    for (int s2 = 0; s2 < 16; ++s2) rows[s2] = *(const u32x4*)(Us + (((unsigned)idx[s2] << 7) + loff));
    fl2_t hv[8];
    hv[0] = {bf_lo(hq0[0]), bf_hi(hq0[0])}; hv[1] = {bf_lo(hq0[1]), bf_hi(hq0[1])};
    hv[2] = {bf_lo(hq0[2]), bf_hi(hq0[2])}; hv[3] = {bf_lo(hq0[3]), bf_hi(hq0[3])};
    hv[4] = {bf_lo(hq1[0]), bf_hi(hq1[0])}; hv[5] = {bf_lo(hq1[1]), bf_hi(hq1[1])};
    hv[6] = {bf_lo(hq1[2]), bf_hi(hq1[2])}; hv[7] = {bf_lo(hq1[3]), bf_hi(hq1[3])};
    const int mn = m + nwx;
    if (mn < TT) {
#pragma unroll
      for (int q = 0; q < 4; ++q) ix[q] = ((const int4*)(sidx + (size_t)mn * 128))[q];
      const u32x4* hp = (const u32x4*)(ws + W_HB + (size_t)mn * 2048 + v * 256 + li * 32);
      hq0 = hp[0]; hq1 = hp[1];
    }
    float ps[16];
#pragma unroll
    for (int s2 = 0; s2 < 16; ++s2) {
      fl2_t acc = {0.f, 0.f};
#pragma unroll
      for (int d = 0; d < 4; ++d) {
        const fl2_t lo = __builtin_amdgcn_cvt_pk_f32_fp8((int)rows[s2][d], false);
        const fl2_t hi = __builtin_amdgcn_cvt_pk_f32_fp8((int)rows[s2][d], true);
        acc = __builtin_elementwise_fma(lo, hv[2 * d], acc);
        acc = __builtin_elementwise_fma(hi, hv[2 * d + 1], acc);
      }
      ps[s2] = acc.x + acc.y;
    }
#pragma unroll
    for (int st = 0; st < 3; ++st) {
      const int bit = 4 >> st, half = 8 >> st;
      const bool upper = (li & bit) != 0;
#pragma unroll
      for (int i = 0; i < half; ++i) {
        const float send = upper ? ps[i] : ps[i + half];
        const float keep = upper ? ps[i + half] : ps[i];
        ps[i] = keep + __shfl_xor(send, bit);
      }
    }
    const int sl = ((li >> 2) & 1) * 8 + ((li >> 1) & 1) * 4 + (li & 1) * 2;
    *(float2*)((float*)(ws + W_PART) + ((size_t)m * 8 + v) * 128 + g * 16 + sl) = make_float2(ps[0], ps[1]);
  }
}

DI void peer_combine(const Params& p) {
  char* ws = p.ws;
  const size_t gt = (size_t)blockIdx.x * 256 + threadIdx.x, gstride = (size_t)gridDim.x * 256;
  for (size_t i = gt; i < (size_t)TT * 128; i += gstride) {
    const size_t m = i >> 7, sl = i & 127;
    const float* pp = (const float*)(ws + W_PART) + m * 1024 + sl;
    float d = 0.f;
#pragma unroll
    for (int v = 0; v < 8; ++v) d += pp[v * 128];
    const float rs2 = ((const float*)(ws + W_RS2))[m];
    const float gate = ((const float*)(ws + W_SGATE))[i];
    ((float*)(ws + W_WTS))[i] = gelu_(d * rs2 * (1.0f / USCALE)) * gate * (1.0f / VSCALE);
  }
}

DI void peer_v_phase(const Params& p) {
  char* ws = p.ws;
  const int lane = threadIdx.x & 63, w = threadIdx.x >> 6, g = lane >> 3, li = lane & 7;
  const int v = blockIdx.x & 7, bx = blockIdx.x >> 3, nbx = (gridDim.x - v + 7) >> 3;
  const int gwx = bx * 4 + w, nwx = nbx * 4;
  const char* Vs = ws + W_VB + (size_t)v * 16384 * 128;
  const unsigned loff = li * 16;
  const int* sidx = (const int*)(ws + W_SIDX) + g * 16;
  const float* wts = (const float*)(ws + W_WTS) + g * 16;
  int4 ix[4];
  float4 wx[4];
  int m = gwx;
  if (m < TT) {
#pragma unroll
    for (int q = 0; q < 4; ++q) { ix[q] = ((const int4*)(sidx + (size_t)m * 128))[q]; wx[q] = ((const float4*)(wts + (size_t)m * 128))[q]; }
  }
  for (; m < TT; m += nwx) {
    const int idx[16] = {ix[0].x, ix[0].y, ix[0].z, ix[0].w, ix[1].x, ix[1].y, ix[1].z, ix[1].w,
                         ix[2].x, ix[2].y, ix[2].z, ix[2].w, ix[3].x, ix[3].y, ix[3].z, ix[3].w};
    const float wt[16] = {wx[0].x, wx[0].y, wx[0].z, wx[0].w, wx[1].x, wx[1].y, wx[1].z, wx[1].w,
                          wx[2].x, wx[2].y, wx[2].z, wx[2].w, wx[3].x, wx[3].y, wx[3].z, wx[3].w};
    u32x4 rows[16];
#pragma unroll
    for (int s2 = 0; s2 < 16; ++s2) rows[s2] = *(const u32x4*)(Vs + (((unsigned)idx[s2] << 7) + loff));
    const int mn = m + nwx;
    if (mn < TT) {
#pragma unroll
      for (int q = 0; q < 4; ++q) { ix[q] = ((const int4*)(sidx + (size_t)mn * 128))[q]; wx[q] = ((const float4*)(wts + (size_t)mn * 128))[q]; }
    }
    fl2_t acc[8];
#pragma unroll
    for (int q = 0; q < 8; ++q) acc[q] = {0.f, 0.f};
#pragma unroll
    for (int s2 = 0; s2 < 16; ++s2) {
      const fl2_t ww = {wt[s2], wt[s2]};
#pragma unroll
      for (int d = 0; d < 4; ++d) {
        const fl2_t lo = __builtin_amdgcn_cvt_pk_f32_fp8((int)rows[s2][d], false);
        const fl2_t hi = __builtin_amdgcn_cvt_pk_f32_fp8((int)rows[s2][d], true);
        acc[2 * d] = __builtin_elementwise_fma(lo, ww, acc[2 * d]);
        acc[2 * d + 1] = __builtin_elementwise_fma(hi, ww, acc[2 * d + 1]);
      }
    }
    float ps[16];
#pragma unroll
    for (int q = 0; q < 8; ++q) { ps[2 * q] = acc[q].x; ps[2 * q + 1] = acc[q].y; }
#pragma unroll
    for (int st = 0; st < 3; ++st) {
      const int bit = 32 >> st, half = 8 >> st;
      const bool upper = (lane & bit) != 0;
#pragma unroll
      for (int i = 0; i < half; ++i) {
        const float send = upper ? ps[i] : ps[i + half];
        const float keep = upper ? ps[i + half] : ps[i];
        ps[i] = keep + __shfl_xor(send, bit);
      }
    }
    const int cl = ((g >> 2) & 1) * 8 + ((g >> 1) & 1) * 4 + (g & 1) * 2;
    float2* yp = (float2*)(p.out + O_Y + (size_t)m * 1024 + v * 128 + li * 16 + cl);
    float2 yv = *yp;
    yv.x += ps[0]; yv.y += ps[1];
    *yp = yv;
  }
}

#define XB_TMO      128
#define XB_XCNT(j)  (256  + 64 * (j))
#define XB_XSUB(j)  (1280 + 64 * (j))
#define XB_XGEN(j)  (2304 + 64 * (j))
#define XB_TOP      3328
#define XB_TOPGEN   3392
#define XCD_BAR_WORDS 3456
#define XB_SPIN_CAP (1u << 18)
#define LAS __attribute__((address_space(3)))
DI unsigned xb_ld(unsigned* p) { return __hip_atomic_load(p, __ATOMIC_RELAXED, __HIP_MEMORY_SCOPE_AGENT); }
DI unsigned xb_add(unsigned* p, unsigned v) { return __hip_atomic_fetch_add(p, v, __ATOMIC_RELAXED, __HIP_MEMORY_SCOPE_AGENT); }
DI unsigned xb_xcc_id() { return (unsigned)__builtin_amdgcn_s_getreg((3 << 11) | 20) & 0xFu; }
#define XB_SPIN(cond, bar) do { unsigned _sp = 0; while (cond) { __builtin_amdgcn_s_sleep(1); \
    if ((++_sp & 255u) == 0u) { if (xb_ld(&(bar)[XB_TMO])) break; if (_sp > XB_SPIN_CAP) { atomicAdd(&(bar)[XB_TMO], 1u); break; } } } } while (0)
struct XcdBarrier { unsigned* bar; unsigned x; volatile LAS unsigned* st; };
DI XcdBarrier xcd_barrier_post(unsigned* bar, volatile LAS unsigned* st) {
  XcdBarrier b; b.bar = bar; b.x = xb_xcc_id(); b.st = st;
  if (threadIdx.x == 0) (void)xb_add(&bar[XB_XCNT(b.x)], 1u);
  return b;
}
DI void xcd_barrier_complete(unsigned* bar, unsigned x, unsigned& nloc, unsigned& nx) {
  const unsigned G = gridDim.x * gridDim.y * gridDim.z;
  unsigned sum, cnt, mine, sp = 0u;
  for (;;) {
    sum = 0u; cnt = 0u; mine = 0u;
#pragma unroll
    for (unsigned j = 0; j < 16; ++j) { const unsigned c = xb_ld(&bar[XB_XCNT(j)]); sum += c; cnt += (c > 0u) ? 1u : 0u; mine = (j == x) ? c : mine; }
    if (sum == G) break;
    __builtin_amdgcn_s_sleep(1);
    if ((++sp & 255u) == 0u) { if (xb_ld(&bar[XB_TMO])) break; if (sp > XB_SPIN_CAP) { atomicAdd(&bar[XB_TMO], 1u); break; } }
  }
  nloc = mine > 0u ? mine : 1u; nx = cnt > 0u ? cnt : 1u;
}
DI void xcd_barrier(const XcdBarrier& b) {
  asm volatile("s_waitcnt vmcnt(0)" ::: "memory");
  __syncthreads();
  if (threadIdx.x == 0) {
    unsigned* bar = b.bar;
    __builtin_amdgcn_s_waitcnt(0);
    unsigned nloc = b.st[0], nx = b.st[1];
    if (nloc == 0u) { xcd_barrier_complete(bar, b.x, nloc, nx); b.st[0] = nloc; b.st[1] = nx; }
    const unsigned old = xb_add(&bar[XB_XSUB(b.x)], 1u);
    const unsigned gen = old / nloc;
    if (old + 1u == (gen + 1u) * nloc) {
      __builtin_amdgcn_fence(__ATOMIC_RELEASE, "agent");
      asm volatile("s_waitcnt vmcnt(0)" ::: "memory");
      const unsigned og = xb_add(&bar[XB_TOP], 1u);
      const unsigned tg = og / nx;
      if (og + 1u == (tg + 1u) * nx) xb_add(&bar[XB_TOPGEN], 1u);
      else XB_SPIN(xb_ld(&bar[XB_TOPGEN]) == tg, bar);
      __builtin_amdgcn_fence(__ATOMIC_ACQUIRE, "agent");
      xb_add(&bar[XB_XGEN(b.x)], 1u);
      asm volatile("s_waitcnt vmcnt(0)" ::: "memory");
    } else {
      XB_SPIN(xb_ld(&bar[XB_XGEN(b.x)]) == gen, bar);
      __builtin_amdgcn_fence(__ATOMIC_ACQUIRE, "agent");
      asm volatile("s_waitcnt vmcnt(0)" ::: "memory");
    }
  }
  __syncthreads();
}

__global__ void __launch_bounds__(256, 2) hymba_mega(Params p) {
  __shared__ __attribute__((aligned(16))) char smem[53248];
  __shared__ uint4 xb_words;
  cg::grid_group grid = cg::this_grid();
  const int nb = gridDim.x, bid = blockIdx.x;
  if (threadIdx.x == 0) xb_words = make_uint4(0u, 0u, 0u, 0u);
  __syncthreads();
  XcdBarrier xb = xcd_barrier_post((unsigned*)(p.ws + W_BAR), (volatile LAS unsigned*)&xb_words);
  if (p.out == nullptr) grid.sync();
  phase0(p, smem);
  xcd_barrier(xb);
  for (int t = bid; t < 130 * 14; t += nb) gemm_tile<1>(p, t / 14, t % 14, smem);
  xcd_barrier(xb);
  for (int it = bid; it < 512; it += nb) lru_item<0>(p, it, smem);
  xcd_barrier(xb);
  for (int it = bid; it < 528 + 544; it += nb) {
    if (it < 528) lru_item<1>(p, it, smem);
    else attn_item(p, it - 528, smem);
  }
  xcd_barrier(xb);
  for (int t = bid; t < 130 * 8; t += nb) gemm_tile<2>(p, t >> 3, t & 7, smem);
  { const int extra = (130 * 8) % nb; if (bid >= extra) conv_table(p, true, bid - extra, nb - extra); }
  xcd_barrier(xb);
  for (int t = bid; t < 130 * 16; t += nb) gemm_tile<3>(p, t >> 4, t & 15, smem);
  { const int extra = (130 * 16) % nb; if (bid >= extra) conv_table(p, false, bid - extra, nb - extra); }
  xcd_barrier(xb);
  __syncthreads();
  route2(p, smem);
  xcd_barrier(xb);
  peer_u_phase(p);
  xcd_barrier(xb);
  peer_combine(p);
  xcd_barrier(xb);
  peer_v_phase(p);
}

extern "C" void kernel_launch(void* const* d_in, const int* in_sizes, int n_in, void* d_out, int out_size, void* d_ws,
                              size_t ws_size, hipStream_t stream) {
  static int grid_blocks = 0;
  if (!grid_blocks) {
    int dev = 0, cus = 0, per_cu = 0;
    (void)hipGetDevice(&dev);
    (void)hipDeviceGetAttribute(&cus, hipDeviceAttributeMultiprocessorCount, dev);
    (void)hipOccupancyMaxActiveBlocksPerMultiprocessor(&per_cu, hymba_mega, 256, 0);
    if (per_cu > 2) per_cu = 2;
    if (per_cu < 1) per_cu = 1;
    grid_blocks = cus * per_cu;
  }
  if (ws_size < W_END) fprintf(stderr, "workspace too small: %zu < %zu\n", ws_size, (size_t)W_END);
  Params p{};
  const float** pp = (const float**)&p;
  for (int i = 0; i < 27; ++i) pp[i] = (const float*)d_in[i];
  p.out = (float*)d_out;
  p.ws = (char*)d_ws;
  (void)hipMemsetAsync((char*)d_ws + W_BAR, 0, XCD_BAR_WORDS * 4, stream);
  void* args[] = {&p};
  hipError_t e = hipLaunchCooperativeKernel((void*)hymba_mega, dim3(grid_blocks), dim3(256), args, 0, stream);
  if (e != hipSuccess) fprintf(stderr, "cooperative launch failed: %s (grid %d)\n", hipGetErrorString(e), grid_blocks);
}
```

```cpp
#include <hip/hip_runtime.h>
#include <hip/hip_cooperative_groups.h>
#include <cstdio>
namespace cg = cooperative_groups;

#define DI __device__ __forceinline__
typedef __bf16 bf2_t __attribute__((ext_vector_type(2)));
typedef float fl2_t __attribute__((ext_vector_type(2)));
typedef short bf16x8 __attribute__((ext_vector_type(8)));
typedef float f32x16 __attribute__((ext_vector_type(16)));
typedef unsigned short u16;
typedef unsigned u32x4 __attribute__((ext_vector_type(4)));
typedef float f32x4 __attribute__((ext_vector_type(4)));
#define MFMA32(a, b, c) __builtin_amdgcn_mfma_f32_32x32x16_bf16((a), (b), (c), 0, 0, 0)

constexpr int TP = 16384, TS = 256, TT = 16640;
constexpr float EPS = 1e-6f;
constexpr float USCALE = 512.0f, VSCALE = 64.0f;

constexpr size_t O_Y = 0;
constexpr size_t O_KP = 17039360, O_VP = 17170432, O_CONVP = 17301504, O_LRUP = 17313792;
constexpr size_t O_KS = 17317888, O_VS = 17580032, O_CONVS = 17842176, O_LRUS = 17866752;

constexpr size_t al(size_t x) { return (x + 255) & ~size_t(255); }
constexpr size_t W_WTIN = 0;
constexpr size_t W_WTOUT = W_WTIN + al(1792ull * 1024 * 2);
constexpr size_t W_WTQ = W_WTOUT + al(1024ull * 1024 * 2);
constexpr size_t W_K1B = W_WTQ + al(2048ull * 1024 * 2);
constexpr size_t W_K2B = W_K1B + al(128 * 128 * 2);
constexpr size_t W_WAT = W_K2B + al(128 * 128 * 2);
constexpr size_t W_WIT = W_WAT + al(8 * 64 * 64 * 2);
constexpr size_t W_C8 = W_WIT + al(8 * 64 * 64 * 2);
constexpr size_t W_UB = W_C8 + al(512 * 4);
constexpr size_t W_VB = W_UB + 16384ull * 1024;
constexpr size_t W_XB = W_UB + al(16384ull * 1024 * 2);
constexpr size_t W_RB = W_XB + al(16384ull * 1024 * 2);
constexpr size_t W_CAT = W_RB;
constexpr size_t W_SIDX = W_RB;
constexpr size_t W_SGATE = W_RB + al(TT * 128ull * 4);
constexpr size_t W_RC = W_RB + al(TT * 1024ull * 2);
constexpr size_t W_U = W_RC;
constexpr size_t W_GG = W_RC + TT * 512ull * 2;
constexpr size_t W_HB = W_RC;
constexpr size_t W_Q = W_RC + al(TT * 1024ull * 2);
constexpr size_t W_KP = W_Q + al(TT * 512ull * 2);
constexpr size_t W_KS = W_KP + al(TP * 128ull * 2);
constexpr size_t W_VTP = W_KS + al(16 * 192 * 128 * 2);
constexpr size_t W_VTS = W_VTP + al(8 * 128 * 2048ull * 2);
constexpr size_t W_SUMA = W_VTS + al(16 * 128 * 192 * 2);
constexpr size_t W_SUMH = W_SUMA + al(512 * 512 * 4);
constexpr size_t W_RS1 = W_SUMH + al(512 * 512 * 4);
constexpr size_t W_SSQL = W_RS1 + al(TT * 4);
constexpr size_t W_SSQA = W_SSQL + al(TT * 4 * 4);
constexpr size_t W_SSQ2 = W_SSQA + al(TT * 8 * 4);
constexpr size_t W_PQ = W_SSQ2 + al(TT * 16 * 4);
constexpr size_t W_TOPL = W_PQ;
constexpr size_t W_PART = W_PQ;
constexpr size_t W_WTS = W_SGATE + al(TT * 128ull * 4);
constexpr size_t W_RS2 = W_PQ + al(TT * 2048ull * 2);
constexpr size_t W_BAR = W_RS2 + al(TT * 4);
constexpr size_t W_QW = W_BAR + al(3456 * 4);
constexpr size_t W_XBS = W_QW + 256;
constexpr size_t W_END = W_XBS + al(256ull * 2048);

struct Params {
  const float *x_p, *x_s, *cache_k, *cache_v, *state_conv, *state_lru, *ln1_g, *w_in, *conv_w, *conv_b,
      *lru_wa, *lru_ba, *lru_wi, *lru_bi, *lru_lambda, *q_g, *k_g, *sinks, *g_lru, *g_attn, *w_out, *ln2_g,
      *w_query, *sk1, *sk2, *peer_u, *peer_v;
  float* out;
  char* ws;
};

DI unsigned pk2(float a, float b) {
  fl2_t f = {a, b};
  return __builtin_bit_cast(unsigned, __builtin_convertvector(f, bf2_t));
}
DI float bf_lo(unsigned u) { return __uint_as_float(u << 16); }
DI float bf_hi(unsigned u) { return __uint_as_float(u & 0xffff0000u); }
DI float bf1(u16 v) { return __uint_as_float(((unsigned)v) << 16); }
DI float sigmoidf_(float x) { return __builtin_amdgcn_rcpf(1.0f + __expf(-x)); }
DI float gelu_(float x) {
  float z = 0.7978845608028654f * (x + 0.044715f * x * x * x);
  return x * __builtin_amdgcn_rcpf(1.0f + __expf(-2.0f * z));
}
DI int otid() { int t = threadIdx.x; asm volatile("" : "+v"(t)); return t; }
DI int crow(int r, int h) { return (r & 3) + 8 * (r >> 2) + 4 * h; }

DI void transpose_tile(const float* __restrict__ src, int ld_src, u16* __restrict__ dst, int ld_dst, int k0, int n0,
                       const float* __restrict__ gain, float* tile) {
  const int tid = otid();
  const int c = tid & 63, r0 = tid >> 6;
  __syncthreads();
#pragma unroll 4
  for (int rr = 0; rr < 16; ++rr) {
    int r = rr * 4 + r0;
    float v = src[(size_t)(k0 + r) * ld_src + n0 + c];
    if (gain) v *= gain[k0 + r];
    tile[r * 65 + c] = v;
  }
  __syncthreads();
  const int n = tid >> 2, kq = (tid & 3) * 16;
  unsigned pk[8];
#pragma unroll
  for (int i = 0; i < 8; ++i) pk[i] = pk2(tile[(kq + 2 * i) * 65 + n], tile[(kq + 2 * i + 1) * 65 + n]);
  uint4* d = (uint4*)(dst + (size_t)(n0 + n) * ld_dst + k0 + kq);
  d[0] = make_uint4(pk[0], pk[1], pk[2], pk[3]);
  d[1] = make_uint4(pk[4], pk[5], pk[6], pk[7]);
}

DI void wf_tile(const Params& p, int hh, int ktile) {
  const int tid = otid(), lane = tid & 63, w = tid >> 6, wn = w & 1, wm = w >> 1, tl = lane & 31, h = lane >> 5;
  const float* sk = (hh & 1) ? p.sk2 : p.sk1;
  f32x16 acc[2][2];
#pragma unroll
  for (int i = 0; i < 2; ++i)
#pragma unroll
    for (int j = 0; j < 2; ++j)
#pragma unroll
      for (int r = 0; r < 16; ++r) acc[i][j][r] = 0.f;
  const int kcol0 = ktile * 128 + wm * 64 + tl;
  const float g2a = p.ln2_g[kcol0], g2b = p.ln2_g[kcol0 + 32];
#pragma unroll 2
  for (int kk = 0; kk < 8; ++kk) {
    bf16x8 a[2], b[2];
#pragma unroll
    for (int i = 0; i < 2; ++i) {
      const float4* sp = (const float4*)(sk + (size_t)(wn * 64 + i * 32 + tl) * 128 + kk * 16 + h * 8);
      const float4 x = sp[0], y = sp[1];
      u32x4 t; t[0] = pk2(x.x, x.y); t[1] = pk2(x.z, x.w); t[2] = pk2(y.x, y.y); t[3] = pk2(y.z, y.w);
      a[i] = __builtin_bit_cast(bf16x8, t);
    }
#pragma unroll
    for (int j = 0; j < 2; ++j) {
      const float gg = j ? g2b : g2a;
      const float4* sp = (const float4*)(p.w_query + (size_t)(kcol0 + j * 32) * 2048 + hh * 128 + kk * 16 + h * 8);
      const float4 x = sp[0], y = sp[1];
      u32x4 t; t[0] = pk2(x.x * gg, x.y * gg); t[1] = pk2(x.z * gg, x.w * gg); t[2] = pk2(y.x * gg, y.y * gg); t[3] = pk2(y.z * gg, y.w * gg);
      b[j] = __builtin_bit_cast(bf16x8, t);
    }
#pragma unroll
    for (int i = 0; i < 2; ++i)
#pragma unroll
      for (int j = 0; j < 2; ++j) acc[i][j] = MFMA32(a[i], b[j], acc[i][j]);
  }
  u16* dst = (u16*)(p.ws + W_WTQ);
#pragma unroll
  for (int i = 0; i < 2; ++i)
#pragma unroll
    for (int j = 0; j < 2; ++j)
#pragma unroll
      for (int r = 0; r < 16; r += 2) {
        const int key = wn * 64 + i * 32 + crow(r, h);
        const unsigned pkv = pk2(acc[i][j][r], acc[i][j][r + 1]);
        dst[(size_t)(hh * 128 + key) * 1024 + kcol0 + j * 32] = (u16)(pkv & 0xffffu);
        dst[(size_t)(hh * 128 + key + 1) * 1024 + kcol0 + j * 32] = (u16)(pkv >> 16);
      }
}

DI void conv_table(const Params& p, bool isU, int part, int nparts, int seg = 0, int nseg = 1) {
  char* ws = p.ws;
  const float* src = isU ? p.peer_u : p.peer_v;
  char* dstb = ws + (isU ? W_UB : W_VB);
  const float scale = isU ? USCALE : VSCALE;
  const size_t i0 = (16384ull * 64 / nseg) * seg, i1 = i0 + 16384ull * 64 / nseg;
  for (size_t i = i0 + (size_t)part * 256 + threadIdx.x; i < i1; i += (size_t)nparts * 256) {
    const int e = (int)(i >> 6), c16 = (int)(i & 63);
    const float4* su = (const float4*)(src + (size_t)e * 1024 + c16 * 16);
    const float4* g2 = (const float4*)(p.ln2_g + c16 * 16);
    u32x4 ou;
#pragma unroll
    for (int q = 0; q < 4; ++q) {
      float4 a = su[q];
      if (isU) { const float4 g = g2[q]; a.x *= g.x; a.y *= g.y; a.z *= g.z; a.w *= g.w; }
      int pu = 0;
      pu = __builtin_amdgcn_cvt_pk_fp8_f32(a.x * scale, a.y * scale, pu, false);
      pu = __builtin_amdgcn_cvt_pk_fp8_f32(a.z * scale, a.w * scale, pu, true);
      ou[q] = (unsigned)pu;
    }
    const size_t off = ((size_t)((c16 >> 3) * 16384 + e)) * 128 + (c16 & 7) * 16;
    *(u32x4*)(dstb + off) = ou;
  }
}

DI void conv_table_queue(const Params& p, bool isU, unsigned* qhead) {
  __shared__ int q_chunk;
  for (;;) {
    __syncthreads();
    if (threadIdx.x == 0) q_chunk = (int)atomicAdd(qhead, 1u);
    __syncthreads();
    const int ch = q_chunk;
    if (ch >= 1024) break;
    conv_table(p, isU, 0, 1, ch, 1024);
  }
}

DI void phase0(const Params& p, char* smem) {
  const int nb = gridDim.x, bid = blockIdx.x, tid = otid();
  char* ws = p.ws;
  float* tile = (float*)smem;
  for (int it = bid; it < 448; it += nb) {
    int kt = it / 28, nt = it % 28;
    transpose_tile(p.w_in, 1792, (u16*)(ws + W_WTIN), 1024, kt * 64, nt * 64, p.ln1_g, tile);
  }
  {
    const int lane = tid & 63;
    const int gw = bid * 4 + (tid >> 6), nw = nb * 4;
    for (int m = gw; m < TT; m += nw) {
      const float* xr = (m < TP) ? (p.x_p + (size_t)m * 1024) : (p.x_s + (size_t)(m - TP) * 1024);
      const float4* xp = (const float4*)xr;
      float ss = 0.f;
      uint4* dst = (uint4*)(ws + ((m < TP) ? (W_XB + (size_t)m * 2048) : (W_XBS + (size_t)(m - TP) * 2048)));
#pragma unroll
      for (int q = 0; q < 2; ++q) {
        float4 a = xp[q * 128 + lane * 2], b = xp[q * 128 + lane * 2 + 1];
        ss += a.x * a.x + a.y * a.y + a.z * a.z + a.w * a.w + b.x * b.x + b.y * b.y + b.z * b.z + b.w * b.w;
        dst[q * 64 + lane] = make_uint4(pk2(a.x, a.y), pk2(a.z, a.w), pk2(b.x, b.y), pk2(b.z, b.w));
      }
#pragma unroll
      for (int s = 32; s >= 1; s >>= 1) ss += __shfl_xor(ss, s);
      if (lane == 0) ((float*)(ws + W_RS1))[m] = rsqrtf(ss * (1.0f / 1024.0f) + EPS);
    }
  }
}

DI void phase0b(const Params& p, char* smem) {
  const int nb = gridDim.x, bid = blockIdx.x, tid = otid();
  char* ws = p.ws;
  float* tile = (float*)smem;
  __shared__ int q_item0b;
  unsigned* q0b = (unsigned*)(p.ws + W_QW + 192);
  for (;;) {
    __syncthreads();
    if (threadIdx.x == 0) q_item0b = (int)atomicAdd(q0b, 1u);
    __syncthreads();
    const int it = q_item0b;
    if (it >= 384) break;
    if (it < 256) {
      int kt = it >> 4, nt = it & 15;
      const float* gain = (kt < 8) ? p.g_lru : (p.g_attn - 512);
      transpose_tile(p.w_out, 1024, (u16*)(ws + W_WTOUT), 1024, kt * 64, nt * 64, gain, tile);
    } else {
      wf_tile(p, (it - 256) >> 3, (it - 256) & 7);
    }
  }
  const size_t gt = (size_t)bid * 256 + tid, gstride = (size_t)nb * 256;
  for (size_t i = gt; i < 8192; i += gstride) {
    const int mat = (int)(i >> 12), r = (int)(i & 4095);
    const int ln = r & 63, kk = (r >> 6) & 3, ii = (r >> 8) & 1, n = r >> 9;
    const float* src = (mat ? p.lru_wi : p.lru_wa) + n * 4096 + (kk * 16 + (ln >> 5) * 8) * 64 + ii * 32 + (ln & 31);
    u32x4 o;
    o[0] = pk2(src[0], src[64]); o[1] = pk2(src[128], src[192]); o[2] = pk2(src[256], src[320]); o[3] = pk2(src[384], src[448]);
    *(u32x4*)(ws + (mat ? W_WIT : W_WAT) + (size_t)r * 16) = o;
  }
  for (size_t i = gt; i < 512; i += gstride) {
    float l = p.lru_lambda[i];
    float sp = (l < -15.f) ? -l : log1pf(expf(-l));
    ((float*)(ws + W_C8))[i] = -8.0f * sp;
  }
  for (size_t i = gt; i < 16 * 128 * 16; i += gstride) {
    int b = (int)(i >> 11), rem = (int)(i & 2047);
    int t = rem >> 4, c8i = rem & 15;
    const float4* sk = (const float4*)(p.cache_k + ((size_t)(b * 128 + t) * 128 + c8i * 8));
    float4 a = sk[0], bb = sk[1];
    uint4 o = make_uint4(pk2(a.x, a.y), pk2(a.z, a.w), pk2(bb.x, bb.y), pk2(bb.z, bb.w));
    *(uint4*)(ws + W_KS + ((size_t)(b * 192 + t) * 128 + c8i * 8) * 2) = o;
    const float4* sv = (const float4*)(p.cache_v + ((size_t)(b * 128 + t) * 128 + c8i * 8));
    float4 va = sv[0], vb = sv[1];
    if (t >= 16) {
      float4* dk = (float4*)(p.out + O_KS + ((size_t)(b * 128 + t - 16) * 128 + c8i * 8));
      dk[0] = a; dk[1] = bb;
      float4* dv = (float4*)(p.out + O_VS + ((size_t)(b * 128 + t - 16) * 128 + c8i * 8));
      dv[0] = va; dv[1] = vb;
    }
    u16* vt = (u16*)(ws + W_VTS) + (size_t)b * 128 * 192;
    float vv[8] = {va.x, va.y, va.z, va.w, vb.x, vb.y, vb.z, vb.w};
#pragma unroll
    for (int q = 0; q < 8; ++q) vt[(size_t)(c8i * 8 + q) * 192 + t] = (u16)(pk2(vv[q], 0.f) & 0xffffu);
  }
  for (size_t i = gt; i < 16 * 48 * 128; i += gstride) {
    int b = (int)(i / (48 * 128)), rem = (int)(i % (48 * 128));
    ((u16*)(ws + W_KS))[(size_t)(b * 192 + 144) * 128 + rem] = 0;
    int ch = rem / 48, tt = rem % 48;
    ((u16*)(ws + W_VTS))[(size_t)(b * 128 + ch) * 192 + 144 + tt] = 0;
  }
}

DI unsigned f2ord(float f) { unsigned u = __float_as_uint(f); return u ^ ((unsigned)((int)u >> 31) | 0x80000000u); }
DI float ord2f(unsigned u) { return __uint_as_float((u & 0x80000000u) ? (u ^ 0x80000000u) : ~u); }
DI void cas_desc(unsigned& a, unsigned& b) { unsigned mx = a > b ? a : b, mn = a > b ? b : a; a = mx; b = mn; }
DI void sort16_desc(unsigned (&v)[16]) {
#define CS(a, b) cas_desc(v[a], v[b]);
  CS(0,13) CS(1,12) CS(2,15) CS(3,14) CS(4,8) CS(5,6) CS(7,11) CS(9,10)
  CS(0,5) CS(1,7) CS(2,9) CS(3,4) CS(6,13) CS(8,14) CS(10,15) CS(11,12)
  CS(0,1) CS(2,3) CS(4,5) CS(6,8) CS(7,9) CS(10,11) CS(12,13) CS(14,15)
  CS(0,2) CS(1,3) CS(4,10) CS(5,11) CS(6,7) CS(8,9) CS(12,14) CS(13,15)
  CS(1,2) CS(3,12) CS(4,6) CS(5,7) CS(8,10) CS(9,11) CS(13,14)
  CS(1,4) CS(2,6) CS(5,8) CS(7,10) CS(9,13) CS(11,14)
  CS(2,4) CS(3,6) CS(9,12) CS(11,13)
  CS(3,5) CS(6,8) CS(7,9) CS(10,12)
  CS(3,4) CS(5,6) CS(7,8) CS(9,10) CS(11,12)
  CS(6,7) CS(8,9)
#undef CS
}
DI void merge16_desc(unsigned (&v)[16]) {
#pragma unroll
  for (int j = 8; j > 0; j >>= 1)
#pragma unroll
    for (int i = 0; i < 16; ++i) {
      int l = i ^ j;
      if (l > i) cas_desc(v[i], v[l]);
    }
}
DI void merge_top16(unsigned (&a)[16], unsigned (&b)[16]) {
#pragma unroll
  for (int i = 0; i < 16; ++i) a[i] = a[i] > b[15 - i] ? a[i] : b[15 - i];
  merge16_desc(a);
}


template <int MODE>
DI void gemm_tile(const Params& p, int mt, int nt, char* smem) {
  constexpr int LROW = 144;
  char* ws = p.ws;
  const char* Wt = ws + (MODE == 1 ? W_WTIN : (MODE == 2 ? W_WTOUT : W_WTQ));
  const char* X = (MODE == 1) ? ((mt < 128) ? ws + W_XB : ws + W_XBS - (size_t)TP * 2048) : ws + (MODE == 2 ? W_CAT : W_HB);
  char* sW = smem;
  char* sX = smem + 128 * LROW;
  const int tid = otid(), lane = tid & 63, w = tid >> 6, wn = w & 1, wm = w >> 1;
  const int tl = lane & 31, h = lane >> 5;
  const char* gW = Wt + (size_t)(nt * 128) * 2048;
  const char* gX = X + (size_t)(mt * 128) * 2048;
  u32x4 rW[4], rX[4];
  f32x16 acc[2][2];
#pragma unroll
  for (int i = 0; i < 2; ++i)
#pragma unroll
    for (int j = 0; j < 2; ++j)
#pragma unroll
      for (int r = 0; r < 16; ++r) acc[i][j][r] = 0.f;

  const int m_lane[2] = {mt * 128 + wm * 64 + tl, mt * 128 + wm * 64 + 32 + tl};
  float ratio[2] = {1.f, 1.f}, fscale[2] = {1.f, 1.f};
  if (MODE == 2) {
#pragma unroll
    for (int j = 0; j < 2; ++j) {
      const float4 sl = *(const float4*)(ws + W_SSQL + (size_t)m_lane[j] * 16);
      const float4 sa0 = *(const float4*)(ws + W_SSQA + (size_t)m_lane[j] * 32);
      const float4 sa1 = *(const float4*)(ws + W_SSQA + (size_t)m_lane[j] * 32 + 16);
      float rsl = rsqrtf((sl.x + sl.y + sl.z + sl.w) * (1.0f / 512.0f) + EPS);
      float rsa = rsqrtf((sa0.x + sa0.y + sa0.z + sa0.w + sa1.x + sa1.y + sa1.z + sa1.w) * (1.0f / 512.0f) + EPS);
      ratio[j] = rsl / rsa;
      fscale[j] = rsa;
    }
  } else if (MODE == 1) {
#pragma unroll
    for (int j = 0; j < 2; ++j) fscale[j] = ((const float*)(ws + W_RS1))[m_lane[j]];
  } else {
#pragma unroll
    for (int j = 0; j < 2; ++j) {
      const float4* sp = (const float4*)(ws + W_SSQ2 + (size_t)m_lane[j] * 64);
      float4 a = sp[0], b = sp[1], c = sp[2], d = sp[3];
      float s = a.x + a.y + a.z + a.w + b.x + b.y + b.z + b.w + c.x + c.y + c.z + c.w + d.x + d.y + d.z + d.w;
      fscale[j] = rsqrtf(s * (1.0f / 1024.0f) + EPS);
    }
  }

  constexpr int BUF = 2 * 128 * LROW;
#pragma unroll
  for (int i = 0; i < 4; ++i) {
    int c = tid + 256 * i, row = c >> 3, kc = c & 7;
    rW[i] = *(const u32x4*)(gW + (unsigned)(row * 2048 + kc * 16));
    rX[i] = *(const u32x4*)(gX + (unsigned)(row * 2048 + kc * 16));
  }
  __syncthreads();
#pragma unroll
  for (int i = 0; i < 4; ++i) {
    int c = tid + 256 * i, row = c >> 3, kc = c & 7;
    *(u32x4*)(sW + row * LROW + kc * 16) = rW[i];
    *(u32x4*)(sX + row * LROW + kc * 16) = rX[i];
  }
#pragma unroll
  for (int i = 0; i < 4; ++i) {
    int c = tid + 256 * i, row = c >> 3, kc = c & 7;
    rW[i] = *(const u32x4*)(gW + (unsigned)(row * 2048 + 128 + kc * 16));
    rX[i] = *(const u32x4*)(gX + (unsigned)(row * 2048 + 128 + kc * 16));
  }
  __syncthreads();
  for (int ks = 0; ks < 16; ++ks) {
    const int cur = (ks & 1) * BUF, nxt = BUF - cur;
    if (MODE == 2 && ks == 8) {
#pragma unroll
      for (int i = 0; i < 2; ++i)
#pragma unroll
        for (int j = 0; j < 2; ++j)
#pragma unroll
          for (int r = 0; r < 16; ++r) acc[i][j][r] *= ratio[j];
    }
#pragma unroll
    for (int kh = 0; kh < 2; ++kh) {
      __builtin_amdgcn_s_setprio(2);
#pragma unroll
      for (int k2 = 0; k2 < 2; ++k2) {
        const int kk = kh * 2 + k2;
        bf16x8 a[2], b[2];
#pragma unroll
        for (int i = 0; i < 2; ++i) a[i] = *(const bf16x8*)(sW + cur + (wn * 64 + i * 32 + tl) * LROW + kk * 32 + h * 16);
#pragma unroll
        for (int j = 0; j < 2; ++j) b[j] = *(const bf16x8*)(sX + cur + (wm * 64 + j * 32 + tl) * LROW + kk * 32 + h * 16);
#pragma unroll
        for (int i = 0; i < 2; ++i)
#pragma unroll
          for (int j = 0; j < 2; ++j) acc[i][j] = MFMA32(a[i], b[j], acc[i][j]);
      }
      __builtin_amdgcn_s_setprio(0);
      if (kh == 0 && ks + 1 < 16) {
#pragma unroll
        for (int i = 0; i < 4; ++i) {
          int c = tid + 256 * i, row = c >> 3, kc = c & 7;
          *(u32x4*)(sW + nxt + row * LROW + kc * 16) = rW[i];
          *(u32x4*)(sX + nxt + row * LROW + kc * 16) = rX[i];
        }
        if (ks + 2 < 16) {
#pragma unroll
          for (int i = 0; i < 4; ++i) {
            int c = tid + 256 * i, row = c >> 3, kc = c & 7;
            rW[i] = *(const u32x4*)(gW + (unsigned)(row * 2048 + (ks + 2) * 128 + kc * 16));
            rX[i] = *(const u32x4*)(gX + (unsigned)(row * 2048 + (ks + 2) * 128 + kc * 16));
          }
        }
      }
    }
    if (ks + 1 < 16) __syncthreads();
  }

  const int ncol0 = nt * 128 + wn * 64;
  if (MODE == 1) {
    u16* Tb = (u16*)smem;
    const int tcol0 = wn * 64 + 4 * h;
    if (nt < 13) __syncthreads();
    if (ncol0 < 512) {
#pragma unroll
      for (int j = 0; j < 2; ++j) {
        const int m = m_lane[j];
        float* convdst = nullptr;
        if (m < TP) {
          int t = m & 2047;
          if (t >= 2045) convdst = p.out + O_CONVP + (size_t)((m >> 11) * 3 + (t - 2045)) * 512;
        } else {
          int ms = m - TP, t = ms & 15;
          if (t >= 13) convdst = p.out + O_CONVS + (size_t)((ms >> 4) * 3 + (t - 13)) * 512;
        }
        u16* ub = (u16*)(ws + W_U) + (size_t)m * 512;
#pragma unroll
        for (int i = 0; i < 2; ++i)
#pragma unroll
          for (int g = 0; g < 4; ++g) {
            int n = ncol0 + i * 32 + 8 * g + 4 * h;
            float v0 = acc[i][j][4 * g] * fscale[j], v1 = acc[i][j][4 * g + 1] * fscale[j],
                  v2 = acc[i][j][4 * g + 2] * fscale[j], v3 = acc[i][j][4 * g + 3] * fscale[j];
            *(uint2*)(Tb + (wm * 64 + j * 32 + tl) * 136 + tcol0 + i * 32 + 8 * g) = make_uint2(pk2(v0, v1), pk2(v2, v3));
            if (convdst) *(float4*)(convdst + n) = make_float4(v0, v1, v2, v3);
          }
      }
    } else if (ncol0 < 1024) {
#pragma unroll
      for (int j = 0; j < 2; ++j) {
        u16* gb = (u16*)(ws + W_GG) + (size_t)m_lane[j] * 512;
#pragma unroll
        for (int i = 0; i < 2; ++i)
#pragma unroll
          for (int g = 0; g < 4; ++g) {
            int n = ncol0 - 512 + i * 32 + 8 * g + 4 * h;
            float v0 = gelu_(acc[i][j][4 * g] * fscale[j]), v1 = gelu_(acc[i][j][4 * g + 1] * fscale[j]),
                  v2 = gelu_(acc[i][j][4 * g + 2] * fscale[j]), v3 = gelu_(acc[i][j][4 * g + 3] * fscale[j]);
            *(uint2*)(Tb + (wm * 64 + j * 32 + tl) * 136 + tcol0 + i * 32 + 8 * g) = make_uint2(pk2(v0, v1), pk2(v2, v3));
          }
      }
    } else if (ncol0 < 1664) {
      const bool isq = ncol0 < 1536;
      const float* gain = isq ? p.q_g : p.k_g;
      const float post = isq ? 0.125f : 1.0f;
#pragma unroll
      for (int j = 0; j < 2; ++j) {
        const int m = m_lane[j];
        float ss = 0.f;
#pragma unroll
        for (int i = 0; i < 2; ++i)
#pragma unroll
          for (int r = 0; r < 16; ++r) {
            float v = acc[i][j][r] * fscale[j];
            ss += v * v;
          }
        ss += __shfl_xor(ss, 32);
        const float sc = fscale[j] * rsqrtf(ss * (1.0f / 64.0f) + EPS) * post;
        u16* dst;
        float* fdst = nullptr;
        int nloc0;
        if (isq) {
          nloc0 = ncol0 - 1024;
          dst = (u16*)(ws + W_Q) + (size_t)m * 512 + nloc0;
        } else {
          nloc0 = ncol0 - 1536;
          if (m < TP) {
            dst = (u16*)(ws + W_KP) + (size_t)m * 128 + nloc0;
            int t = m & 2047;
            if (t >= 1920) fdst = p.out + O_KP + (size_t)((m >> 11) * 128 + (t - 1920)) * 128 + nloc0;
          } else {
            int ms = m - TP, b = ms >> 4, t = ms & 15;
            dst = (u16*)(ws + W_KS) + (size_t)(b * 192 + 128 + t) * 128 + nloc0;
            fdst = p.out + O_KS + (size_t)(b * 128 + 112 + t) * 128 + nloc0;
          }
        }
#pragma unroll
        for (int i = 0; i < 2; ++i)
#pragma unroll
          for (int g = 0; g < 4; ++g) {
            int d = i * 32 + 8 * g + 4 * h;
            const float4 gn = *(const float4*)(gain + d);
            float v0 = acc[i][j][4 * g] * sc * gn.x, v1 = acc[i][j][4 * g + 1] * sc * gn.y,
                  v2 = acc[i][j][4 * g + 2] * sc * gn.z, v3 = acc[i][j][4 * g + 3] * sc * gn.w;
            *(uint2*)(Tb + (wm * 64 + j * 32 + tl) * 136 + tcol0 + i * 32 + 8 * g) = make_uint2(pk2(v0, v1), pk2(v2, v3));
            if (fdst) *(float4*)(fdst + d) = make_float4(v0, v1, v2, v3);
          }
      }
    } else {
#pragma unroll
      for (int j = 0; j < 2; ++j) {
        const int m = m_lane[j];
        u16* vt;
        size_t vstride;
        float* fdst = nullptr;
        const int ch0 = ncol0 - 1664;
        if (m < TP) {
          int b = m >> 11, t = m & 2047;
          vt = (u16*)(ws + W_VTP) + (size_t)b * 128 * 2048 + t;
          vstride = 2048;
          if (t >= 1920) fdst = p.out + O_VP + (size_t)(b * 128 + (t - 1920)) * 128;
        } else {
          int ms = m - TP, b = ms >> 4, t = ms & 15;
          vt = (u16*)(ws + W_VTS) + (size_t)b * 128 * 192 + 128 + t;
          vstride = 192;
          fdst = p.out + O_VS + (size_t)(b * 128 + 112 + t) * 128;
        }
#pragma unroll
        for (int i = 0; i < 2; ++i)
#pragma unroll
          for (int g = 0; g < 4; ++g) {
            int ch = ch0 + i * 32 + 8 * g + 4 * h;
            float v0 = acc[i][j][4 * g] * fscale[j], v1 = acc[i][j][4 * g + 1] * fscale[j],
                  v2 = acc[i][j][4 * g + 2] * fscale[j], v3 = acc[i][j][4 * g + 3] * fscale[j];
            unsigned p01 = pk2(v0, v1), p23 = pk2(v2, v3);
            vt[(size_t)(ch + 0) * vstride] = (u16)(p01 & 0xffffu);
            vt[(size_t)(ch + 1) * vstride] = (u16)(p01 >> 16);
            vt[(size_t)(ch + 2) * vstride] = (u16)(p23 & 0xffffu);
            vt[(size_t)(ch + 3) * vstride] = (u16)(p23 >> 16);
            if (fdst) *(float4*)(fdst + ch) = make_float4(v0, v1, v2, v3);
          }
      }
    }
    if (nt < 13) {
      __syncthreads();
#pragma unroll
      for (int it = 0; it < 8; ++it) {
        const int c = tid + 256 * it, rl = c >> 4, cc = c & 15;
        const int m = mt * 128 + rl;
        const u32x4 vrow = *(const u32x4*)(Tb + rl * 136 + cc * 8);
        unsigned off;
        if (nt < 4) off = (unsigned)(W_U + (m * 512 + nt * 128 + cc * 8) * 2);
        else if (nt < 8) off = (unsigned)(W_GG + (m * 512 + (nt - 4) * 128 + cc * 8) * 2);
        else if (nt < 12) off = (unsigned)(W_Q + (m * 512 + (nt - 8) * 128 + cc * 8) * 2);
        else if (m < TP) off = (unsigned)(W_KP + (m * 128 + cc * 8) * 2);
        else { const int ms = m - TP; off = (unsigned)(W_KS + (((ms >> 4) * 192 + 128 + (ms & 15)) * 128 + cc * 8) * 2); }
        *(u32x4*)(ws + off) = vrow;
      }
    }
  } else if (MODE == 2) {
    float* T = (float*)smem;
    __syncthreads();
#pragma unroll
    for (int j = 0; j < 2; ++j) {
      const int rl = wm * 64 + j * 32 + tl;
#pragma unroll
      for (int i = 0; i < 2; ++i)
#pragma unroll
        for (int g = 0; g < 4; ++g) {
          const int col = wn * 64 + i * 32 + 8 * g + 4 * h;
          f32x4 v;
          v[0] = acc[i][j][4 * g] * fscale[j]; v[1] = acc[i][j][4 * g + 1] * fscale[j];
          v[2] = acc[i][j][4 * g + 2] * fscale[j]; v[3] = acc[i][j][4 * g + 3] * fscale[j];
          *(f32x4*)(T + rl * 132 + col) = v;
        }
    }
    __syncthreads();
    const char* xbb = (mt < 128) ? ws + W_XB : ws + W_XBS - (size_t)TP * 2048;
#pragma unroll 4
    for (int it = 0; it < 16; ++it) {
      const int c = tid + 256 * it, rl = c >> 5, cc = c & 31;
      const int m = mt * 128 + rl, n = nt * 128 + cc * 4;
      const f32x4 t = *(const f32x4*)(T + rl * 132 + cc * 4);
      const uint2 xq = *(const uint2*)(xbb + (unsigned)((m * 1024 + n) * 2));
      f32x4 y;
      y[0] = bf_lo(xq.x) + t[0]; y[1] = bf_hi(xq.x) + t[1]; y[2] = bf_lo(xq.y) + t[2]; y[3] = bf_hi(xq.y) + t[3];
      *(uint2*)(ws + (unsigned)(W_HB + (m * 1024 + n) * 2)) = make_uint2(pk2(y[0], y[1]), pk2(y[2], y[3]));
      float ss = y[0] * y[0] + y[1] * y[1] + y[2] * y[2] + y[3] * y[3];
      ss += __uint_as_float(__builtin_amdgcn_update_dpp(0u, __float_as_uint(ss), 0x111, 0xF, 0xF, false));
      ss += __uint_as_float(__builtin_amdgcn_update_dpp(0u, __float_as_uint(ss), 0x112, 0xF, 0xF, false));
      ss += __uint_as_float(__builtin_amdgcn_update_dpp(0u, __float_as_uint(ss), 0x114, 0xF, 0xF, false));
      ss += __uint_as_float(__builtin_amdgcn_update_dpp(0u, __float_as_uint(ss), 0x118, 0xF, 0xF, false));
      if ((lane & 15) == 15) *(float*)(ws + (unsigned)(W_SSQ2 + (m * 16 + nt * 2 + (cc >> 4)) * 4)) = ss;
    }
  } else {
    unsigned* Lx = (unsigned*)smem;
    __syncthreads();
#pragma unroll
    for (int j = 0; j < 2; ++j) {
      if (nt == 0 && wn == 0 && h == 0) ((float*)(ws + W_RS2))[m_lane[j]] = fscale[j];
      unsigned top[16], tmp[16];
#pragma unroll
      for (int r = 0; r < 16; ++r) top[r] = (f2ord(acc[0][j][r] * fscale[j]) & ~127u) | (unsigned)(127 - (wn * 64 + crow(r, h)));
      sort16_desc(top);
#pragma unroll
      for (int r = 0; r < 16; ++r) tmp[r] = (f2ord(acc[1][j][r] * fscale[j]) & ~127u) | (unsigned)(127 - (wn * 64 + 32 + crow(r, h)));
      sort16_desc(tmp);
      merge_top16(top, tmp);
      u32x4* d4 = (u32x4*)(Lx + (((wn * 2 + h) * 4 + wm * 2 + j) * 32 + tl) * 16);
#pragma unroll
      for (int q = 0; q < 4; ++q) { u32x4 v4; v4[0] = top[4 * q]; v4[1] = top[4 * q + 1]; v4[2] = top[4 * q + 2]; v4[3] = top[4 * q + 3]; d4[q] = v4; }
    }
    __syncthreads();
    if (tid < 128) {
      const int u = tid >> 5, t2 = tid & 31;
      unsigned top[16], tmp[16];
#pragma unroll
      for (int li = 0; li < 4; ++li) {
        const u32x4* s4 = (const u32x4*)(Lx + ((li * 4 + u) * 32 + t2) * 16);
#pragma unroll
        for (int q = 0; q < 4; ++q) {
          const u32x4 x0 = s4[q];
          if (li == 0) { top[4 * q] = x0[0]; top[4 * q + 1] = x0[1]; top[4 * q + 2] = x0[2]; top[4 * q + 3] = x0[3]; }
          else { tmp[4 * q] = x0[0]; tmp[4 * q + 1] = x0[1]; tmp[4 * q + 2] = x0[2]; tmp[4 * q + 3] = x0[3]; }
        }
        if (li > 0) merge_top16(top, tmp);
      }
      const int mrow = mt * 128 + u * 32 + t2;
      u32x4* g4 = (u32x4*)(ws + (unsigned)(W_TOPL + ((mrow * 16 + nt) * 16) * 4));
#pragma unroll
      for (int q = 0; q < 4; ++q) { u32x4 v4; v4[0] = top[4 * q]; v4[1] = top[4 * q + 1]; v4[2] = top[4 * q + 2]; v4[3] = top[4 * q + 3]; g4[q] = v4; }
    }
  }
}

#define SCAN_STEP(CTRL) { \
    const float Ap = __uint_as_float(__builtin_amdgcn_update_dpp(0x3f800000u, __float_as_uint(A), CTRL, 0xF, 0xF, false)); \
    const float Hp = __uint_as_float(__builtin_amdgcn_update_dpp(0u, __float_as_uint(H), CTRL, 0xF, 0xF, false)); \
    H = A * Hp + H; A = A * Ap; }
template <int FINAL>
DI void lru_item(const Params& p, int item, char* smem) {
  char* ws = p.ws;
  const bool samp = item >= 512;
  int b, c, m0, nvalid;
  if (!samp) { b = item >> 6; c = item & 63; m0 = b * 2048 + c * 32; nvalid = 32; }
  else { b = item - 512; c = 0; m0 = TP + b * 16; nvalid = 16; }
  const int tid = otid(), lane = tid & 63, w = tid >> 6, tl = lane & 31, h = lane >> 5;
  u16* XC = (u16*)smem;
  float* hin = (float*)(smem + 32 * 1040);
  __syncthreads();
  {
    const int ch = 2 * tid;
    const float2 w0 = *(const float2*)(p.conv_w + ch), w1 = *(const float2*)(p.conv_w + 512 + ch),
                 w2 = *(const float2*)(p.conv_w + 1024 + ch), w3 = *(const float2*)(p.conv_w + 1536 + ch),
                 cb = *(const float2*)(p.conv_b + ch);
    float2 r0 = {0.f, 0.f}, r1 = {0.f, 0.f}, r2 = {0.f, 0.f};
    const u16* ub = (const u16*)(ws + W_U);
    if (!samp) {
      if (c > 0) {
        unsigned a0 = *(const unsigned*)(ub + (size_t)(m0 - 3) * 512 + ch), a1 = *(const unsigned*)(ub + (size_t)(m0 - 2) * 512 + ch),
                 a2 = *(const unsigned*)(ub + (size_t)(m0 - 1) * 512 + ch);
        r0 = {bf_lo(a0), bf_hi(a0)}; r1 = {bf_lo(a1), bf_hi(a1)}; r2 = {bf_lo(a2), bf_hi(a2)};
      }
    } else {
      const float* sc = p.state_conv + (size_t)b * 3 * 512 + ch;
      r0 = *(const float2*)(sc); r1 = *(const float2*)(sc + 512); r2 = *(const float2*)(sc + 1024);
    }
    unsigned uraw[32];
#pragma unroll
    for (int t = 0; t < 32; ++t) uraw[t] = (t < nvalid) ? *(const unsigned*)(ub + (size_t)(m0 + t) * 512 + ch) : 0u;
#pragma unroll
    for (int t = 0; t < 32; ++t) {
      float2 cur = {bf_lo(uraw[t]), bf_hi(uraw[t])};
      float x0 = cb.x + w0.x * r0.x + w1.x * r1.x + w2.x * r2.x + w3.x * cur.x;
      float x1 = cb.y + w0.y * r0.y + w1.y * r1.y + w2.y * r2.y + w3.y * cur.y;
      *(unsigned*)(XC + t * 520 + ch) = pk2(x0, x1);
      r0 = r1; r1 = r2; r2 = cur;
    }
    if (FINAL) {
      u16* G = (u16*)(smem + 35328);
      u32x4 gr[8];
#pragma unroll
      for (int it = 0; it < 8; ++it) {
        const int cidx = tid + 256 * it, rl = cidx >> 6, cc = cidx & 63;
        if (rl < nvalid) gr[it] = *(const u32x4*)(ws + (unsigned)(W_GG + ((m0 + rl) * 512 + cc * 8) * 2));
      }
#pragma unroll
      for (int it = 0; it < 8; ++it) {
        const int cidx = tid + 256 * it, rl = cidx >> 6, cc = cidx & 63;
        if (rl < nvalid) *(u32x4*)(G + rl * 520 + cc * 8) = gr[it];
      }
    }
    if (FINAL) {
      float2 hh;
      if (samp) hh = *(const float2*)(p.state_lru + (size_t)b * 512 + ch);
      else {
        hh = {0.f, 0.f};
        const float* sA = (const float*)(ws + W_SUMA) + (size_t)(b * 64) * 512 + ch;
        const float* sH = (const float*)(ws + W_SUMH) + (size_t)(b * 64) * 512 + ch;
        int cc = 0;
        for (; cc + 16 <= c; cc += 16) {
          float2 Av[16], Hv[16];
#pragma unroll
          for (int u = 0; u < 16; ++u) { Av[u] = *(const float2*)(sA + (size_t)(cc + u) * 512); Hv[u] = *(const float2*)(sH + (size_t)(cc + u) * 512); }
#pragma unroll
          for (int u = 0; u < 16; ++u) { hh.x = Av[u].x * hh.x + Hv[u].x; hh.y = Av[u].y * hh.y + Hv[u].y; }
        }
        for (; cc + 4 <= c; cc += 4) {
          float2 Av[4], Hv[4];
#pragma unroll
          for (int u = 0; u < 4; ++u) { Av[u] = *(const float2*)(sA + (size_t)(cc + u) * 512); Hv[u] = *(const float2*)(sH + (size_t)(cc + u) * 512); }
#pragma unroll
          for (int u = 0; u < 4; ++u) { hh.x = Av[u].x * hh.x + Hv[u].x; hh.y = Av[u].y * hh.y + Hv[u].y; }
        }
        for (; cc < c; ++cc) {
          float2 A0 = *(const float2*)(sA + (size_t)cc * 512), H0 = *(const float2*)(sH + (size_t)cc * 512);
          hh.x = A0.x * hh.x + H0.x; hh.y = A0.y * hh.y + H0.y;
        }
      }
      hin[ch] = hh.x; hin[ch + 1] = hh.y;
    }
  }
  __syncthreads();
  const u16* WaT = (const u16*)(ws + W_WAT);
  const u16* WiT = (const u16*)(ws + W_WIT);
  const float* c8 = (const float*)(ws + W_C8);
  const int m = m0 + tl;
  const bool valid = tl < nvalid;
  float ssq = 0.f;
#pragma unroll 1
  for (int nbk = 0; nbk < 2; ++nbk) {
    const int n = 2 * w + nbk;
    f32x16 accA[2], accI[2];
#pragma unroll
    for (int i = 0; i < 2; ++i)
#pragma unroll
      for (int r = 0; r < 16; ++r) { accA[i][r] = 0.f; accI[i][r] = 0.f; }
#pragma unroll
    for (int kk = 0; kk < 4; ++kk) {
      const bf16x8 bx = *(const bf16x8*)((const char*)XC + tl * 1040 + (n * 64 + kk * 16 + h * 8) * 2);
#pragma unroll
      for (int i = 0; i < 2; ++i) {
        const bf16x8 aa = *(const bf16x8*)(WaT + (unsigned)((((n * 2 + i) * 4 + kk) * 64 + lane) * 8));
        const bf16x8 ai = *(const bf16x8*)(WiT + (unsigned)((((n * 2 + i) * 4 + kk) * 64 + lane) * 8));
        accA[i] = MFMA32(aa, bx, accA[i]);
        accI[i] = MFMA32(ai, bx, accI[i]);
      }
    }
#pragma unroll
    for (int i = 0; i < 2; ++i)
#pragma unroll
      for (int g = 0; g < 4; ++g) {
        const int ch = n * 64 + i * 32 + 8 * g + 4 * h;
        const float4 ba4 = *(const float4*)(p.lru_ba + ch), bi4 = *(const float4*)(p.lru_bi + ch), c84 = *(const float4*)(c8 + ch);
        const float bav[4] = {ba4.x, ba4.y, ba4.z, ba4.w}, biv[4] = {bi4.x, bi4.y, bi4.z, bi4.w}, c8v[4] = {c84.x, c84.y, c84.z, c84.w};
        const uint2 xcp = *(const uint2*)(XC + tl * 520 + ch);
        const float xcv[4] = {bf_lo(xcp.x), bf_hi(xcp.x), bf_lo(xcp.y), bf_hi(xcp.y)};
        float hv[4];
        float A4[4], H4[4];
#pragma unroll
        for (int q = 0; q < 4; ++q) {
          const int r = 4 * g + q;
          float rr = sigmoidf_(accA[i][r] + bav[q]);
          float ii = sigmoidf_(accI[i][r] + biv[q]);
          float la = c8v[q] * rr;
          A4[q] = __expf(la);
          float x2 = 2.0f * la;
          float em = -x2 * (1.0f + x2 * (0.5f + x2 * (0.16666667f + x2 * (0.041666668f + x2 * (0.0083333333f + x2 * 0.0013888889f)))));
          H4[q] = __builtin_amdgcn_sqrtf(fmaxf(em, 0.f)) * ii * xcv[q];
        }
#define SCAN4(CTRL) \
        asm volatile("s_nop 1\n\t" \
            "v_fmac_f32_dpp %0, %0, %4 " CTRL "\n\tv_mul_f32_dpp %4, %4, %4 " CTRL "\n\t" \
            "v_fmac_f32_dpp %1, %1, %5 " CTRL "\n\tv_mul_f32_dpp %5, %5, %5 " CTRL "\n\t" \
            "v_fmac_f32_dpp %2, %2, %6 " CTRL "\n\tv_mul_f32_dpp %6, %6, %6 " CTRL "\n\t" \
            "v_fmac_f32_dpp %3, %3, %7 " CTRL "\n\tv_mul_f32_dpp %7, %7, %7 " CTRL "\n\t" \
            : "+v"(H4[0]), "+v"(H4[1]), "+v"(H4[2]), "+v"(H4[3]), "+v"(A4[0]), "+v"(A4[1]), "+v"(A4[2]), "+v"(A4[3]));
        SCAN4("row_shr:1 row_mask:0xf bank_mask:0xf")
        SCAN4("row_shr:2 row_mask:0xf bank_mask:0xf")
        SCAN4("row_shr:4 row_mask:0xf bank_mask:0xf")
        SCAN4("row_shr:8 row_mask:0xf bank_mask:0xf")
        SCAN4("row_bcast:15 row_mask:0xa bank_mask:0xf")
        asm volatile("s_nop 1" ::: "memory");
#pragma unroll
        for (int q = 0; q < 4; ++q) {
          const float A = A4[q], H = H4[q];
          if (!FINAL) {
            if (tl == 31) { ((float*)(smem + 35328))[ch + q] = A; ((float*)(smem + 35328))[512 + ch + q] = H; }
          } else {
            hv[q] = H + A * hin[ch + q];
          }
        }
        if (FINAL) {
          if (tl == nvalid - 1 && (samp || c == 63)) {
            float* dst = p.out + (samp ? O_LRUS : O_LRUP) + (size_t)b * 512 + ch;
            *(float4*)dst = make_float4(hv[0], hv[1], hv[2], hv[3]);
          }
          if (valid) {
            u16* G = (u16*)(smem + 35328);
            const uint2 gp = *(const uint2*)(G + tl * 520 + ch);
            float o0 = hv[0] * bf_lo(gp.x), o1 = hv[1] * bf_hi(gp.x), o2 = hv[2] * bf_lo(gp.y), o3 = hv[3] * bf_hi(gp.y);
            ssq += o0 * o0 + o1 * o1 + o2 * o2 + o3 * o3;
            *(uint2*)(G + tl * 520 + ch) = make_uint2(pk2(o0, o1), pk2(o2, o3));
          }
        }
      }
  }
  if (!FINAL) {
    __syncthreads();
    const float* S = (const float*)(smem + 35328);
    *(float2*)((float*)(ws + W_SUMA) + (size_t)(b * 64 + c) * 512 + 2 * tid) = *(const float2*)(S + 2 * tid);
    *(float2*)((float*)(ws + W_SUMH) + (size_t)(b * 64 + c) * 512 + 2 * tid) = *(const float2*)(S + 512 + 2 * tid);
  }
  if (FINAL) {
    ssq += __shfl_xor(ssq, 32);
    if (valid && h == 0) ((float*)(ws + W_SSQL))[(size_t)m * 4 + w] = ssq;
    __syncthreads();
    const u16* G = (const u16*)(smem + 35328);
#pragma unroll
    for (int it = 0; it < 8; ++it) {
      const int cidx = tid + 256 * it, rl = cidx >> 6, cc = cidx & 63;
      if (rl < nvalid) *(u32x4*)(ws + (unsigned)(W_CAT + ((m0 + rl) * 1024 + cc * 8) * 2)) = *(const u32x4*)(G + rl * 520 + cc * 8);
    }
  }
}

DI void attn_item(const Params& p, int item, char* smem) {
  char* ws = p.ws;
  const int tid = otid(), lane = tid & 63, w = tid >> 6, tl = lane & 31, h = lane >> 5;
  const bool samp = item >= 512;
  int b, c, g;
  const u16* Kb; const u16* Vt; int vstride, kc_lo, kc_hi, nkeys, mq0; bool qvalid;
  if (!samp) {
    b = item >> 6; c = (item >> 1) & 31; g = item & 1;
    Kb = (const u16*)(ws + W_KP) + (size_t)b * 2048 * 128;
    Vt = (const u16*)(ws + W_VTP) + (size_t)b * 128 * 2048;
    vstride = 2048; kc_lo = (c >= 2) ? c - 2 : 0; kc_hi = c; nkeys = 1 << 30;
    mq0 = b * 2048 + c * 64 + tl; qvalid = true;
  } else {
    int it = item - 512; b = it >> 1; g = it & 1; c = 0;
    Kb = (const u16*)(ws + W_KS) + (size_t)b * 192 * 128;
    Vt = (const u16*)(ws + W_VTS) + (size_t)b * 128 * 192;
    vstride = 192; kc_lo = 0; kc_hi = 2; nkeys = 144;
    mq0 = TP + b * 16 + (tl & 15); qvalid = tl < 16;
  }
  const int hq = g * 4 + w;
  const float sink = p.sinks[hq];
  char* sK = smem;
  char* sV = smem + 192 * 144;
  const int nch = kc_hi - kc_lo + 1;
  const int nj = samp ? 1 : 2;
  bf16x8 bq[2][4];
#pragma unroll
  for (int j = 0; j < 2; ++j)
#pragma unroll
    for (int kk = 0; kk < 4; ++kk)
      bq[j][kk] = *(const bf16x8*)((const u16*)(ws + W_Q) + (size_t)(mq0 + (samp ? 0 : j * 32)) * 512 + hq * 64 + kk * 16 + h * 8);
  __syncthreads();
  {
    u32x4 kr[6], vr[6];
#pragma unroll
    for (int i = 0; i < 6; ++i) {
      const int idx = tid + 256 * i;
      const int key = idx >> 3, part = idx & 7;
      if (key < nch * 64) kr[i] = *(const u32x4*)(Kb + (size_t)(kc_lo * 64 + key) * 128 + g * 64 + part * 8);
      const int d = idx / 24, pv = idx % 24;
      if (pv < nch * 8) vr[i] = *(const u32x4*)(Vt + (size_t)(g * 64 + d) * vstride + kc_lo * 64 + pv * 8);
    }
#pragma unroll
    for (int i = 0; i < 6; ++i) {
      const int idx = tid + 256 * i;
      const int key = idx >> 3, part = idx & 7;
      if (key < nch * 64) *(u32x4*)(sK + key * 144 + part * 16) = kr[i];
      const int d = idx / 24, pv = idx % 24;
      if (pv < nch * 8) *(u32x4*)(sV + d * 400 + pv * 16) = vr[i];
    }
  }
  __syncthreads();
#pragma unroll
  for (int j = 0; j < 2; ++j) {
    if (j < nj) {
    const int mqj = mq0 + j * 32;
    float mrun = sink, lrun = 1.f;
    f32x16 O[2];
#pragma unroll
    for (int i = 0; i < 2; ++i)
#pragma unroll
      for (int r = 0; r < 16; ++r) O[i][r] = 0.f;
#pragma unroll 1
    for (int kc = 0; kc < nch; ++kc) {
      f32x16 S[2];
#pragma unroll
      for (int i = 0; i < 2; ++i)
#pragma unroll
        for (int r = 0; r < 16; ++r) S[i][r] = 0.f;
#pragma unroll
      for (int kk = 0; kk < 4; ++kk)
#pragma unroll
        for (int kt = 0; kt < 2; ++kt) {
          const bf16x8 ak = *(const bf16x8*)(sK + (kc * 64 + kt * 32 + tl) * 144 + kk * 32 + h * 16);
          S[kt] = MFMA32(ak, bq[j][kk], S[kt]);
        }
      if (samp) {
#pragma unroll
        for (int kt = 0; kt < 2; ++kt)
#pragma unroll
          for (int r = 0; r < 16; ++r) {
            int key = kc * 64 + kt * 32 + crow(r, h);
            if (key >= nkeys) S[kt][r] = -INFINITY;
          }
      }
      {
        float mx = -INFINITY;
#pragma unroll
        for (int kt = 0; kt < 2; ++kt)
#pragma unroll
          for (int r = 0; r < 16; ++r) mx = fmaxf(mx, S[kt][r]);
        mx = fmaxf(mx, __shfl_xor(mx, 32));
        const float mnew = fmaxf(mrun, mx);
        const float alpha = __expf(mrun - mnew);
        float ps = 0.f;
#pragma unroll
        for (int kt = 0; kt < 2; ++kt)
#pragma unroll
          for (int r = 0; r < 16; ++r) {
            float pv = __expf(S[kt][r] - mnew);
            S[kt][r] = pv;
            ps += pv;
          }
        ps += __shfl_xor(ps, 32);
        lrun = lrun * alpha + ps;
        mrun = mnew;
#pragma unroll
        for (int dt = 0; dt < 2; ++dt)
#pragma unroll
          for (int r = 0; r < 16; ++r) O[dt][r] *= alpha;
      }
#pragma unroll
      for (int kt = 0; kt < 2; ++kt)
#pragma unroll
        for (int s2 = 0; s2 < 2; ++s2) {
          u32x4 pp;
          pp[0] = pk2(S[kt][8 * s2 + 0], S[kt][8 * s2 + 1]);
          pp[1] = pk2(S[kt][8 * s2 + 2], S[kt][8 * s2 + 3]);
          pp[2] = pk2(S[kt][8 * s2 + 4], S[kt][8 * s2 + 5]);
          pp[3] = pk2(S[kt][8 * s2 + 6], S[kt][8 * s2 + 7]);
          const bf16x8 bp = __builtin_bit_cast(bf16x8, pp);
#pragma unroll
          for (int dt = 0; dt < 2; ++dt) {
            const int d = dt * 32 + tl;
            const uint2 lo = *(const uint2*)(sV + d * 400 + (kc * 64 + kt * 32 + 16 * s2 + 4 * h) * 2);
            const uint2 hi = *(const uint2*)(sV + d * 400 + (kc * 64 + kt * 32 + 16 * s2 + 8 + 4 * h) * 2);
            u32x4 av4;
            av4[0] = lo.x; av4[1] = lo.y; av4[2] = hi.x; av4[3] = hi.y;
            O[dt] = MFMA32(__builtin_bit_cast(bf16x8, av4), bp, O[dt]);
          }
        }
    }
    const float inv = 1.0f / lrun;
    float ss = 0.f;
    u16* To = (u16*)(smem + 53248);
#pragma unroll
    for (int dt = 0; dt < 2; ++dt)
#pragma unroll
      for (int g4 = 0; g4 < 4; ++g4) {
        int d = dt * 32 + 8 * g4 + 4 * h;
        float v0 = O[dt][4 * g4] * inv, v1 = O[dt][4 * g4 + 1] * inv, v2 = O[dt][4 * g4 + 2] * inv, v3 = O[dt][4 * g4 + 3] * inv;
        ss += v0 * v0 + v1 * v1 + v2 * v2 + v3 * v3;
        *(uint2*)(To + tl * 264 + w * 64 + d) = make_uint2(pk2(v0, v1), pk2(v2, v3));
      }
    ss += __shfl_xor(ss, 32);
    if (qvalid && h == 0) ((float*)(ws + W_SSQA))[(size_t)mqj * 8 + hq] = ss;
    __syncthreads();
    {
      const int mrow0 = samp ? (TP + b * 16) : (b * 2048 + c * 64 + j * 32);
#pragma unroll
      for (int it = 0; it < 4; ++it) {
        const int cidx = tid + 256 * it, rl = cidx >> 5, cc = cidx & 31;
        if (!samp || rl < 16)
          *(u32x4*)(ws + (unsigned)(W_CAT + ((mrow0 + rl) * 1024 + 512 + g * 256 + cc * 8) * 2)) = *(const u32x4*)(To + rl * 264 + cc * 8);
      }
    }
    __syncthreads();
    }
  }
}

struct CandTab { int i[64]; int j[64]; int n; };
constexpr CandTab make_tab() {
  CandTab t{};
  int n = 0;
  for (int i = 0; i < 16; ++i)
    for (int j = 0; j < 16; ++j)
      if ((i + 1) * (j + 1) <= 16) { t.i[n] = i; t.j[n] = j; ++n; }
  t.n = n;
  return t;
}

DI void route2(const Params& p, char* smem) {
  char* ws = p.ws;
  constexpr CandTab CT = make_tab();
  const int tid = otid();
  unsigned* Lp = (unsigned*)smem + tid * 33;
  for (int base = blockIdx.x * 256; base < TT * 8; base += gridDim.x * 256) {
    const int it = base + tid;
    const int mm = it >> 3, hd = it & 7;
    unsigned l1[16], l2[16];
    {
      const u32x4* s1 = (const u32x4*)((const unsigned*)(ws + W_TOPL) + ((size_t)mm * 16 + hd * 2) * 16);
#pragma unroll
      for (int q = 0; q < 4; ++q) {
        const u32x4 a = s1[q], b = s1[4 + q];
        l1[4 * q] = a[0]; l1[4 * q + 1] = a[1]; l1[4 * q + 2] = a[2]; l1[4 * q + 3] = a[3];
        l2[4 * q] = b[0]; l2[4 * q + 1] = b[1]; l2[4 * q + 2] = b[2]; l2[4 * q + 3] = b[3];
      }
    }
#pragma unroll
    for (int i = 0; i < 16; ++i) { Lp[i] = l1[i]; Lp[16 + i] = l2[i]; }
    float f1[16], f2[16];
#pragma unroll
    for (int i = 0; i < 16; ++i) { f1[i] = ord2f(l1[i] & ~127u); f2[i] = ord2f(l2[i] & ~127u); }
    unsigned top[16], tmp[16];
#pragma unroll
    for (int grp = 0; grp < 4; ++grp) {
#pragma unroll
      for (int q = 0; q < 16; ++q) {
        const int cidx = grp * 16 + q;
        unsigned key = 0;
        if (cidx < CT.n) {
          const int ci = CT.i[cidx], cj = CT.j[cidx];
          key = (f2ord(f1[ci] + f2[cj]) & ~255u) | (unsigned)(255 - (ci * 16 + cj));
        }
        if (grp == 0) top[q] = key; else tmp[q] = key;
      }
      if (grp == 0) sort16_desc(top);
      else { sort16_desc(tmp); merge_top16(top, tmp); }
    }
    float sv[16]; int ex[16];
    float smax = -INFINITY;
#pragma unroll
    for (int q = 0; q < 16; ++q) {
      const int code = 255 - (int)(top[q] & 255u);
      const int ci = code >> 4, cj = code & 15;
      const unsigned a = Lp[ci], bb = Lp[16 + cj];
      const int i1 = 127 - (int)(a & 127u), i2 = 127 - (int)(bb & 127u);
      sv[q] = ord2f(a & ~127u) + ord2f(bb & ~127u);
      ex[q] = i1 * 128 + i2;
      smax = fmaxf(smax, sv[q]);
    }
    float sum = 0.f;
#pragma unroll
    for (int q = 0; q < 16; ++q) { sv[q] = __expf(sv[q] - smax); sum += sv[q]; }
    const float inv = 1.0f / sum;
    int4* di = (int4*)((int*)(ws + W_SIDX) + (size_t)mm * 128 + hd * 16);
    float4* dg = (float4*)((float*)(ws + W_SGATE) + (size_t)mm * 128 + hd * 16);
#pragma unroll
    for (int q = 0; q < 4; ++q) {
      di[q] = make_int4(ex[4 * q], ex[4 * q + 1], ex[4 * q + 2], ex[4 * q + 3]);
      dg[q] = make_float4(sv[4 * q] * inv, sv[4 * q + 1] * inv, sv[4 * q + 2] * inv, sv[4 * q + 3] * inv);
    }
  }
}

DI void peer_u_phase(const Params& p) {
  char* ws = p.ws;
  const int tid_ = otid(); const int lane = tid_ & 63, w = tid_ >> 6, g = lane >> 3, li = lane & 7;
  const int v = blockIdx.x & 7, bx = blockIdx.x >> 3, nbx = (gridDim.x - v + 7) >> 3;
  const int gwx = bx * 4 + w, nwx = nbx * 4;
  const char* Us = ws + W_UB + (size_t)v * 16384 * 128;
  const unsigned loff = li * 16;
  const int* sidx = (const int*)(ws + W_SIDX) + g * 16;
  int4 ix[4];
  u32x4 hq0, hq1;
  int m = gwx;
  if (m < TT) {
#pragma unroll
    for (int q = 0; q < 4; ++q) ix[q] = ((const int4*)(sidx + (size_t)m * 128))[q];
    const u32x4* hp = (const u32x4*)(ws + W_HB + (size_t)m * 2048 + v * 256 + li * 32);
    hq0 = hp[0]; hq1 = hp[1];
  }
  for (; m < TT; m += nwx) {
    const int idx[16] = {ix[0].x, ix[0].y, ix[0].z, ix[0].w, ix[1].x, ix[1].y, ix[1].z, ix[1].w,
                         ix[2].x, ix[2].y, ix[2].z, ix[2].w, ix[3].x, ix[3].y, ix[3].z, ix[3].w};
    u32x4 rows[16];
#pragma unroll
    for (int s2 = 0; s2 < 16; ++s2) rows[s2] = *(const u32x4*)(Us + (((unsigned)idx[s2] << 7) + loff));
    fl2_t hv[8];
    hv[0] = {bf_lo(hq0[0]), bf_hi(hq0[0])}; hv[1] = {bf_lo(hq0[1]), bf_hi(hq0[1])};
    hv[2] = {bf_lo(hq0[2]), bf_hi(hq0[2])}; hv[3] = {bf_lo(hq0[3]), bf_hi(hq0[3])};
    hv[4] = {bf_lo(hq1[0]), bf_hi(hq1[0])}; hv[5] = {bf_lo(hq1[1]), bf_hi(hq1[1])};
    hv[6] = {bf_lo(hq1[2]), bf_hi(hq1[2])}; hv[7] = {bf_lo(hq1[3]), bf_hi(hq1[3])};
    const int mn = m + nwx;
    if (mn < TT) {
#pragma unroll
      for (int q = 0; q < 4; ++q) ix[q] = ((const int4*)(sidx + (size_t)mn * 128))[q];
      const u32x4* hp = (const u32x4*)(ws + W_HB + (size_t)mn * 2048 + v * 256 + li * 32);
      hq0 = hp[0]; hq1 = hp[1];
    }
    float ps[16];
#pragma unroll
    for (int s2 = 0; s2 < 16; ++s2) {
      fl2_t acc = {0.f, 0.f};
#pragma unroll
      for (int d = 0; d < 4; ++d) {
        const fl2_t lo = __builtin_amdgcn_cvt_pk_f32_fp8((int)rows[s2][d], false);
        const fl2_t hi = __builtin_amdgcn_cvt_pk_f32_fp8((int)rows[s2][d], true);
        acc = __builtin_elementwise_fma(lo, hv[2 * d], acc);
        acc = __builtin_elementwise_fma(hi, hv[2 * d + 1], acc);
      }
      ps[s2] = acc.x + acc.y;
    }
#pragma unroll
    for (int st = 0; st < 3; ++st) {
      const int bit = 4 >> st, half = 8 >> st;
      const bool upper = (li & bit) != 0;
#pragma unroll
      for (int i = 0; i < half; ++i) {
        const float send = upper ? ps[i] : ps[i + half];
        const float keep = upper ? ps[i + half] : ps[i];
        ps[i] = keep + __shfl_xor(send, bit);
      }
    }
    const int sl = ((li >> 2) & 1) * 8 + ((li >> 1) & 1) * 4 + (li & 1) * 2;
    *(unsigned*)((u16*)(ws + W_PART) + ((size_t)m * 8 + v) * 128 + g * 16 + sl) = pk2(ps[0], ps[1]);
  }
}

DI void peer_combine(const Params& p) {
  char* ws = p.ws;
  const size_t gt = (size_t)blockIdx.x * 256 + otid(), gstride = (size_t)gridDim.x * 256;
  for (size_t i = gt; i < (size_t)TT * 16; i += gstride) {
    const size_t m = i >> 4, s8 = (i & 15) * 8;
    const u16* pp = (const u16*)(ws + W_PART) + m * 1024 + s8;
    float d[8] = {0.f, 0.f, 0.f, 0.f, 0.f, 0.f, 0.f, 0.f};
#pragma unroll
    for (int v = 0; v < 8; ++v) {
      const u32x4 q = *(const u32x4*)(pp + v * 128);
#pragma unroll
      for (int k = 0; k < 4; ++k) { d[2 * k] += bf_lo(q[k]); d[2 * k + 1] += bf_hi(q[k]); }
    }
    const float sc = ((const float*)(ws + W_RS2))[m] * (1.0f / USCALE);
    const f32x4* gp = (const f32x4*)((const float*)(ws + W_SGATE) + m * 128 + s8);
    const f32x4 g0 = gp[0], g1 = gp[1];
    f32x4 o0, o1;
#pragma unroll
    for (int k = 0; k < 4; ++k) {
      o0[k] = gelu_(d[k] * sc) * g0[k] * (1.0f / VSCALE);
      o1[k] = gelu_(d[4 + k] * sc) * g1[k] * (1.0f / VSCALE);
    }
    f32x4* op = (f32x4*)((float*)(ws + W_WTS) + m * 128 + s8);
    op[0] = o0; op[1] = o1;
  }
}

DI void peer_v_phase(const Params& p) {
  char* ws = p.ws;
  const int tid_ = otid(); const int lane = tid_ & 63, w = tid_ >> 6, g = lane >> 3, li = lane & 7;
  const int v = blockIdx.x & 7, bx = blockIdx.x >> 3, nbx = (gridDim.x - v + 7) >> 3;
  const int gwx = bx * 4 + w, nwx = nbx * 4;
  const char* Vs = ws + W_VB + (size_t)v * 16384 * 128;
  const unsigned loff = li * 16;
  const int* sidx = (const int*)(ws + W_SIDX) + g * 16;
  const float* wts = (const float*)(ws + W_WTS) + g * 16;
  int4 ix[4];
  float4 wx[4];
  int m = gwx;
  if (m < TT) {
#pragma unroll
    for (int q = 0; q < 4; ++q) { ix[q] = ((const int4*)(sidx + (size_t)m * 128))[q]; wx[q] = ((const float4*)(wts + (size_t)m * 128))[q]; }
  }
  for (; m < TT; m += nwx) {
    const int idx[16] = {ix[0].x, ix[0].y, ix[0].z, ix[0].w, ix[1].x, ix[1].y, ix[1].z, ix[1].w,
                         ix[2].x, ix[2].y, ix[2].z, ix[2].w, ix[3].x, ix[3].y, ix[3].z, ix[3].w};
    const float wt[16] = {wx[0].x, wx[0].y, wx[0].z, wx[0].w, wx[1].x, wx[1].y, wx[1].z, wx[1].w,
                          wx[2].x, wx[2].y, wx[2].z, wx[2].w, wx[3].x, wx[3].y, wx[3].z, wx[3].w};
    u32x4 rows[16];
#pragma unroll
    for (int s2 = 0; s2 < 16; ++s2) rows[s2] = *(const u32x4*)(Vs + (((unsigned)idx[s2] << 7) + loff));
    const int mn = m + nwx;
    if (mn < TT) {
#pragma unroll
      for (int q = 0; q < 4; ++q) { ix[q] = ((const int4*)(sidx + (size_t)mn * 128))[q]; wx[q] = ((const float4*)(wts + (size_t)mn * 128))[q]; }
    }
    fl2_t acc[8];
#pragma unroll
    for (int q = 0; q < 8; ++q) acc[q] = {0.f, 0.f};
#pragma unroll
    for (int s2 = 0; s2 < 16; ++s2) {
      const fl2_t ww = {wt[s2], wt[s2]};
#pragma unroll
      for (int d = 0; d < 4; ++d) {
        const fl2_t lo = __builtin_amdgcn_cvt_pk_f32_fp8((int)rows[s2][d], false);
        const fl2_t hi = __builtin_amdgcn_cvt_pk_f32_fp8((int)rows[s2][d], true);
        acc[2 * d] = __builtin_elementwise_fma(lo, ww, acc[2 * d]);
        acc[2 * d + 1] = __builtin_elementwise_fma(hi, ww, acc[2 * d + 1]);
      }
    }
    float ps[16];
#pragma unroll
    for (int q = 0; q < 8; ++q) { ps[2 * q] = acc[q].x; ps[2 * q + 1] = acc[q].y; }
#pragma unroll
    for (int st = 0; st < 3; ++st) {
      const int bit = 32 >> st, half = 8 >> st;
      const bool upper = (lane & bit) != 0;
#pragma unroll
      for (int i = 0; i < half; ++i) {
        const float send = upper ? ps[i] : ps[i + half];
        const float keep = upper ? ps[i + half] : ps[i];
        ps[i] = keep + __shfl_xor(send, bit);
      }
    }
    const int cl = ((g >> 2) & 1) * 8 + ((g >> 1) & 1) * 4 + (g & 1) * 2;
    const size_t yo = (size_t)m * 1024 + v * 128 + li * 16 + cl;
    const unsigned hb2 = *(const unsigned*)((const u16*)(ws + W_HB) + yo);
    *(float2*)(p.out + O_Y + yo) = make_float2(bf_lo(hb2) + ps[0], bf_hi(hb2) + ps[1]);
  }
}

#define XB_TMO      128
#define XB_XCNT(j)  (256  + 64 * (j))
#define XB_XSUB(j)  (1280 + 64 * (j))
#define XB_XGEN(j)  (2304 + 64 * (j))
#define XB_TOP      3328
#define XB_TOPGEN   3392
#define XCD_BAR_WORDS 3456
#define XB_SPIN_CAP (1u << 18)
#define LAS __attribute__((address_space(3)))
DI unsigned xb_ld(unsigned* p) { return __hip_atomic_load(p, __ATOMIC_RELAXED, __HIP_MEMORY_SCOPE_AGENT); }
DI unsigned xb_add(unsigned* p, unsigned v) { return __hip_atomic_fetch_add(p, v, __ATOMIC_RELAXED, __HIP_MEMORY_SCOPE_AGENT); }
DI unsigned xb_xcc_id() { return (unsigned)__builtin_amdgcn_s_getreg((3 << 11) | 20) & 0xFu; }
#define XB_SPIN(cond, bar) do { unsigned _sp = 0; while (cond) { __builtin_amdgcn_s_sleep(1); \
    if ((++_sp & 255u) == 0u) { if (xb_ld(&(bar)[XB_TMO])) break; if (_sp > XB_SPIN_CAP) { atomicAdd(&(bar)[XB_TMO], 1u); break; } } } } while (0)
struct XcdBarrier { unsigned* bar; unsigned x; volatile LAS unsigned* st; };
DI XcdBarrier xcd_barrier_post(unsigned* bar, volatile LAS unsigned* st) {
  XcdBarrier b; b.bar = bar; b.x = xb_xcc_id(); b.st = st;
  if (threadIdx.x == 0) (void)xb_add(&bar[XB_XCNT(b.x)], 1u);
  return b;
}
DI void xcd_barrier_complete(unsigned* bar, unsigned x, unsigned& nloc, unsigned& nx) {
  const unsigned G = gridDim.x * gridDim.y * gridDim.z;
  unsigned sum, cnt, mine, sp = 0u;
  for (;;) {
    sum = 0u; cnt = 0u; mine = 0u;
#pragma unroll
    for (unsigned j = 0; j < 16; ++j) { const unsigned c = xb_ld(&bar[XB_XCNT(j)]); sum += c; cnt += (c > 0u) ? 1u : 0u; mine = (j == x) ? c : mine; }
    if (sum == G) break;
    __builtin_amdgcn_s_sleep(1);
    if ((++sp & 255u) == 0u) { if (xb_ld(&bar[XB_TMO])) break; if (sp > XB_SPIN_CAP) { atomicAdd(&bar[XB_TMO], 1u); break; } }
  }
  nloc = mine > 0u ? mine : 1u; nx = cnt > 0u ? cnt : 1u;
}
DI void xcd_barrier(const XcdBarrier& b) {
  asm volatile("s_waitcnt vmcnt(0)" ::: "memory");
  __syncthreads();
  if (threadIdx.x == 0) {
    unsigned* bar = b.bar;
    __builtin_amdgcn_s_waitcnt(0);
    unsigned nloc = b.st[0], nx = b.st[1];
    if (nloc == 0u) { xcd_barrier_complete(bar, b.x, nloc, nx); b.st[0] = nloc; b.st[1] = nx; }
    const unsigned old = xb_add(&bar[XB_XSUB(b.x)], 1u);
    const unsigned gen = old / nloc;
    if (old + 1u == (gen + 1u) * nloc) {
      __builtin_amdgcn_fence(__ATOMIC_RELEASE, "agent");
      asm volatile("s_waitcnt vmcnt(0)" ::: "memory");
      const unsigned og = xb_add(&bar[XB_TOP], 1u);
      const unsigned tg = og / nx;
      if (og + 1u == (tg + 1u) * nx) xb_add(&bar[XB_TOPGEN], 1u);
      else XB_SPIN(xb_ld(&bar[XB_TOPGEN]) == tg, bar);
      __builtin_amdgcn_fence(__ATOMIC_ACQUIRE, "agent");
      xb_add(&bar[XB_XGEN(b.x)], 1u);
      asm volatile("s_waitcnt vmcnt(0)" ::: "memory");
    } else {
      XB_SPIN(xb_ld(&bar[XB_XGEN(b.x)]) == gen, bar);
      __builtin_amdgcn_fence(__ATOMIC_ACQUIRE, "agent");
      asm volatile("s_waitcnt vmcnt(0)" ::: "memory");
    }
  }
  __syncthreads();
}

__global__ void __launch_bounds__(256, 2) hymba_mega(Params p) {
  __shared__ __attribute__((aligned(16))) char smem[73728];
  __shared__ uint4 xb_words;
  cg::grid_group grid = cg::this_grid();
  const int nb = gridDim.x, bid = blockIdx.x;
  const bool xcd_ok = (nb & 7) == 0 && nb >= 8;
  const int vx = bid & 7, bxx = bid >> 3, nbx = nb >> 3;
  if (threadIdx.x == 0) xb_words = make_uint4(0u, 0u, 0u, 0u);
  __syncthreads();
  XcdBarrier xb = xcd_barrier_post((unsigned*)(p.ws + W_BAR), (volatile LAS unsigned*)&xb_words);
  if (p.out == nullptr) grid.sync();
  phase0(p, smem);
  xcd_barrier(xb);
  {
    const int cnt = xcd_ok ? ((130 - vx + 7) >> 3) * 14 : 130 * 14;
    for (int u = xcd_ok ? bxx : bid; u < cnt; u += xcd_ok ? nbx : nb) {
      const int mt = xcd_ok ? vx + 8 * (u / 14) : u / 14;
      gemm_tile<1>(p, mt, u % 14, smem);
    }
    __syncthreads();
    phase0b(p, smem);
  }
  xcd_barrier(xb);
  for (int it = bid; it < 512; it += nb) lru_item<0>(p, it, smem);
  xcd_barrier(xb);
  {
    __shared__ int q_item;
    unsigned* qhead = (unsigned*)(p.ws + W_QW);
    int it = bid;
    while (it < 528 + 544) {
      if (it < 528) lru_item<1>(p, it, smem);
      else attn_item(p, it - 528, smem);
      __syncthreads();
      if (threadIdx.x == 0) q_item = nb + (int)atomicAdd(qhead, 1u);
      __syncthreads();
      it = q_item;
    }
  }
  xcd_barrier(xb);
  {
    const int cnt = xcd_ok ? 130 : 130 * 8, st = xcd_ok ? bxx : bid, sd = xcd_ok ? nbx : nb;
    for (int u = st; u < cnt; u += sd) gemm_tile<2>(p, xcd_ok ? u : (u >> 3), xcd_ok ? vx : (u & 7), smem);
    const int extra = cnt % sd;
    (void)extra;
    conv_table_queue(p, true, (unsigned*)(p.ws + W_QW + 64));
  }
  xcd_barrier(xb);
  {
    const int cnt = xcd_ok ? 260 : 130 * 16, st = xcd_ok ? bxx : bid, sd = xcd_ok ? nbx : nb;
    for (int u = st; u < cnt; u += sd) gemm_tile<3>(p, xcd_ok ? (u >> 1) : (u >> 4), xcd_ok ? (vx * 2 + (u & 1)) : (u & 15), smem);
    const int extra = cnt % sd;
    (void)extra;
    conv_table_queue(p, false, (unsigned*)(p.ws + W_QW + 128));
  }
  xcd_barrier(xb);
  __syncthreads();
  route2(p, smem);
  xcd_barrier(xb);
  peer_u_phase(p);
  xcd_barrier(xb);
  peer_combine(p);
  xcd_barrier(xb);
  peer_v_phase(p);
}

extern "C" void kernel_launch(void* const* d_in, const int* in_sizes, int n_in, void* d_out, int out_size, void* d_ws,
                              size_t ws_size, hipStream_t stream) {
  static int grid_blocks = 0;
  if (!grid_blocks) {
    int dev = 0, cus = 0, per_cu = 0;
    (void)hipGetDevice(&dev);
    (void)hipDeviceGetAttribute(&cus, hipDeviceAttributeMultiprocessorCount, dev);
    (void)hipOccupancyMaxActiveBlocksPerMultiprocessor(&per_cu, hymba_mega, 256, 0);
    if (per_cu > 2) per_cu = 2;
    if (per_cu < 1) per_cu = 1;
    grid_blocks = cus * per_cu;
  }
  if (ws_size < W_END) fprintf(stderr, "workspace too small: %zu < %zu\n", ws_size, (size_t)W_END);
  Params p{};
  const float** pp = (const float**)&p;
  for (int i = 0; i < 27; ++i) pp[i] = (const float*)d_in[i];
  p.out = (float*)d_out;
  p.ws = (char*)d_ws;
  (void)hipMemsetAsync((char*)d_ws + W_BAR, 0, al(XCD_BAR_WORDS * 4) + 256, stream);
  void* args[] = {&p};
  hipError_t e = hipLaunchCooperativeKernel((void*)hymba_mega, dim3(grid_blocks), dim3(256), args, 0, stream);
  if (e != hipSuccess) fprintf(stderr, "cooperative launch failed: %s (grid %d)\n", hipGetErrorString(e), grid_blocks);
}
```

```cpp
#include <hip/hip_runtime.h>
#include <hip/hip_cooperative_groups.h>
#include <cstdio>
namespace cg = cooperative_groups;

#define DI __device__ __forceinline__
typedef __bf16 bf2_t __attribute__((ext_vector_type(2)));
typedef float fl2_t __attribute__((ext_vector_type(2)));
typedef short bf16x8 __attribute__((ext_vector_type(8)));
typedef float f32x16 __attribute__((ext_vector_type(16)));
typedef unsigned short u16;
typedef unsigned u32x4 __attribute__((ext_vector_type(4)));
typedef float f32x4 __attribute__((ext_vector_type(4)));
#define MFMA32(a, b, c) __builtin_amdgcn_mfma_f32_32x32x16_bf16((a), (b), (c), 0, 0, 0)

constexpr int TP = 16384, TS = 256, TT = 16640;
constexpr float EPS = 1e-6f;
constexpr float USCALE = 512.0f, VSCALE = 64.0f;

constexpr size_t O_Y = 0;
constexpr size_t O_KP = 17039360, O_VP = 17170432, O_CONVP = 17301504, O_LRUP = 17313792;
constexpr size_t O_KS = 17317888, O_VS = 17580032, O_CONVS = 17842176, O_LRUS = 17866752;

constexpr size_t al(size_t x) { return (x + 255) & ~size_t(255); }
constexpr size_t W_WTIN = 0;
constexpr size_t W_WTOUT = W_WTIN + al(1792ull * 1024 * 2);
constexpr size_t W_WTQ = W_WTOUT + al(1024ull * 1024 * 2);
constexpr size_t W_K1B = W_WTQ + al(2048ull * 1024 * 2);
constexpr size_t W_K2B = W_K1B + al(128 * 128 * 2);
constexpr size_t W_WAT = W_K2B + al(128 * 128 * 2);
constexpr size_t W_WIT = W_WAT + al(8 * 64 * 64 * 2);
constexpr size_t W_C8 = W_WIT + al(8 * 64 * 64 * 2);
constexpr size_t W_UB = W_C8 + al(512 * 4);
constexpr size_t W_VB = W_UB + 16384ull * 1024;
constexpr size_t W_XB = W_UB + al(16384ull * 1024 * 2);
constexpr size_t W_RB = W_XB + al(16384ull * 1024 * 2);
constexpr size_t W_CAT = W_RB;
constexpr size_t W_SIDX = W_RB;
constexpr size_t W_SGATE = W_RB + al(TT * 128ull * 4);
constexpr size_t W_RC = W_RB + al(TT * 1024ull * 2);
constexpr size_t W_U = W_RC;
constexpr size_t W_GG = W_RC + TT * 512ull * 2;
constexpr size_t W_HB = W_RC;
constexpr size_t W_Q = W_RC + al(TT * 1024ull * 2);
constexpr size_t W_KP = W_Q + al(TT * 512ull * 2);
constexpr size_t W_KS = W_KP + al(TP * 128ull * 2);
constexpr size_t W_VTP = W_KS + al(16 * 192 * 128 * 2);
constexpr size_t W_VTS = W_VTP + al(8 * 128 * 2048ull * 2);
constexpr size_t W_SUMA = W_VTS + al(16 * 128 * 192 * 2);
constexpr size_t W_SUMH = W_SUMA + al(512 * 512 * 4);
constexpr size_t W_RS1 = W_SUMH + al(512 * 512 * 4);
constexpr size_t W_SSQL = W_RS1 + al(TT * 4);
constexpr size_t W_SSQA = W_SSQL + al(TT * 4 * 4);
constexpr size_t W_SSQ2 = W_SSQA + al(TT * 8 * 4);
constexpr size_t W_PQ = W_SSQ2 + al(TT * 16 * 4);
constexpr size_t W_TOPL = W_PQ;
constexpr size_t W_PART = W_PQ;
constexpr size_t W_WTS = W_SGATE + al(TT * 128ull * 4);
constexpr size_t W_RS2 = W_PQ + al(TT * 2048ull * 2);
constexpr size_t W_BAR = W_RS2 + al(TT * 4);
constexpr size_t W_QW = W_BAR + al(3456 * 4);
constexpr size_t W_XBS = W_QW + 256;
constexpr size_t W_END = W_XBS + al(256ull * 2048);

struct Params {
  const float *x_p, *x_s, *cache_k, *cache_v, *state_conv, *state_lru, *ln1_g, *w_in, *conv_w, *conv_b,
      *lru_wa, *lru_ba, *lru_wi, *lru_bi, *lru_lambda, *q_g, *k_g, *sinks, *g_lru, *g_attn, *w_out, *ln2_g,
      *w_query, *sk1, *sk2, *peer_u, *peer_v;
  float* out;
  char* ws;
};

DI unsigned pk2(float a, float b) {
  fl2_t f = {a, b};
  return __builtin_bit_cast(unsigned, __builtin_convertvector(f, bf2_t));
}
DI float bf_lo(unsigned u) { return __uint_as_float(u << 16); }
DI float bf_hi(unsigned u) { return __uint_as_float(u & 0xffff0000u); }
DI float bf1(u16 v) { return __uint_as_float(((unsigned)v) << 16); }
DI float sigmoidf_(float x) { return __builtin_amdgcn_rcpf(1.0f + __expf(-x)); }
DI float gelu_(float x) {
  float z = 0.7978845608028654f * (x + 0.044715f * x * x * x);
  return x * __builtin_amdgcn_rcpf(1.0f + __expf(-2.0f * z));
}
DI int otid() { int t = threadIdx.x; asm volatile("" : "+v"(t)); return t; }
DI int crow(int r, int h) { return (r & 3) + 8 * (r >> 2) + 4 * h; }

DI void transpose_tile(const float* __restrict__ src, int ld_src, u16* __restrict__ dst, int ld_dst, int k0, int n0,
                       const float* __restrict__ gain, float* tile) {
  const int tid = otid();
  const int c = tid & 63, r0 = tid >> 6;
  __syncthreads();
#pragma unroll 4
  for (int rr = 0; rr < 16; ++rr) {
    int r = rr * 4 + r0;
    float v = src[(size_t)(k0 + r) * ld_src + n0 + c];
    if (gain) v *= gain[k0 + r];
    tile[r * 65 + c] = v;
  }
  __syncthreads();
  const int n = tid >> 2, kq = (tid & 3) * 16;
  unsigned pk[8];
#pragma unroll
  for (int i = 0; i < 8; ++i) pk[i] = pk2(tile[(kq + 2 * i) * 65 + n], tile[(kq + 2 * i + 1) * 65 + n]);
  uint4* d = (uint4*)(dst + (size_t)(n0 + n) * ld_dst + k0 + kq);
  d[0] = make_uint4(pk[0], pk[1], pk[2], pk[3]);
  d[1] = make_uint4(pk[4], pk[5], pk[6], pk[7]);
}

DI void wf_tile(const Params& p, int hh, int ktile) {
  const int tid = otid(), lane = tid & 63, w = tid >> 6, wn = w & 1, wm = w >> 1, tl = lane & 31, h = lane >> 5;
  const float* sk = (hh & 1) ? p.sk2 : p.sk1;
  f32x16 acc[2][2];
#pragma unroll
  for (int i = 0; i < 2; ++i)
#pragma unroll
    for (int j = 0; j < 2; ++j)
#pragma unroll
      for (int r = 0; r < 16; ++r) acc[i][j][r] = 0.f;
  const int kcol0 = ktile * 128 + wm * 64 + tl;
  const float g2a = p.ln2_g[kcol0], g2b = p.ln2_g[kcol0 + 32];
#pragma unroll 2
  for (int kk = 0; kk < 8; ++kk) {
    bf16x8 a[2], b[2];
#pragma unroll
    for (int i = 0; i < 2; ++i) {
      const float4* sp = (const float4*)(sk + (size_t)(wn * 64 + i * 32 + tl) * 128 + kk * 16 + h * 8);
      const float4 x = sp[0], y = sp[1];
      u32x4 t; t[0] = pk2(x.x, x.y); t[1] = pk2(x.z, x.w); t[2] = pk2(y.x, y.y); t[3] = pk2(y.z, y.w);
      a[i] = __builtin_bit_cast(bf16x8, t);
    }
#pragma unroll
    for (int j = 0; j < 2; ++j) {
      const float gg = j ? g2b : g2a;
      const float4* sp = (const float4*)(p.w_query + (size_t)(kcol0 + j * 32) * 2048 + hh * 128 + kk * 16 + h * 8);
      const float4 x = sp[0], y = sp[1];
      u32x4 t; t[0] = pk2(x.x * gg, x.y * gg); t[1] = pk2(x.z * gg, x.w * gg); t[2] = pk2(y.x * gg, y.y * gg); t[3] = pk2(y.z * gg, y.w * gg);
      b[j] = __builtin_bit_cast(bf16x8, t);
    }
#pragma unroll
    for (int i = 0; i < 2; ++i)
#pragma unroll
      for (int j = 0; j < 2; ++j) acc[i][j] = MFMA32(a[i], b[j], acc[i][j]);
  }
  u16* dst = (u16*)(p.ws + W_WTQ);
#pragma unroll
  for (int i = 0; i < 2; ++i)
#pragma unroll
    for (int j = 0; j < 2; ++j)
#pragma unroll
      for (int r = 0; r < 16; r += 2) {
        const int key = wn * 64 + i * 32 + crow(r, h);
        const unsigned pkv = pk2(acc[i][j][r], acc[i][j][r + 1]);
        dst[(size_t)(hh * 128 + key) * 1024 + kcol0 + j * 32] = (u16)(pkv & 0xffffu);
        dst[(size_t)(hh * 128 + key + 1) * 1024 + kcol0 + j * 32] = (u16)(pkv >> 16);
      }
}

DI void conv_table(const Params& p, bool isU, int part, int nparts, int seg = 0, int nseg = 1) {
  char* ws = p.ws;
  const float* src = isU ? p.peer_u : p.peer_v;
  char* dstb = ws + (isU ? W_UB : W_VB);
  const float scale = isU ? USCALE : VSCALE;
  const size_t i0 = (16384ull * 64 / nseg) * seg, i1 = i0 + 16384ull * 64 / nseg;
  for (size_t i = i0 + (size_t)part * 256 + threadIdx.x; i < i1; i += (size_t)nparts * 256) {
    const int e = (int)(i >> 6), c16 = (int)(i & 63);
    const float4* su = (const float4*)(src + (size_t)e * 1024 + c16 * 16);
    const float4* g2 = (const float4*)(p.ln2_g + c16 * 16);
    u32x4 ou;
#pragma unroll
    for (int q = 0; q < 4; ++q) {
      float4 a = su[q];
      if (isU) { const float4 g = g2[q]; a.x *= g.x; a.y *= g.y; a.z *= g.z; a.w *= g.w; }
      int pu = 0;
      pu = __builtin_amdgcn_cvt_pk_fp8_f32(a.x * scale, a.y * scale, pu, false);
      pu = __builtin_amdgcn_cvt_pk_fp8_f32(a.z * scale, a.w * scale, pu, true);
      ou[q] = (unsigned)pu;
    }
    const size_t off = ((size_t)((c16 >> 3) * 16384 + e)) * 128 + (c16 & 7) * 16;
    *(u32x4*)(dstb + off) = ou;
  }
}

DI void conv_table_queue(const Params& p, bool isU, unsigned* qhead) {
  __shared__ int q_chunk;
  for (;;) {
    __syncthreads();
    if (threadIdx.x == 0) q_chunk = (int)atomicAdd(qhead, 1u);
    __syncthreads();
    const int ch = q_chunk;
    if (ch >= 1024) break;
    conv_table(p, isU, 0, 1, ch, 1024);
  }
}

DI void phase0(const Params& p, char* smem) {
  const int nb = gridDim.x, bid = blockIdx.x, tid = otid();
  char* ws = p.ws;
  float* tile = (float*)smem;
  for (int it = bid; it < 448; it += nb) {
    int kt = it / 28, nt = it % 28;
    transpose_tile(p.w_in, 1792, (u16*)(ws + W_WTIN), 1024, kt * 64, nt * 64, p.ln1_g, tile);
  }
  {
    const int lane = tid & 63;
    const int gw = bid * 4 + (tid >> 6), nw = nb * 4;
    for (int m = gw; m < TT; m += nw) {
      const float* xr = (m < TP) ? (p.x_p + (size_t)m * 1024) : (p.x_s + (size_t)(m - TP) * 1024);
      const float4* xp = (const float4*)xr;
      float ss = 0.f;
      uint4* dst = (uint4*)(ws + ((m < TP) ? (W_XB + (size_t)m * 2048) : (W_XBS + (size_t)(m - TP) * 2048)));
#pragma unroll
      for (int q = 0; q < 2; ++q) {
        float4 a = xp[q * 128 + lane * 2], b = xp[q * 128 + lane * 2 + 1];
        ss += a.x * a.x + a.y * a.y + a.z * a.z + a.w * a.w + b.x * b.x + b.y * b.y + b.z * b.z + b.w * b.w;
        dst[q * 64 + lane] = make_uint4(pk2(a.x, a.y), pk2(a.z, a.w), pk2(b.x, b.y), pk2(b.z, b.w));
      }
#pragma unroll
      for (int s = 32; s >= 1; s >>= 1) ss += __shfl_xor(ss, s);
      if (lane == 0) ((float*)(ws + W_RS1))[m] = rsqrtf(ss * (1.0f / 1024.0f) + EPS);
    }
  }
}

DI void phase0b(const Params& p, char* smem) {
  const int nb = gridDim.x, bid = blockIdx.x, tid = otid();
  char* ws = p.ws;
  float* tile = (float*)smem;
  for (int it = nb - 1 - bid; it < 384; it += nb) {
    if (it < 256) {
      int kt = it >> 4, nt = it & 15;
      const float* gain = (kt < 8) ? p.g_lru : (p.g_attn - 512);
      transpose_tile(p.w_out, 1024, (u16*)(ws + W_WTOUT), 1024, kt * 64, nt * 64, gain, tile);
    } else {
      wf_tile(p, (it - 256) >> 3, (it - 256) & 7);
    }
  }
  const size_t gt = (size_t)bid * 256 + tid, gstride = (size_t)nb * 256;
  for (size_t i = gt; i < 8192; i += gstride) {
    const int mat = (int)(i >> 12), r = (int)(i & 4095);
    const int ln = r & 63, kk = (r >> 6) & 3, ii = (r >> 8) & 1, n = r >> 9;
    const float* src = (mat ? p.lru_wi : p.lru_wa) + n * 4096 + (kk * 16 + (ln >> 5) * 8) * 64 + ii * 32 + (ln & 31);
    u32x4 o;
    o[0] = pk2(src[0], src[64]); o[1] = pk2(src[128], src[192]); o[2] = pk2(src[256], src[320]); o[3] = pk2(src[384], src[448]);
    *(u32x4*)(ws + (mat ? W_WIT : W_WAT) + (size_t)r * 16) = o;
  }
  for (size_t i = gt; i < 512; i += gstride) {
    float l = p.lru_lambda[i];
    float sp = (l < -15.f) ? -l : log1pf(expf(-l));
    ((float*)(ws + W_C8))[i] = -8.0f * sp;
  }
  for (size_t i = gt; i < 16 * 128 * 16; i += gstride) {
    int b = (int)(i >> 11), rem = (int)(i & 2047);
    int t = rem >> 4, c8i = rem & 15;
    const float4* sk = (const float4*)(p.cache_k + ((size_t)(b * 128 + t) * 128 + c8i * 8));
    float4 a = sk[0], bb = sk[1];
    uint4 o = make_uint4(pk2(a.x, a.y), pk2(a.z, a.w), pk2(bb.x, bb.y), pk2(bb.z, bb.w));
    *(uint4*)(ws + W_KS + ((size_t)(b * 192 + t) * 128 + c8i * 8) * 2) = o;
    const float4* sv = (const float4*)(p.cache_v + ((size_t)(b * 128 + t) * 128 + c8i * 8));
    float4 va = sv[0], vb = sv[1];
    if (t >= 16) {
      float4* dk = (float4*)(p.out + O_KS + ((size_t)(b * 128 + t - 16) * 128 + c8i * 8));
      dk[0] = a; dk[1] = bb;
      float4* dv = (float4*)(p.out + O_VS + ((size_t)(b * 128 + t - 16) * 128 + c8i * 8));
      dv[0] = va; dv[1] = vb;
    }
    u16* vt = (u16*)(ws + W_VTS) + (size_t)b * 128 * 192;
    float vv[8] = {va.x, va.y, va.z, va.w, vb.x, vb.y, vb.z, vb.w};
#pragma unroll
    for (int q = 0; q < 8; ++q) vt[(size_t)(c8i * 8 + q) * 192 + t] = (u16)(pk2(vv[q], 0.f) & 0xffffu);
  }
  for (size_t i = gt; i < 16 * 48 * 128; i += gstride) {
    int b = (int)(i / (48 * 128)), rem = (int)(i % (48 * 128));
    ((u16*)(ws + W_KS))[(size_t)(b * 192 + 144) * 128 + rem] = 0;
    int ch = rem / 48, tt = rem % 48;
    ((u16*)(ws + W_VTS))[(size_t)(b * 128 + ch) * 192 + 144 + tt] = 0;
  }
}

DI unsigned f2ord(float f) { unsigned u = __float_as_uint(f); return u ^ ((unsigned)((int)u >> 31) | 0x80000000u); }
DI float ord2f(unsigned u) { return __uint_as_float((u & 0x80000000u) ? (u ^ 0x80000000u) : ~u); }
DI void cas_desc(unsigned& a, unsigned& b) { unsigned mx = a > b ? a : b, mn = a > b ? b : a; a = mx; b = mn; }
DI void sort16_desc(unsigned (&v)[16]) {
#define CS(a, b) cas_desc(v[a], v[b]);
  CS(0,13) CS(1,12) CS(2,15) CS(3,14) CS(4,8) CS(5,6) CS(7,11) CS(9,10)
  CS(0,5) CS(1,7) CS(2,9) CS(3,4) CS(6,13) CS(8,14) CS(10,15) CS(11,12)
  CS(0,1) CS(2,3) CS(4,5) CS(6,8) CS(7,9) CS(10,11) CS(12,13) CS(14,15)
  CS(0,2) CS(1,3) CS(4,10) CS(5,11) CS(6,7) CS(8,9) CS(12,14) CS(13,15)
  CS(1,2) CS(3,12) CS(4,6) CS(5,7) CS(8,10) CS(9,11) CS(13,14)
  CS(1,4) CS(2,6) CS(5,8) CS(7,10) CS(9,13) CS(11,14)
  CS(2,4) CS(3,6) CS(9,12) CS(11,13)
  CS(3,5) CS(6,8) CS(7,9) CS(10,12)
  CS(3,4) CS(5,6) CS(7,8) CS(9,10) CS(11,12)
  CS(6,7) CS(8,9)
#undef CS
}
DI void merge16_desc(unsigned (&v)[16]) {
#pragma unroll
  for (int j = 8; j > 0; j >>= 1)
#pragma unroll
    for (int i = 0; i < 16; ++i) {
      int l = i ^ j;
      if (l > i) cas_desc(v[i], v[l]);
    }
}
DI void merge_top16(unsigned (&a)[16], unsigned (&b)[16]) {
#pragma unroll
  for (int i = 0; i < 16; ++i) a[i] = a[i] > b[15 - i] ? a[i] : b[15 - i];
  merge16_desc(a);
}


template <int MODE>
DI void gemm_tile(const Params& p, int mt, int nt, char* smem) {
  constexpr int LROW = 144;
  char* ws = p.ws;
  const char* Wt = ws + (MODE == 1 ? W_WTIN : (MODE == 2 ? W_WTOUT : W_WTQ));
  const char* X = (MODE == 1) ? ((mt < 128) ? ws + W_XB : ws + W_XBS - (size_t)TP * 2048) : ws + (MODE == 2 ? W_CAT : W_HB);
  char* sW = smem;
  char* sX = smem + 128 * LROW;
  const int tid = otid(), lane = tid & 63, w = tid >> 6, wn = w & 1, wm = w >> 1;
  const int tl = lane & 31, h = lane >> 5;
  const char* gW = Wt + (size_t)(nt * 128) * 2048;
  const char* gX = X + (size_t)(mt * 128) * 2048;
  u32x4 rW[4], rX[4];
  f32x16 acc[2][2];
#pragma unroll
  for (int i = 0; i < 2; ++i)
#pragma unroll
    for (int j = 0; j < 2; ++j)
#pragma unroll
      for (int r = 0; r < 16; ++r) acc[i][j][r] = 0.f;

  const int m_lane[2] = {mt * 128 + wm * 64 + tl, mt * 128 + wm * 64 + 32 + tl};
  float ratio[2] = {1.f, 1.f}, fscale[2] = {1.f, 1.f};
  if (MODE == 2) {
#pragma unroll
    for (int j = 0; j < 2; ++j) {
      const float4 sl = *(const float4*)(ws + W_SSQL + (size_t)m_lane[j] * 16);
      const float4 sa0 = *(const float4*)(ws + W_SSQA + (size_t)m_lane[j] * 32);
      const float4 sa1 = *(const float4*)(ws + W_SSQA + (size_t)m_lane[j] * 32 + 16);
      float rsl = rsqrtf((sl.x + sl.y + sl.z + sl.w) * (1.0f / 512.0f) + EPS);
      float rsa = rsqrtf((sa0.x + sa0.y + sa0.z + sa0.w + sa1.x + sa1.y + sa1.z + sa1.w) * (1.0f / 512.0f) + EPS);
      ratio[j] = rsl / rsa;
      fscale[j] = rsa;
    }
  } else if (MODE == 1) {
#pragma unroll
    for (int j = 0; j < 2; ++j) fscale[j] = ((const float*)(ws + W_RS1))[m_lane[j]];
  } else {
#pragma unroll
    for (int j = 0; j < 2; ++j) {
      const float4* sp = (const float4*)(ws + W_SSQ2 + (size_t)m_lane[j] * 64);
      float4 a = sp[0], b = sp[1], c = sp[2], d = sp[3];
      float s = a.x + a.y + a.z + a.w + b.x + b.y + b.z + b.w + c.x + c.y + c.z + c.w + d.x + d.y + d.z + d.w;
      fscale[j] = rsqrtf(s * (1.0f / 1024.0f) + EPS);
    }
  }

  constexpr int BUF = 2 * 128 * LROW;
#pragma unroll
  for (int i = 0; i < 4; ++i) {
    int c = tid + 256 * i, row = c >> 3, kc = c & 7;
    rW[i] = *(const u32x4*)(gW + (unsigned)(row * 2048 + kc * 16));
    rX[i] = *(const u32x4*)(gX + (unsigned)(row * 2048 + kc * 16));
  }
  __syncthreads();
#pragma unroll
  for (int i = 0; i < 4; ++i) {
    int c = tid + 256 * i, row = c >> 3, kc = c & 7;
    *(u32x4*)(sW + row * LROW + kc * 16) = rW[i];
    *(u32x4*)(sX + row * LROW + kc * 16) = rX[i];
  }
#pragma unroll
  for (int i = 0; i < 4; ++i) {
    int c = tid + 256 * i, row = c >> 3, kc = c & 7;
    rW[i] = *(const u32x4*)(gW + (unsigned)(row * 2048 + 128 + kc * 16));
    rX[i] = *(const u32x4*)(gX + (unsigned)(row * 2048 + 128 + kc * 16));
  }
  __syncthreads();
  for (int ks = 0; ks < 16; ++ks) {
    const int cur = (ks & 1) * BUF, nxt = BUF - cur;
    if (MODE == 2 && ks == 8) {
#pragma unroll
      for (int i = 0; i < 2; ++i)
#pragma unroll
        for (int j = 0; j < 2; ++j)
#pragma unroll
          for (int r = 0; r < 16; ++r) acc[i][j][r] *= ratio[j];
    }
#pragma unroll
    for (int kh = 0; kh < 2; ++kh) {
      __builtin_amdgcn_s_setprio(2);
#pragma unroll
      for (int k2 = 0; k2 < 2; ++k2) {
        const int kk = kh * 2 + k2;
        bf16x8 a[2], b[2];
#pragma unroll
        for (int i = 0; i < 2; ++i) a[i] = *(const bf16x8*)(sW + cur + (wn * 64 + i * 32 + tl) * LROW + kk * 32 + h * 16);
#pragma unroll
        for (int j = 0; j < 2; ++j) b[j] = *(const bf16x8*)(sX + cur + (wm * 64 + j * 32 + tl) * LROW + kk * 32 + h * 16);
#pragma unroll
        for (int i = 0; i < 2; ++i)
#pragma unroll
          for (int j = 0; j < 2; ++j) acc[i][j] = MFMA32(a[i], b[j], acc[i][j]);
      }
      __builtin_amdgcn_s_setprio(0);
      if (kh == 0 && ks + 1 < 16) {
#pragma unroll
        for (int i = 0; i < 4; ++i) {
          int c = tid + 256 * i, row = c >> 3, kc = c & 7;
          *(u32x4*)(sW + nxt + row * LROW + kc * 16) = rW[i];
          *(u32x4*)(sX + nxt + row * LROW + kc * 16) = rX[i];
        }
        if (ks + 2 < 16) {
#pragma unroll
          for (int i = 0; i < 4; ++i) {
            int c = tid + 256 * i, row = c >> 3, kc = c & 7;
            rW[i] = *(const u32x4*)(gW + (unsigned)(row * 2048 + (ks + 2) * 128 + kc * 16));
            rX[i] = *(const u32x4*)(gX + (unsigned)(row * 2048 + (ks + 2) * 128 + kc * 16));
          }
        }
      }
    }
    if (ks + 1 < 16) __syncthreads();
  }

  const int ncol0 = nt * 128 + wn * 64;
  if (MODE == 1) {
    u16* Tb = (u16*)smem;
    const int tcol0 = wn * 64 + 4 * h;
    if (nt < 13) __syncthreads();
    if (ncol0 < 512) {
#pragma unroll
      for (int j = 0; j < 2; ++j) {
        const int m = m_lane[j];
        float* convdst = nullptr;
        if (m < TP) {
          int t = m & 2047;
          if (t >= 2045) convdst = p.out + O_CONVP + (size_t)((m >> 11) * 3 + (t - 2045)) * 512;
        } else {
          int ms = m - TP, t = ms & 15;
          if (t >= 13) convdst = p.out + O_CONVS + (size_t)((ms >> 4) * 3 + (t - 13)) * 512;
        }
        u16* ub = (u16*)(ws + W_U) + (size_t)m * 512;
#pragma unroll
        for (int i = 0; i < 2; ++i)
#pragma unroll
          for (int g = 0; g < 4; ++g) {
            int n = ncol0 + i * 32 + 8 * g + 4 * h;
            float v0 = acc[i][j][4 * g] * fscale[j], v1 = acc[i][j][4 * g + 1] * fscale[j],
                  v2 = acc[i][j][4 * g + 2] * fscale[j], v3 = acc[i][j][4 * g + 3] * fscale[j];
            *(uint2*)(Tb + (wm * 64 + j * 32 + tl) * 136 + tcol0 + i * 32 + 8 * g) = make_uint2(pk2(v0, v1), pk2(v2, v3));
            if (convdst) *(float4*)(convdst + n) = make_float4(v0, v1, v2, v3);
          }
      }
    } else if (ncol0 < 1024) {
#pragma unroll
      for (int j = 0; j < 2; ++j) {
        u16* gb = (u16*)(ws + W_GG) + (size_t)m_lane[j] * 512;
#pragma unroll
        for (int i = 0; i < 2; ++i)
#pragma unroll
          for (int g = 0; g < 4; ++g) {
            int n = ncol0 - 512 + i * 32 + 8 * g + 4 * h;
            float v0 = gelu_(acc[i][j][4 * g] * fscale[j]), v1 = gelu_(acc[i][j][4 * g + 1] * fscale[j]),
                  v2 = gelu_(acc[i][j][4 * g + 2] * fscale[j]), v3 = gelu_(acc[i][j][4 * g + 3] * fscale[j]);
            *(uint2*)(Tb + (wm * 64 + j * 32 + tl) * 136 + tcol0 + i * 32 + 8 * g) = make_uint2(pk2(v0, v1), pk2(v2, v3));
          }
      }
    } else if (ncol0 < 1664) {
      const bool isq = ncol0 < 1536;
      const float* gain = isq ? p.q_g : p.k_g;
      const float post = isq ? 0.125f : 1.0f;
#pragma unroll
      for (int j = 0; j < 2; ++j) {
        const int m = m_lane[j];
        float ss = 0.f;
#pragma unroll
        for (int i = 0; i < 2; ++i)
#pragma unroll
          for (int r = 0; r < 16; ++r) {
            float v = acc[i][j][r] * fscale[j];
            ss += v * v;
          }
        ss += __shfl_xor(ss, 32);
        const float sc = fscale[j] * rsqrtf(ss * (1.0f / 64.0f) + EPS) * post;
        u16* dst;
        float* fdst = nullptr;
        int nloc0;
        if (isq) {
          nloc0 = ncol0 - 1024;
          dst = (u16*)(ws + W_Q) + (size_t)m * 512 + nloc0;
        } else {
          nloc0 = ncol0 - 1536;
          if (m < TP) {
            dst = (u16*)(ws + W_KP) + (size_t)m * 128 + nloc0;
            int t = m & 2047;
            if (t >= 1920) fdst = p.out + O_KP + (size_t)((m >> 11) * 128 + (t - 1920)) * 128 + nloc0;
          } else {
            int ms = m - TP, b = ms >> 4, t = ms & 15;
            dst = (u16*)(ws + W_KS) + (size_t)(b * 192 + 128 + t) * 128 + nloc0;
            fdst = p.out + O_KS + (size_t)(b * 128 + 112 + t) * 128 + nloc0;
          }
        }
#pragma unroll
        for (int i = 0; i < 2; ++i)
#pragma unroll
          for (int g = 0; g < 4; ++g) {
            int d = i * 32 + 8 * g + 4 * h;
            const float4 gn = *(const float4*)(gain + d);
            float v0 = acc[i][j][4 * g] * sc * gn.x, v1 = acc[i][j][4 * g + 1] * sc * gn.y,
                  v2 = acc[i][j][4 * g + 2] * sc * gn.z, v3 = acc[i][j][4 * g + 3] * sc * gn.w;
            *(uint2*)(Tb + (wm * 64 + j * 32 + tl) * 136 + tcol0 + i * 32 + 8 * g) = make_uint2(pk2(v0, v1), pk2(v2, v3));
            if (fdst) *(float4*)(fdst + d) = make_float4(v0, v1, v2, v3);
          }
      }
    } else {
#pragma unroll
      for (int j = 0; j < 2; ++j) {
        const int m = m_lane[j];
        u16* vt;
        size_t vstride;
        float* fdst = nullptr;
        const int ch0 = ncol0 - 1664;
        if (m < TP) {
          int b = m >> 11, t = m & 2047;
          vt = (u16*)(ws + W_VTP) + (size_t)b * 128 * 2048 + t;
          vstride = 2048;
          if (t >= 1920) fdst = p.out + O_VP + (size_t)(b * 128 + (t - 1920)) * 128;
        } else {
          int ms = m - TP, b = ms >> 4, t = ms & 15;
          vt = (u16*)(ws + W_VTS) + (size_t)b * 128 * 192 + 128 + t;
          vstride = 192;
          fdst = p.out + O_VS + (size_t)(b * 128 + 112 + t) * 128;
        }
#pragma unroll
        for (int i = 0; i < 2; ++i)
#pragma unroll
          for (int g = 0; g < 4; ++g) {
            int ch = ch0 + i * 32 + 8 * g + 4 * h;
            float v0 = acc[i][j][4 * g] * fscale[j], v1 = acc[i][j][4 * g + 1] * fscale[j],
                  v2 = acc[i][j][4 * g + 2] * fscale[j], v3 = acc[i][j][4 * g + 3] * fscale[j];
            unsigned p01 = pk2(v0, v1), p23 = pk2(v2, v3);
            vt[(size_t)(ch + 0) * vstride] = (u16)(p01 & 0xffffu);
            vt[(size_t)(ch + 1) * vstride] = (u16)(p01 >> 16);
            vt[(size_t)(ch + 2) * vstride] = (u16)(p23 & 0xffffu);
            vt[(size_t)(ch + 3) * vstride] = (u16)(p23 >> 16);
            if (fdst) *(float4*)(fdst + ch) = make_float4(v0, v1, v2, v3);
          }
      }
    }
    if (nt < 13) {
      __syncthreads();
#pragma unroll
      for (int it = 0; it < 8; ++it) {
        const int c = tid + 256 * it, rl = c >> 4, cc = c & 15;
        const int m = mt * 128 + rl;
        const u32x4 vrow = *(const u32x4*)(Tb + rl * 136 + cc * 8);
        unsigned off;
        if (nt < 4) off = (unsigned)(W_U + (m * 512 + nt * 128 + cc * 8) * 2);
        else if (nt < 8) off = (unsigned)(W_GG + (m * 512 + (nt - 4) * 128 + cc * 8) * 2);
        else if (nt < 12) off = (unsigned)(W_Q + (m * 512 + (nt - 8) * 128 + cc * 8) * 2);
        else if (m < TP) off = (unsigned)(W_KP + (m * 128 + cc * 8) * 2);
        else { const int ms = m - TP; off = (unsigned)(W_KS + (((ms >> 4) * 192 + 128 + (ms & 15)) * 128 + cc * 8) * 2); }
        *(u32x4*)(ws + off) = vrow;
      }
    }
  } else if (MODE == 2) {
    float* T = (float*)smem;
    __syncthreads();
#pragma unroll
    for (int j = 0; j < 2; ++j) {
      const int rl = wm * 64 + j * 32 + tl;
#pragma unroll
      for (int i = 0; i < 2; ++i)
#pragma unroll
        for (int g = 0; g < 4; ++g) {
          const int col = wn * 64 + i * 32 + 8 * g + 4 * h;
          f32x4 v;
          v[0] = acc[i][j][4 * g] * fscale[j]; v[1] = acc[i][j][4 * g + 1] * fscale[j];
          v[2] = acc[i][j][4 * g + 2] * fscale[j]; v[3] = acc[i][j][4 * g + 3] * fscale[j];
          *(f32x4*)(T + rl * 132 + col) = v;
        }
    }
    __syncthreads();
    const char* xbb = (mt < 128) ? ws + W_XB : ws + W_XBS - (size_t)TP * 2048;
#pragma unroll 4
    for (int it = 0; it < 16; ++it) {
      const int c = tid + 256 * it, rl = c >> 5, cc = c & 31;
      const int m = mt * 128 + rl, n = nt * 128 + cc * 4;
      const f32x4 t = *(const f32x4*)(T + rl * 132 + cc * 4);
      const uint2 xq = *(const uint2*)(xbb + (unsigned)((m * 1024 + n) * 2));
      f32x4 y;
      y[0] = bf_lo(xq.x) + t[0]; y[1] = bf_hi(xq.x) + t[1]; y[2] = bf_lo(xq.y) + t[2]; y[3] = bf_hi(xq.y) + t[3];
      *(uint2*)(ws + (unsigned)(W_HB + (m * 1024 + n) * 2)) = make_uint2(pk2(y[0], y[1]), pk2(y[2], y[3]));
      float ss = y[0] * y[0] + y[1] * y[1] + y[2] * y[2] + y[3] * y[3];
      ss += __uint_as_float(__builtin_amdgcn_update_dpp(0u, __float_as_uint(ss), 0x111, 0xF, 0xF, false));
      ss += __uint_as_float(__builtin_amdgcn_update_dpp(0u, __float_as_uint(ss), 0x112, 0xF, 0xF, false));
      ss += __uint_as_float(__builtin_amdgcn_update_dpp(0u, __float_as_uint(ss), 0x114, 0xF, 0xF, false));
      ss += __uint_as_float(__builtin_amdgcn_update_dpp(0u, __float_as_uint(ss), 0x118, 0xF, 0xF, false));
      if ((lane & 15) == 15) *(float*)(ws + (unsigned)(W_SSQ2 + (m * 16 + nt * 2 + (cc >> 4)) * 4)) = ss;
    }
  } else {
    unsigned* Lx = (unsigned*)smem;
    __syncthreads();
#pragma unroll
    for (int j = 0; j < 2; ++j) {
      if (nt == 0 && wn == 0 && h == 0) ((float*)(ws + W_RS2))[m_lane[j]] = fscale[j];
      unsigned top[16], tmp[16];
#pragma unroll
      for (int r = 0; r < 16; ++r) top[r] = (f2ord(acc[0][j][r] * fscale[j]) & ~127u) | (unsigned)(127 - (wn * 64 + crow(r, h)));
      sort16_desc(top);
#pragma unroll
      for (int r = 0; r < 16; ++r) tmp[r] = (f2ord(acc[1][j][r] * fscale[j]) & ~127u) | (unsigned)(127 - (wn * 64 + 32 + crow(r, h)));
      sort16_desc(tmp);
      merge_top16(top, tmp);
      u32x4* d4 = (u32x4*)(Lx + (((wn * 2 + h) * 4 + wm * 2 + j) * 32 + tl) * 16);
#pragma unroll
      for (int q = 0; q < 4; ++q) { u32x4 v4; v4[0] = top[4 * q]; v4[1] = top[4 * q + 1]; v4[2] = top[4 * q + 2]; v4[3] = top[4 * q + 3]; d4[q] = v4; }
    }
    __syncthreads();
    if (tid < 128) {
      const int u = tid >> 5, t2 = tid & 31;
      unsigned top[16], tmp[16];
#pragma unroll
      for (int li = 0; li < 4; ++li) {
        const u32x4* s4 = (const u32x4*)(Lx + ((li * 4 + u) * 32 + t2) * 16);
#pragma unroll
        for (int q = 0; q < 4; ++q) {
          const u32x4 x0 = s4[q];
          if (li == 0) { top[4 * q] = x0[0]; top[4 * q + 1] = x0[1]; top[4 * q + 2] = x0[2]; top[4 * q + 3] = x0[3]; }
          else { tmp[4 * q] = x0[0]; tmp[4 * q + 1] = x0[1]; tmp[4 * q + 2] = x0[2]; tmp[4 * q + 3] = x0[3]; }
        }
        if (li > 0) merge_top16(top, tmp);
      }
      const int mrow = mt * 128 + u * 32 + t2;
      u32x4* g4 = (u32x4*)(ws + (unsigned)(W_TOPL + ((mrow * 16 + nt) * 16) * 4));
#pragma unroll
      for (int q = 0; q < 4; ++q) { u32x4 v4; v4[0] = top[4 * q]; v4[1] = top[4 * q + 1]; v4[2] = top[4 * q + 2]; v4[3] = top[4 * q + 3]; g4[q] = v4; }
    }
  }
}

#define SCAN_STEP(CTRL) { \
    const float Ap = __uint_as_float(__builtin_amdgcn_update_dpp(0x3f800000u, __float_as_uint(A), CTRL, 0xF, 0xF, false)); \
    const float Hp = __uint_as_float(__builtin_amdgcn_update_dpp(0u, __float_as_uint(H), CTRL, 0xF, 0xF, false)); \
    H = A * Hp + H; A = A * Ap; }
template <int FINAL>
DI void lru_item(const Params& p, int item, char* smem) {
  char* ws = p.ws;
  const bool samp = item >= 512;
  int b, c, m0, nvalid;
  if (!samp) { b = item >> 6; c = item & 63; m0 = b * 2048 + c * 32; nvalid = 32; }
  else { b = item - 512; c = 0; m0 = TP + b * 16; nvalid = 16; }
  const int tid = otid(), lane = tid & 63, w = tid >> 6, tl = lane & 31, h = lane >> 5;
  u16* XC = (u16*)smem;
  float* hin = (float*)(smem + 32 * 1040);
  __syncthreads();
  {
    const int ch = 2 * tid;
    const float2 w0 = *(const float2*)(p.conv_w + ch), w1 = *(const float2*)(p.conv_w + 512 + ch),
                 w2 = *(const float2*)(p.conv_w + 1024 + ch), w3 = *(const float2*)(p.conv_w + 1536 + ch),
                 cb = *(const float2*)(p.conv_b + ch);
    float2 r0 = {0.f, 0.f}, r1 = {0.f, 0.f}, r2 = {0.f, 0.f};
    const u16* ub = (const u16*)(ws + W_U);
    if (!samp) {
      if (c > 0) {
        unsigned a0 = *(const unsigned*)(ub + (size_t)(m0 - 3) * 512 + ch), a1 = *(const unsigned*)(ub + (size_t)(m0 - 2) * 512 + ch),
                 a2 = *(const unsigned*)(ub + (size_t)(m0 - 1) * 512 + ch);
        r0 = {bf_lo(a0), bf_hi(a0)}; r1 = {bf_lo(a1), bf_hi(a1)}; r2 = {bf_lo(a2), bf_hi(a2)};
      }
    } else {
      const float* sc = p.state_conv + (size_t)b * 3 * 512 + ch;
      r0 = *(const float2*)(sc); r1 = *(const float2*)(sc + 512); r2 = *(const float2*)(sc + 1024);
    }
    unsigned uraw[32];
#pragma unroll
    for (int t = 0; t < 32; ++t) uraw[t] = (t < nvalid) ? *(const unsigned*)(ub + (size_t)(m0 + t) * 512 + ch) : 0u;
#pragma unroll
    for (int t = 0; t < 32; ++t) {
      float2 cur = {bf_lo(uraw[t]), bf_hi(uraw[t])};
      float x0 = cb.x + w0.x * r0.x + w1.x * r1.x + w2.x * r2.x + w3.x * cur.x;
      float x1 = cb.y + w0.y * r0.y + w1.y * r1.y + w2.y * r2.y + w3.y * cur.y;
      *(unsigned*)(XC + t * 520 + ch) = pk2(x0, x1);
      r0 = r1; r1 = r2; r2 = cur;
    }
    if (FINAL) {
      u16* G = (u16*)(smem + 35328);
      u32x4 gr[8];
#pragma unroll
      for (int it = 0; it < 8; ++it) {
        const int cidx = tid + 256 * it, rl = cidx >> 6, cc = cidx & 63;
        if (rl < nvalid) gr[it] = *(const u32x4*)(ws + (unsigned)(W_GG + ((m0 + rl) * 512 + cc * 8) * 2));
      }
#pragma unroll
      for (int it = 0; it < 8; ++it) {
        const int cidx = tid + 256 * it, rl = cidx >> 6, cc = cidx & 63;
        if (rl < nvalid) *(u32x4*)(G + rl * 520 + cc * 8) = gr[it];
      }
    }
    if (FINAL) {
      float2 hh;
      if (samp) hh = *(const float2*)(p.state_lru + (size_t)b * 512 + ch);
      else {
        hh = {0.f, 0.f};
        const float* sA = (const float*)(ws + W_SUMA) + (size_t)(b * 64) * 512 + ch;
        const float* sH = (const float*)(ws + W_SUMH) + (size_t)(b * 64) * 512 + ch;
        int cc = 0;
        for (; cc + 16 <= c; cc += 16) {
          float2 Av[16], Hv[16];
#pragma unroll
          for (int u = 0; u < 16; ++u) { Av[u] = *(const float2*)(sA + (size_t)(cc + u) * 512); Hv[u] = *(const float2*)(sH + (size_t)(cc + u) * 512); }
#pragma unroll
          for (int u = 0; u < 16; ++u) { hh.x = Av[u].x * hh.x + Hv[u].x; hh.y = Av[u].y * hh.y + Hv[u].y; }
        }
        for (; cc + 4 <= c; cc += 4) {
          float2 Av[4], Hv[4];
#pragma unroll
          for (int u = 0; u < 4; ++u) { Av[u] = *(const float2*)(sA + (size_t)(cc + u) * 512); Hv[u] = *(const float2*)(sH + (size_t)(cc + u) * 512); }
#pragma unroll
          for (int u = 0; u < 4; ++u) { hh.x = Av[u].x * hh.x + Hv[u].x; hh.y = Av[u].y * hh.y + Hv[u].y; }
        }
        for (; cc < c; ++cc) {
          float2 A0 = *(const float2*)(sA + (size_t)cc * 512), H0 = *(const float2*)(sH + (size_t)cc * 512);
          hh.x = A0.x * hh.x + H0.x; hh.y = A0.y * hh.y + H0.y;
        }
      }
      hin[ch] = hh.x; hin[ch + 1] = hh.y;
    }
  }
  __syncthreads();
  const u16* WaT = (const u16*)(ws + W_WAT);
  const u16* WiT = (const u16*)(ws + W_WIT);
  const float* c8 = (const float*)(ws + W_C8);
  const int m = m0 + tl;
  const bool valid = tl < nvalid;
  float ssq = 0.f;
#pragma unroll 1
  for (int nbk = 0; nbk < 2; ++nbk) {
    const int n = 2 * w + nbk;
    f32x16 accA[2], accI[2];
#pragma unroll
    for (int i = 0; i < 2; ++i)
#pragma unroll
      for (int r = 0; r < 16; ++r) { accA[i][r] = 0.f; accI[i][r] = 0.f; }
#pragma unroll
    for (int kk = 0; kk < 4; ++kk) {
      const bf16x8 bx = *(const bf16x8*)((const char*)XC + tl * 1040 + (n * 64 + kk * 16 + h * 8) * 2);
#pragma unroll
      for (int i = 0; i < 2; ++i) {
        const bf16x8 aa = *(const bf16x8*)(WaT + (unsigned)((((n * 2 + i) * 4 + kk) * 64 + lane) * 8));
        const bf16x8 ai = *(const bf16x8*)(WiT + (unsigned)((((n * 2 + i) * 4 + kk) * 64 + lane) * 8));
        accA[i] = MFMA32(aa, bx, accA[i]);
        accI[i] = MFMA32(ai, bx, accI[i]);
      }
    }
#pragma unroll
    for (int i = 0; i < 2; ++i)
#pragma unroll
      for (int g = 0; g < 4; ++g) {
        const int ch = n * 64 + i * 32 + 8 * g + 4 * h;
        const float4 ba4 = *(const float4*)(p.lru_ba + ch), bi4 = *(const float4*)(p.lru_bi + ch), c84 = *(const float4*)(c8 + ch);
        const float bav[4] = {ba4.x, ba4.y, ba4.z, ba4.w}, biv[4] = {bi4.x, bi4.y, bi4.z, bi4.w}, c8v[4] = {c84.x, c84.y, c84.z, c84.w};
        const uint2 xcp = *(const uint2*)(XC + tl * 520 + ch);
        const float xcv[4] = {bf_lo(xcp.x), bf_hi(xcp.x), bf_lo(xcp.y), bf_hi(xcp.y)};
        float hv[4];
        float A4[4], H4[4];
#pragma unroll
        for (int q = 0; q < 4; ++q) {
          const int r = 4 * g + q;
          float rr = sigmoidf_(accA[i][r] + bav[q]);
          float ii = sigmoidf_(accI[i][r] + biv[q]);
          float la = c8v[q] * rr;
          A4[q] = __expf(la);
          float x2 = 2.0f * la;
          float em = -x2 * (1.0f + x2 * (0.5f + x2 * (0.16666667f + x2 * (0.041666668f + x2 * (0.0083333333f + x2 * 0.0013888889f)))));
          H4[q] = __builtin_amdgcn_sqrtf(fmaxf(em, 0.f)) * ii * xcv[q];
        }
#define SCAN4(CTRL) \
        asm volatile("s_nop 1\n\t" \
            "v_fmac_f32_dpp %0, %0, %4 " CTRL "\n\tv_mul_f32_dpp %4, %4, %4 " CTRL "\n\t" \
            "v_fmac_f32_dpp %1, %1, %5 " CTRL "\n\tv_mul_f32_dpp %5, %5, %5 " CTRL "\n\t" \
            "v_fmac_f32_dpp %2, %2, %6 " CTRL "\n\tv_mul_f32_dpp %6, %6, %6 " CTRL "\n\t" \
            "v_fmac_f32_dpp %3, %3, %7 " CTRL "\n\tv_mul_f32_dpp %7, %7, %7 " CTRL "\n\t" \
            : "+v"(H4[0]), "+v"(H4[1]), "+v"(H4[2]), "+v"(H4[3]), "+v"(A4[0]), "+v"(A4[1]), "+v"(A4[2]), "+v"(A4[3]));
        SCAN4("row_shr:1 row_mask:0xf bank_mask:0xf")
        SCAN4("row_shr:2 row_mask:0xf bank_mask:0xf")
        SCAN4("row_shr:4 row_mask:0xf bank_mask:0xf")
        SCAN4("row_shr:8 row_mask:0xf bank_mask:0xf")
        SCAN4("row_bcast:15 row_mask:0xa bank_mask:0xf")
        asm volatile("s_nop 1" ::: "memory");
#pragma unroll
        for (int q = 0; q < 4; ++q) {
          const float A = A4[q], H = H4[q];
          if (!FINAL) {
            if (tl == 31) { ((float*)(smem + 35328))[ch + q] = A; ((float*)(smem + 35328))[512 + ch + q] = H; }
          } else {
            hv[q] = H + A * hin[ch + q];
          }
        }
        if (FINAL) {
          if (tl == nvalid - 1 && (samp || c == 63)) {
            float* dst = p.out + (samp ? O_LRUS : O_LRUP) + (size_t)b * 512 + ch;
            *(float4*)dst = make_float4(hv[0], hv[1], hv[2], hv[3]);
          }
          if (valid) {
            u16* G = (u16*)(smem + 35328);
            const uint2 gp = *(const uint2*)(G + tl * 520 + ch);
            float o0 = hv[0] * bf_lo(gp.x), o1 = hv[1] * bf_hi(gp.x), o2 = hv[2] * bf_lo(gp.y), o3 = hv[3] * bf_hi(gp.y);
            ssq += o0 * o0 + o1 * o1 + o2 * o2 + o3 * o3;
            *(uint2*)(G + tl * 520 + ch) = make_uint2(pk2(o0, o1), pk2(o2, o3));
          }
        }
      }
  }
  if (!FINAL) {
    __syncthreads();
    const float* S = (const float*)(smem + 35328);
    *(float2*)((float*)(ws + W_SUMA) + (size_t)(b * 64 + c) * 512 + 2 * tid) = *(const float2*)(S + 2 * tid);
    *(float2*)((float*)(ws + W_SUMH) + (size_t)(b * 64 + c) * 512 + 2 * tid) = *(const float2*)(S + 512 + 2 * tid);
  }
  if (FINAL) {
    ssq += __shfl_xor(ssq, 32);
    if (valid && h == 0) ((float*)(ws + W_SSQL))[(size_t)m * 4 + w] = ssq;
    __syncthreads();
    const u16* G = (const u16*)(smem + 35328);
#pragma unroll
    for (int it = 0; it < 8; ++it) {
      const int cidx = tid + 256 * it, rl = cidx >> 6, cc = cidx & 63;
      if (rl < nvalid) *(u32x4*)(ws + (unsigned)(W_CAT + ((m0 + rl) * 1024 + cc * 8) * 2)) = *(const u32x4*)(G + rl * 520 + cc * 8);
    }
  }
}

DI void attn_item(const Params& p, int item, char* smem) {
  char* ws = p.ws;
  const int tid = otid(), lane = tid & 63, w = tid >> 6, tl = lane & 31, h = lane >> 5;
  const bool samp = item >= 512;
  int b, c, g;
  const u16* Kb; const u16* Vt; int vstride, kc_lo, kc_hi, nkeys, mq0; bool qvalid;
  if (!samp) {
    b = item >> 6; c = (item >> 1) & 31; g = item & 1;
    Kb = (const u16*)(ws + W_KP) + (size_t)b * 2048 * 128;
    Vt = (const u16*)(ws + W_VTP) + (size_t)b * 128 * 2048;
    vstride = 2048; kc_lo = (c >= 2) ? c - 2 : 0; kc_hi = c; nkeys = 1 << 30;
    mq0 = b * 2048 + c * 64 + tl; qvalid = true;
  } else {
    int it = item - 512; b = it >> 1; g = it & 1; c = 0;
    Kb = (const u16*)(ws + W_KS) + (size_t)b * 192 * 128;
    Vt = (const u16*)(ws + W_VTS) + (size_t)b * 128 * 192;
    vstride = 192; kc_lo = 0; kc_hi = 2; nkeys = 144;
    mq0 = TP + b * 16 + (tl & 15); qvalid = tl < 16;
  }
  const int hq = g * 4 + w;
  const float sink = p.sinks[hq];
  char* sK = smem;
  char* sV = smem + 192 * 144;
  const int nch = kc_hi - kc_lo + 1;
  const int nj = samp ? 1 : 2;
  bf16x8 bq[2][4];
#pragma unroll
  for (int j = 0; j < 2; ++j)
#pragma unroll
    for (int kk = 0; kk < 4; ++kk)
      bq[j][kk] = *(const bf16x8*)((const u16*)(ws + W_Q) + (size_t)(mq0 + (samp ? 0 : j * 32)) * 512 + hq * 64 + kk * 16 + h * 8);
  __syncthreads();
  {
    u32x4 kr[6], vr[6];
#pragma unroll
    for (int i = 0; i < 6; ++i) {
      const int idx = tid + 256 * i;
      const int key = idx >> 3, part = idx & 7;
      if (key < nch * 64) kr[i] = *(const u32x4*)(Kb + (size_t)(kc_lo * 64 + key) * 128 + g * 64 + part * 8);
      const int d = idx / 24, pv = idx % 24;
      if (pv < nch * 8) vr[i] = *(const u32x4*)(Vt + (size_t)(g * 64 + d) * vstride + kc_lo * 64 + pv * 8);
    }
#pragma unroll
    for (int i = 0; i < 6; ++i) {
      const int idx = tid + 256 * i;
      const int key = idx >> 3, part = idx & 7;
      if (key < nch * 64) *(u32x4*)(sK + key * 144 + part * 16) = kr[i];
      const int d = idx / 24, pv = idx % 24;
      if (pv < nch * 8) *(u32x4*)(sV + d * 400 + pv * 16) = vr[i];
    }
  }
  __syncthreads();
#pragma unroll
  for (int j = 0; j < 2; ++j) {
    if (j < nj) {
    const int mqj = mq0 + j * 32;
    float mrun = sink, lrun = 1.f;
    f32x16 O[2];
#pragma unroll
    for (int i = 0; i < 2; ++i)
#pragma unroll
      for (int r = 0; r < 16; ++r) O[i][r] = 0.f;
#pragma unroll 1
    for (int kc = 0; kc < nch; ++kc) {
      f32x16 S[2];
#pragma unroll
      for (int i = 0; i < 2; ++i)
#pragma unroll
        for (int r = 0; r < 16; ++r) S[i][r] = 0.f;
#pragma unroll
      for (int kk = 0; kk < 4; ++kk)
#pragma unroll
        for (int kt = 0; kt < 2; ++kt) {
          const bf16x8 ak = *(const bf16x8*)(sK + (kc * 64 + kt * 32 + tl) * 144 + kk * 32 + h * 16);
          S[kt] = MFMA32(ak, bq[j][kk], S[kt]);
        }
      if (samp) {
#pragma unroll
        for (int kt = 0; kt < 2; ++kt)
#pragma unroll
          for (int r = 0; r < 16; ++r) {
            int key = kc * 64 + kt * 32 + crow(r, h);
            if (key >= nkeys) S[kt][r] = -INFINITY;
          }
      }
      {
        float mx = -INFINITY;
#pragma unroll
        for (int kt = 0; kt < 2; ++kt)
#pragma unroll
          for (int r = 0; r < 16; ++r) mx = fmaxf(mx, S[kt][r]);
        mx = fmaxf(mx, __shfl_xor(mx, 32));
        const float mnew = fmaxf(mrun, mx);
        const float alpha = __expf(mrun - mnew);
        float ps = 0.f;
#pragma unroll
        for (int kt = 0; kt < 2; ++kt)
#pragma unroll
          for (int r = 0; r < 16; ++r) {
            float pv = __expf(S[kt][r] - mnew);
            S[kt][r] = pv;
            ps += pv;
          }
        ps += __shfl_xor(ps, 32);
        lrun = lrun * alpha + ps;
        mrun = mnew;
#pragma unroll
        for (int dt = 0; dt < 2; ++dt)
#pragma unroll
          for (int r = 0; r < 16; ++r) O[dt][r] *= alpha;
      }
#pragma unroll
      for (int kt = 0; kt < 2; ++kt)
#pragma unroll
        for (int s2 = 0; s2 < 2; ++s2) {
          u32x4 pp;
          pp[0] = pk2(S[kt][8 * s2 + 0], S[kt][8 * s2 + 1]);
          pp[1] = pk2(S[kt][8 * s2 + 2], S[kt][8 * s2 + 3]);
          pp[2] = pk2(S[kt][8 * s2 + 4], S[kt][8 * s2 + 5]);
          pp[3] = pk2(S[kt][8 * s2 + 6], S[kt][8 * s2 + 7]);
          const bf16x8 bp = __builtin_bit_cast(bf16x8, pp);
#pragma unroll
          for (int dt = 0; dt < 2; ++dt) {
            const int d = dt * 32 + tl;
            const uint2 lo = *(const uint2*)(sV + d * 400 + (kc * 64 + kt * 32 + 16 * s2 + 4 * h) * 2);
            const uint2 hi = *(const uint2*)(sV + d * 400 + (kc * 64 + kt * 32 + 16 * s2 + 8 + 4 * h) * 2);
            u32x4 av4;
            av4[0] = lo.x; av4[1] = lo.y; av4[2] = hi.x; av4[3] = hi.y;
            O[dt] = MFMA32(__builtin_bit_cast(bf16x8, av4), bp, O[dt]);
          }
        }
    }
    const float inv = 1.0f / lrun;
    float ss = 0.f;
    u16* To = (u16*)(smem + 53248);
#pragma unroll
    for (int dt = 0; dt < 2; ++dt)
#pragma unroll
      for (int g4 = 0; g4 < 4; ++g4) {
        int d = dt * 32 + 8 * g4 + 4 * h;
        float v0 = O[dt][4 * g4] * inv, v1 = O[dt][4 * g4 + 1] * inv, v2 = O[dt][4 * g4 + 2] * inv, v3 = O[dt][4 * g4 + 3] * inv;
        ss += v0 * v0 + v1 * v1 + v2 * v2 + v3 * v3;
        *(uint2*)(To + tl * 264 + w * 64 + d) = make_uint2(pk2(v0, v1), pk2(v2, v3));
      }
    ss += __shfl_xor(ss, 32);
    if (qvalid && h == 0) ((float*)(ws + W_SSQA))[(size_t)mqj * 8 + hq] = ss;
    __syncthreads();
    {
      const int mrow0 = samp ? (TP + b * 16) : (b * 2048 + c * 64 + j * 32);
#pragma unroll
      for (int it = 0; it < 4; ++it) {
        const int cidx = tid + 256 * it, rl = cidx >> 5, cc = cidx & 31;
        if (!samp || rl < 16)
          *(u32x4*)(ws + (unsigned)(W_CAT + ((mrow0 + rl) * 1024 + 512 + g * 256 + cc * 8) * 2)) = *(const u32x4*)(To + rl * 264 + cc * 8);
      }
    }
    __syncthreads();
    }
  }
}

struct CandTab { int i[64]; int j[64]; int n; };
constexpr CandTab make_tab() {
  CandTab t{};
  int n = 0;
  for (int i = 0; i < 16; ++i)
    for (int j = 0; j < 16; ++j)
      if ((i + 1) * (j + 1) <= 16) { t.i[n] = i; t.j[n] = j; ++n; }
  t.n = n;
  return t;
}

DI void route2(const Params& p, char* smem) {
  char* ws = p.ws;
  constexpr CandTab CT = make_tab();
  const int tid = otid();
  unsigned* Lp = (unsigned*)smem + tid * 33;
  for (int base = blockIdx.x * 256; base < TT * 8; base += gridDim.x * 256) {
    const int it = base + tid;
    const int mm = it >> 3, hd = it & 7;
    unsigned l1[16], l2[16];
    {
      const u32x4* s1 = (const u32x4*)((const unsigned*)(ws + W_TOPL) + ((size_t)mm * 16 + hd * 2) * 16);
#pragma unroll
      for (int q = 0; q < 4; ++q) {
        const u32x4 a = s1[q], b = s1[4 + q];
        l1[4 * q] = a[0]; l1[4 * q + 1] = a[1]; l1[4 * q + 2] = a[2]; l1[4 * q + 3] = a[3];
        l2[4 * q] = b[0]; l2[4 * q + 1] = b[1]; l2[4 * q + 2] = b[2]; l2[4 * q + 3] = b[3];
      }
    }
#pragma unroll
    for (int i = 0; i < 16; ++i) { Lp[i] = l1[i]; Lp[16 + i] = l2[i]; }
    float f1[16], f2[16];
#pragma unroll
    for (int i = 0; i < 16; ++i) { f1[i] = ord2f(l1[i] & ~127u); f2[i] = ord2f(l2[i] & ~127u); }
    unsigned top[16], tmp[16];
#pragma unroll
    for (int grp = 0; grp < 4; ++grp) {
#pragma unroll
      for (int q = 0; q < 16; ++q) {
        const int cidx = grp * 16 + q;
        unsigned key = 0;
        if (cidx < CT.n) {
          const int ci = CT.i[cidx], cj = CT.j[cidx];
          key = (f2ord(f1[ci] + f2[cj]) & ~255u) | (unsigned)(255 - (ci * 16 + cj));
        }
        if (grp == 0) top[q] = key; else tmp[q] = key;
      }
      if (grp == 0) sort16_desc(top);
      else { sort16_desc(tmp); merge_top16(top, tmp); }
    }
    float sv[16]; int ex[16];
    float smax = -INFINITY;
#pragma unroll
    for (int q = 0; q < 16; ++q) {
      const int code = 255 - (int)(top[q] & 255u);
      const int ci = code >> 4, cj = code & 15;
      const unsigned a = Lp[ci], bb = Lp[16 + cj];
      const int i1 = 127 - (int)(a & 127u), i2 = 127 - (int)(bb & 127u);
      sv[q] = ord2f(a & ~127u) + ord2f(bb & ~127u);
      ex[q] = i1 * 128 + i2;
      smax = fmaxf(smax, sv[q]);
    }
    float sum = 0.f;
#pragma unroll
    for (int q = 0; q < 16; ++q) { sv[q] = __expf(sv[q] - smax); sum += sv[q]; }
    const float inv = 1.0f / sum;
    int4* di = (int4*)((int*)(ws + W_SIDX) + (size_t)mm * 128 + hd * 16);
    float4* dg = (float4*)((float*)(ws + W_SGATE) + (size_t)mm * 128 + hd * 16);
#pragma unroll
    for (int q = 0; q < 4; ++q) {
      di[q] = make_int4(ex[4 * q], ex[4 * q + 1], ex[4 * q + 2], ex[4 * q + 3]);
      dg[q] = make_float4(sv[4 * q] * inv, sv[4 * q + 1] * inv, sv[4 * q + 2] * inv, sv[4 * q + 3] * inv);
    }
  }
}

DI void peer_u_phase(const Params& p) {
  char* ws = p.ws;
  const int tid_ = otid(); const int lane = tid_ & 63, w = tid_ >> 6, g = lane >> 3, li = lane & 7;
  const int v = blockIdx.x & 7, bx = blockIdx.x >> 3, nbx = (gridDim.x - v + 7) >> 3;
  const int gwx = bx * 4 + w, nwx = nbx * 4;
  const char* Us = ws + W_UB + (size_t)v * 16384 * 128;
  const unsigned loff = li * 16;
  const int* sidx = (const int*)(ws + W_SIDX) + g * 16;
  int4 ix[4];
  u32x4 hq0, hq1;
  int m = gwx;
  if (m < TT) {
#pragma unroll
    for (int q = 0; q < 4; ++q) ix[q] = ((const int4*)(sidx + (size_t)m * 128))[q];
    const u32x4* hp = (const u32x4*)(ws + W_HB + (size_t)m * 2048 + v * 256 + li * 32);
    hq0 = hp[0]; hq1 = hp[1];
  }
  for (; m < TT; m += nwx) {
    const int idx[16] = {ix[0].x, ix[0].y, ix[0].z, ix[0].w, ix[1].x, ix[1].y, ix[1].z, ix[1].w,
                         ix[2].x, ix[2].y, ix[2].z, ix[2].w, ix[3].x, ix[3].y, ix[3].z, ix[3].w};
    u32x4 rows[16];
#pragma unroll
    for (int s2 = 0; s2 < 16; ++s2) rows[s2] = *(const u32x4*)(Us + (((unsigned)idx[s2] << 7) + loff));
    fl2_t hv[8];
    hv[0] = {bf_lo(hq0[0]), bf_hi(hq0[0])}; hv[1] = {bf_lo(hq0[1]), bf_hi(hq0[1])};
    hv[2] = {bf_lo(hq0[2]), bf_hi(hq0[2])}; hv[3] = {bf_lo(hq0[3]), bf_hi(hq0[3])};
    hv[4] = {bf_lo(hq1[0]), bf_hi(hq1[0])}; hv[5] = {bf_lo(hq1[1]), bf_hi(hq1[1])};
    hv[6] = {bf_lo(hq1[2]), bf_hi(hq1[2])}; hv[7] = {bf_lo(hq1[3]), bf_hi(hq1[3])};
    const int mn = m + nwx;
    if (mn < TT) {
#pragma unroll
      for (int q = 0; q < 4; ++q) ix[q] = ((const int4*)(sidx + (size_t)mn * 128))[q];
      const u32x4* hp = (const u32x4*)(ws + W_HB + (size_t)mn * 2048 + v * 256 + li * 32);
      hq0 = hp[0]; hq1 = hp[1];
    }
    float ps[16];
#pragma unroll
    for (int s2 = 0; s2 < 16; ++s2) {
      fl2_t acc = {0.f, 0.f};
#pragma unroll
      for (int d = 0; d < 4; ++d) {
        const fl2_t lo = __builtin_amdgcn_cvt_pk_f32_fp8((int)rows[s2][d], false);
        const fl2_t hi = __builtin_amdgcn_cvt_pk_f32_fp8((int)rows[s2][d], true);
        acc = __builtin_elementwise_fma(lo, hv[2 * d], acc);
        acc = __builtin_elementwise_fma(hi, hv[2 * d + 1], acc);
      }
      ps[s2] = acc.x + acc.y;
    }
#pragma unroll
    for (int st = 0; st < 3; ++st) {
      const int bit = 4 >> st, half = 8 >> st;
      const bool upper = (li & bit) != 0;
#pragma unroll
      for (int i = 0; i < half; ++i) {
        const float send = upper ? ps[i] : ps[i + half];
        const float keep = upper ? ps[i + half] : ps[i];
        ps[i] = keep + __shfl_xor(send, bit);
      }
    }
    const int sl = ((li >> 2) & 1) * 8 + ((li >> 1) & 1) * 4 + (li & 1) * 2;
    *(unsigned*)((u16*)(ws + W_PART) + ((size_t)m * 8 + v) * 128 + g * 16 + sl) = pk2(ps[0], ps[1]);
  }
}

DI void peer_combine(const Params& p) {
  char* ws = p.ws;
  const size_t gt = (size_t)blockIdx.x * 256 + otid(), gstride = (size_t)gridDim.x * 256;
  for (size_t i = gt; i < (size_t)TT * 16; i += gstride) {
    const size_t m = i >> 4, s8 = (i & 15) * 8;
    const u16* pp = (const u16*)(ws + W_PART) + m * 1024 + s8;
    float d[8] = {0.f, 0.f, 0.f, 0.f, 0.f, 0.f, 0.f, 0.f};
#pragma unroll
    for (int v = 0; v < 8; ++v) {
      const u32x4 q = *(const u32x4*)(pp + v * 128);
#pragma unroll
      for (int k = 0; k < 4; ++k) { d[2 * k] += bf_lo(q[k]); d[2 * k + 1] += bf_hi(q[k]); }
    }
    const float sc = ((const float*)(ws + W_RS2))[m] * (1.0f / USCALE);
    const f32x4* gp = (const f32x4*)((const float*)(ws + W_SGATE) + m * 128 + s8);
    const f32x4 g0 = gp[0], g1 = gp[1];
    f32x4 o0, o1;
#pragma unroll
    for (int k = 0; k < 4; ++k) {
      o0[k] = gelu_(d[k] * sc) * g0[k] * (1.0f / VSCALE);
      o1[k] = gelu_(d[4 + k] * sc) * g1[k] * (1.0f / VSCALE);
    }
    f32x4* op = (f32x4*)((float*)(ws + W_WTS) + m * 128 + s8);
    op[0] = o0; op[1] = o1;
  }
}

DI void peer_v_phase(const Params& p) {
  char* ws = p.ws;
  const int tid_ = otid(); const int lane = tid_ & 63, w = tid_ >> 6, g = lane >> 3, li = lane & 7;
  const int v = blockIdx.x & 7, bx = blockIdx.x >> 3, nbx = (gridDim.x - v + 7) >> 3;
  const int gwx = bx * 4 + w, nwx = nbx * 4;
  const char* Vs = ws + W_VB + (size_t)v * 16384 * 128;
  const unsigned loff = li * 16;
  const int* sidx = (const int*)(ws + W_SIDX) + g * 16;
  const float* wts = (const float*)(ws + W_WTS) + g * 16;
  int4 ix[4];
  float4 wx[4];
  int m = gwx;
  if (m < TT) {
#pragma unroll
    for (int q = 0; q < 4; ++q) { ix[q] = ((const int4*)(sidx + (size_t)m * 128))[q]; wx[q] = ((const float4*)(wts + (size_t)m * 128))[q]; }
  }
  for (; m < TT; m += nwx) {
    const int idx[16] = {ix[0].x, ix[0].y, ix[0].z, ix[0].w, ix[1].x, ix[1].y, ix[1].z, ix[1].w,
                         ix[2].x, ix[2].y, ix[2].z, ix[2].w, ix[3].x, ix[3].y, ix[3].z, ix[3].w};
    const float wt[16] = {wx[0].x, wx[0].y, wx[0].z, wx[0].w, wx[1].x, wx[1].y, wx[1].z, wx[1].w,
                          wx[2].x, wx[2].y, wx[2].z, wx[2].w, wx[3].x, wx[3].y, wx[3].z, wx[3].w};
    u32x4 rows[16];
#pragma unroll
    for (int s2 = 0; s2 < 16; ++s2) rows[s2] = *(const u32x4*)(Vs + (((unsigned)idx[s2] << 7) + loff));
    const int mn = m + nwx;
    if (mn < TT) {
#pragma unroll
      for (int q = 0; q < 4; ++q) { ix[q] = ((const int4*)(sidx + (size_t)mn * 128))[q]; wx[q] = ((const float4*)(wts + (size_t)mn * 128))[q]; }
    }
    fl2_t acc[8];
#pragma unroll
    for (int q = 0; q < 8; ++q) acc[q] = {0.f, 0.f};
#pragma unroll
    for (int s2 = 0; s2 < 16; ++s2) {
      const fl2_t ww = {wt[s2], wt[s2]};
#pragma unroll
      for (int d = 0; d < 4; ++d) {
        const fl2_t lo = __builtin_amdgcn_cvt_pk_f32_fp8((int)rows[s2][d], false);
        const fl2_t hi = __builtin_amdgcn_cvt_pk_f32_fp8((int)rows[s2][d], true);
        acc[2 * d] = __builtin_elementwise_fma(lo, ww, acc[2 * d]);
        acc[2 * d + 1] = __builtin_elementwise_fma(hi, ww, acc[2 * d + 1]);
      }
    }
    float ps[16];
#pragma unroll
    for (int q = 0; q < 8; ++q) { ps[2 * q] = acc[q].x; ps[2 * q + 1] = acc[q].y; }
#pragma unroll
    for (int st = 0; st < 3; ++st) {
      const int bit = 32 >> st, half = 8 >> st;
      const bool upper = (lane & bit) != 0;
#pragma unroll
      for (int i = 0; i < half; ++i) {
        const float send = upper ? ps[i] : ps[i + half];
        const float keep = upper ? ps[i + half] : ps[i];
        ps[i] = keep + __shfl_xor(send, bit);
      }
    }
    const int cl = ((g >> 2) & 1) * 8 + ((g >> 1) & 1) * 4 + (g & 1) * 2;
    const size_t yo = (size_t)m * 1024 + v * 128 + li * 16 + cl;
    const unsigned hb2 = *(const unsigned*)((const u16*)(ws + W_HB) + yo);
    *(float2*)(p.out + O_Y + yo) = make_float2(bf_lo(hb2) + ps[0], bf_hi(hb2) + ps[1]);
  }
}

#define XB_TMO      128
#define XB_XCNT(j)  (256  + 64 * (j))
#define XB_XSUB(j)  (1280 + 64 * (j))
#define XB_XGEN(j)  (2304 + 64 * (j))
#define XB_TOP      3328
#define XB_TOPGEN   3392
#define XCD_BAR_WORDS 3456
#define XB_SPIN_CAP (1u << 18)
#define LAS __attribute__((address_space(3)))
DI unsigned xb_ld(unsigned* p) { return __hip_atomic_load(p, __ATOMIC_RELAXED, __HIP_MEMORY_SCOPE_AGENT); }
DI unsigned xb_add(unsigned* p, unsigned v) { return __hip_atomic_fetch_add(p, v, __ATOMIC_RELAXED, __HIP_MEMORY_SCOPE_AGENT); }
DI unsigned xb_xcc_id() { return (unsigned)__builtin_amdgcn_s_getreg((3 << 11) | 20) & 0xFu; }
#define XB_SPIN(cond, bar) do { unsigned _sp = 0; while (cond) { __builtin_amdgcn_s_sleep(8); \
    if ((++_sp & 255u) == 0u) { if (xb_ld(&(bar)[XB_TMO])) break; if (_sp > XB_SPIN_CAP) { atomicAdd(&(bar)[XB_TMO], 1u); break; } } } } while (0)
struct XcdBarrier { unsigned* bar; unsigned x; volatile LAS unsigned* st; };
DI XcdBarrier xcd_barrier_post(unsigned* bar, volatile LAS unsigned* st) {
  XcdBarrier b; b.bar = bar; b.x = xb_xcc_id(); b.st = st;
  if (threadIdx.x == 0) (void)xb_add(&bar[XB_XCNT(b.x)], 1u);
  return b;
}
DI void xcd_barrier_complete(unsigned* bar, unsigned x, unsigned& nloc, unsigned& nx) {
  const unsigned G = gridDim.x * gridDim.y * gridDim.z;
  unsigned sum, cnt, mine, sp = 0u;
  for (;;) {
    sum = 0u; cnt = 0u; mine = 0u;
#pragma unroll
    for (unsigned j = 0; j < 16; ++j) { const unsigned c = xb_ld(&bar[XB_XCNT(j)]); sum += c; cnt += (c > 0u) ? 1u : 0u; mine = (j == x) ? c : mine; }
    if (sum == G) break;
    __builtin_amdgcn_s_sleep(1);
    if ((++sp & 255u) == 0u) { if (xb_ld(&bar[XB_TMO])) break; if (sp > XB_SPIN_CAP) { atomicAdd(&bar[XB_TMO], 1u); break; } }
  }
  nloc = mine > 0u ? mine : 1u; nx = cnt > 0u ? cnt : 1u;
}
DI void xcd_barrier(const XcdBarrier& b) {
  asm volatile("s_waitcnt vmcnt(0)" ::: "memory");
  __syncthreads();
  if (threadIdx.x == 0) {
    unsigned* bar = b.bar;
    __builtin_amdgcn_s_waitcnt(0);
    unsigned nloc = b.st[0], nx = b.st[1];
    if (nloc == 0u) { xcd_barrier_complete(bar, b.x, nloc, nx); b.st[0] = nloc; b.st[1] = nx; }
    const unsigned old = xb_add(&bar[XB_XSUB(b.x)], 1u);
    const unsigned gen = old / nloc;
    if (old + 1u == (gen + 1u) * nloc) {
      __builtin_amdgcn_fence(__ATOMIC_RELEASE, "agent");
      asm volatile("s_waitcnt vmcnt(0)" ::: "memory");
      const unsigned og = xb_add(&bar[XB_TOP], 1u);
      const unsigned tg = og / nx;
      if (og + 1u == (tg + 1u) * nx) xb_add(&bar[XB_TOPGEN], 1u);
      else XB_SPIN(xb_ld(&bar[XB_TOPGEN]) == tg, bar);
      __builtin_amdgcn_fence(__ATOMIC_ACQUIRE, "agent");
      xb_add(&bar[XB_XGEN(b.x)], 1u);
      asm volatile("s_waitcnt vmcnt(0)" ::: "memory");
    } else {
      XB_SPIN(xb_ld(&bar[XB_XGEN(b.x)]) == gen, bar);
      __builtin_amdgcn_fence(__ATOMIC_ACQUIRE, "agent");
      asm volatile("s_waitcnt vmcnt(0)" ::: "memory");
    }
  }
  __syncthreads();
}

__global__ void __launch_bounds__(256, 2) hymba_mega(Params p) {
  __shared__ __attribute__((aligned(16))) char smem[73728];
  __shared__ uint4 xb_words;
  cg::grid_group grid = cg::this_grid();
  const int nb = gridDim.x, bid = blockIdx.x;
  const bool xcd_ok = (nb & 7) == 0 && nb >= 8;
  const int vx = bid & 7, bxx = bid >> 3, nbx = nb >> 3;
  if (threadIdx.x == 0) xb_words = make_uint4(0u, 0u, 0u, 0u);
  __syncthreads();
  XcdBarrier xb = xcd_barrier_post((unsigned*)(p.ws + W_BAR), (volatile LAS unsigned*)&xb_words);
  if (p.out == nullptr) grid.sync();
  phase0(p, smem);
  xcd_barrier(xb);
  {
    const int cnt = xcd_ok ? ((130 - vx + 7) >> 3) * 14 : 130 * 14;
    for (int u = xcd_ok ? bxx : bid; u < cnt; u += xcd_ok ? nbx : nb) {
      const int mt = xcd_ok ? vx + 8 * (u / 14) : u / 14;
      gemm_tile<1>(p, mt, u % 14, smem);
    }
    __syncthreads();
    phase0b(p, smem);
  }
  xcd_barrier(xb);
  for (int it = bid; it < 512; it += nb) lru_item<0>(p, it, smem);
  xcd_barrier(xb);
  {
    __shared__ int q_item;
    unsigned* qhead = (unsigned*)(p.ws + W_QW);
    int it = bid;
    while (it < 528 + 544) {
      if (it < 528) lru_item<1>(p, it, smem);
      else attn_item(p, it - 528, smem);
      __syncthreads();
      if (threadIdx.x == 0) q_item = nb + (int)atomicAdd(qhead, 1u);
      __syncthreads();
      it = q_item;
    }
  }
  xcd_barrier(xb);
  {
    const int cnt = xcd_ok ? 130 : 130 * 8, st = xcd_ok ? bxx : bid, sd = xcd_ok ? nbx : nb;
    for (int u = st; u < cnt; u += sd) gemm_tile<2>(p, xcd_ok ? u : (u >> 3), xcd_ok ? vx : (u & 7), smem);
    const int extra = cnt % sd;
    (void)extra;
    conv_table_queue(p, true, (unsigned*)(p.ws + W_QW + 64));
  }
  xcd_barrier(xb);
  {
    const int cnt = xcd_ok ? 260 : 130 * 16, st = xcd_ok ? bxx : bid, sd = xcd_ok ? nbx : nb;
    for (int u = st; u < cnt; u += sd) gemm_tile<3>(p, xcd_ok ? (u >> 1) : (u >> 4), xcd_ok ? (vx * 2 + (u & 1)) : (u & 15), smem);
    const int extra = cnt % sd;
    (void)extra;
    conv_table_queue(p, false, (unsigned*)(p.ws + W_QW + 128));
  }
  xcd_barrier(xb);
  __syncthreads();
  route2(p, smem);
  xcd_barrier(xb);
  peer_u_phase(p);
  xcd_barrier(xb);
  peer_combine(p);
  xcd_barrier(xb);
  peer_v_phase(p);
}

extern "C" void kernel_launch(void* const* d_in, const int* in_sizes, int n_in, void* d_out, int out_size, void* d_ws,
                              size_t ws_size, hipStream_t stream) {
  static int grid_blocks = 0;
  if (!grid_blocks) {
    int dev = 0, cus = 0, per_cu = 0;
    (void)hipGetDevice(&dev);
    (void)hipDeviceGetAttribute(&cus, hipDeviceAttributeMultiprocessorCount, dev);
    (void)hipOccupancyMaxActiveBlocksPerMultiprocessor(&per_cu, hymba_mega, 256, 0);
    if (per_cu > 2) per_cu = 2;
    if (per_cu < 1) per_cu = 1;
    grid_blocks = cus * per_cu;
  }
  if (ws_size < W_END) fprintf(stderr, "workspace too small: %zu < %zu\n", ws_size, (size_t)W_END);
  Params p{};
  const float** pp = (const float**)&p;
  for (int i = 0; i < 27; ++i) pp[i] = (const float*)d_in[i];
  p.out = (float*)d_out;
  p.ws = (char*)d_ws;
  (void)hipMemsetAsync((char*)d_ws + W_BAR, 0, al(XCD_BAR_WORDS * 4) + 256, stream);
  void* args[] = {&p};
  hipError_t e = hipLaunchCooperativeKernel((void*)hymba_mega, dim3(grid_blocks), dim3(256), args, 0, stream);
  if (e != hipSuccess) fprintf(stderr, "cooperative launch failed: %s (grid %d)\n", hipGetErrorString(e), grid_blocks);
}
```

```cpp
#include <hip/hip_runtime.h>
#include <hip/hip_cooperative_groups.h>
#include <cstdio>
namespace cg = cooperative_groups;

#define DI __device__ __forceinline__
typedef __bf16 bf2_t __attribute__((ext_vector_type(2)));
typedef float fl2_t __attribute__((ext_vector_type(2)));
typedef short bf16x8 __attribute__((ext_vector_type(8)));
typedef float f32x16 __attribute__((ext_vector_type(16)));
typedef unsigned short u16;
typedef unsigned u32x4 __attribute__((ext_vector_type(4)));
typedef float f32x4 __attribute__((ext_vector_type(4)));
#define MFMA32(a, b, c) __builtin_amdgcn_mfma_f32_32x32x16_bf16((a), (b), (c), 0, 0, 0)

constexpr int TP = 16384, TS = 256, TT = 16640;
constexpr float EPS = 1e-6f;
constexpr float USCALE = 512.0f, VSCALE = 64.0f;

constexpr size_t O_Y = 0;
constexpr size_t O_KP = 17039360, O_VP = 17170432, O_CONVP = 17301504, O_LRUP = 17313792;
constexpr size_t O_KS = 17317888, O_VS = 17580032, O_CONVS = 17842176, O_LRUS = 17866752;

constexpr size_t al(size_t x) { return (x + 255) & ~size_t(255); }
constexpr size_t W_WTIN = 0;
constexpr size_t W_WTOUT = W_WTIN + al(1792ull * 1024 * 2);
constexpr size_t W_WTQ = W_WTOUT + al(1024ull * 1024 * 2);
constexpr size_t W_K1B = W_WTQ + al(2048ull * 1024 * 2);
constexpr size_t W_K2B = W_K1B + al(128 * 128 * 2);
constexpr size_t W_WAT = W_K2B + al(128 * 128 * 2);
constexpr size_t W_WIT = W_WAT + al(8 * 64 * 64 * 2);
constexpr size_t W_C8 = W_WIT + al(8 * 64 * 64 * 2);
constexpr size_t W_UB = W_C8 + al(512 * 4);
constexpr size_t W_VB = W_UB + 16384ull * 1024;
constexpr size_t W_XB = W_UB + al(16384ull * 1024 * 2);
constexpr size_t W_RB = W_XB + al(16384ull * 1024 * 2);
constexpr size_t W_CAT = W_RB;
constexpr size_t W_SIDX = W_RB;
constexpr size_t W_SGATE = W_RB + al(TT * 128ull * 4);
constexpr size_t W_RC = W_RB + al(TT * 1024ull * 2);
constexpr size_t W_U = W_RC;
constexpr size_t W_GG = W_RC + TT * 512ull * 2;
constexpr size_t W_HB = W_RC;
constexpr size_t W_Q = W_RC + al(TT * 1024ull * 2);
constexpr size_t W_KP = W_Q + al(TT * 512ull * 2);
constexpr size_t W_KS = W_KP + al(TP * 128ull * 2);
constexpr size_t W_VTP = W_KS + al(16 * 192 * 128 * 2);
constexpr size_t W_VTS = W_VTP + al(8 * 128 * 2048ull * 2);
constexpr size_t W_SUMA = W_VTS + al(16 * 128 * 192 * 2);
constexpr size_t W_SUMH = W_SUMA + al(512 * 512 * 4);
constexpr size_t W_RS1 = W_SUMH + al(512 * 512 * 4);
constexpr size_t W_SSQL = W_RS1 + al(TT * 4);
constexpr size_t W_SSQA = W_SSQL + al(TT * 4 * 4);
constexpr size_t W_SSQ2 = W_SSQA + al(TT * 8 * 4);
constexpr size_t W_PQ = W_SSQ2 + al(TT * 16 * 4);
constexpr size_t W_TOPL = W_PQ;
constexpr size_t W_PART = W_PQ;
constexpr size_t W_WTS = W_SGATE + al(TT * 128ull * 4);
constexpr size_t W_RS2 = W_PQ + al(TT * 2048ull * 2);
constexpr size_t W_BAR = W_RS2 + al(TT * 4);
constexpr size_t W_QW = W_BAR + al(3456 * 4);
constexpr size_t W_XBS = W_QW + 256;
constexpr size_t W_END = W_XBS + al(256ull * 2048);

struct Params {
  const float *x_p, *x_s, *cache_k, *cache_v, *state_conv, *state_lru, *ln1_g, *w_in, *conv_w, *conv_b,
      *lru_wa, *lru_ba, *lru_wi, *lru_bi, *lru_lambda, *q_g, *k_g, *sinks, *g_lru, *g_attn, *w_out, *ln2_g,
      *w_query, *sk1, *sk2, *peer_u, *peer_v;
  float* out;
  char* ws;
};

DI unsigned pk2(float a, float b) {
  fl2_t f = {a, b};
  return __builtin_bit_cast(unsigned, __builtin_convertvector(f, bf2_t));
}
DI float bf_lo(unsigned u) { return __uint_as_float(u << 16); }
DI float bf_hi(unsigned u) { return __uint_as_float(u & 0xffff0000u); }
DI float bf1(u16 v) { return __uint_as_float(((unsigned)v) << 16); }
DI float sigmoidf_(float x) { return __builtin_amdgcn_rcpf(1.0f + __expf(-x)); }
DI float gelu_(float x) {
  float z = 0.7978845608028654f * (x + 0.044715f * x * x * x);
  return x * __builtin_amdgcn_rcpf(1.0f + __expf(-2.0f * z));
}
DI int otid() { int t = threadIdx.x; asm volatile("" : "+v"(t)); return t; }
DI int crow(int r, int h) { return (r & 3) + 8 * (r >> 2) + 4 * h; }

DI void transpose_tile(const float* __restrict__ src, int ld_src, u16* __restrict__ dst, int ld_dst, int k0, int n0,
                       const float* __restrict__ gain, float* tile) {
  const int tid = otid();
  const int c = tid & 63, r0 = tid >> 6;
  __syncthreads();
#pragma unroll 4
  for (int rr = 0; rr < 16; ++rr) {
    int r = rr * 4 + r0;
    float v = src[(size_t)(k0 + r) * ld_src + n0 + c];
    if (gain) v *= gain[k0 + r];
    tile[r * 65 + c] = v;
  }
  __syncthreads();
  const int n = tid >> 2, kq = (tid & 3) * 16;
  unsigned pk[8];
#pragma unroll
  for (int i = 0; i < 8; ++i) pk[i] = pk2(tile[(kq + 2 * i) * 65 + n], tile[(kq + 2 * i + 1) * 65 + n]);
  uint4* d = (uint4*)(dst + (size_t)(n0 + n) * ld_dst + k0 + kq);
  d[0] = make_uint4(pk[0], pk[1], pk[2], pk[3]);
  d[1] = make_uint4(pk[4], pk[5], pk[6], pk[7]);
}

DI void wf_tile(const Params& p, int hh, int ktile) {
  const int tid = otid(), lane = tid & 63, w = tid >> 6, wn = w & 1, wm = w >> 1, tl = lane & 31, h = lane >> 5;
  const float* sk = (hh & 1) ? p.sk2 : p.sk1;
  f32x16 acc[2][2];
#pragma unroll
  for (int i = 0; i < 2; ++i)
#pragma unroll
    for (int j = 0; j < 2; ++j)
#pragma unroll
      for (int r = 0; r < 16; ++r) acc[i][j][r] = 0.f;
  const int kcol0 = ktile * 128 + wm * 64 + tl;
  const float g2a = p.ln2_g[kcol0], g2b = p.ln2_g[kcol0 + 32];
#pragma unroll 2
  for (int kk = 0; kk < 8; ++kk) {
    bf16x8 a[2], b[2];
#pragma unroll
    for (int i = 0; i < 2; ++i) {
      const float4* sp = (const float4*)(sk + (size_t)(wn * 64 + i * 32 + tl) * 128 + kk * 16 + h * 8);
      const float4 x = sp[0], y = sp[1];
      u32x4 t; t[0] = pk2(x.x, x.y); t[1] = pk2(x.z, x.w); t[2] = pk2(y.x, y.y); t[3] = pk2(y.z, y.w);
      a[i] = __builtin_bit_cast(bf16x8, t);
    }
#pragma unroll
    for (int j = 0; j < 2; ++j) {
      const float gg = j ? g2b : g2a;
      const float4* sp = (const float4*)(p.w_query + (size_t)(kcol0 + j * 32) * 2048 + hh * 128 + kk * 16 + h * 8);
      const float4 x = sp[0], y = sp[1];
      u32x4 t; t[0] = pk2(x.x * gg, x.y * gg); t[1] = pk2(x.z * gg, x.w * gg); t[2] = pk2(y.x * gg, y.y * gg); t[3] = pk2(y.z * gg, y.w * gg);
      b[j] = __builtin_bit_cast(bf16x8, t);
    }
#pragma unroll
    for (int i = 0; i < 2; ++i)
#pragma unroll
      for (int j = 0; j < 2; ++j) acc[i][j] = MFMA32(a[i], b[j], acc[i][j]);
  }
  u16* dst = (u16*)(p.ws + W_WTQ);
#pragma unroll
  for (int i = 0; i < 2; ++i)
#pragma unroll
    for (int j = 0; j < 2; ++j)
#pragma unroll
      for (int r = 0; r < 16; r += 2) {
        const int key = wn * 64 + i * 32 + crow(r, h);
        const unsigned pkv = pk2(acc[i][j][r], acc[i][j][r + 1]);
        dst[(size_t)(hh * 128 + key) * 1024 + kcol0 + j * 32] = (u16)(pkv & 0xffffu);
        dst[(size_t)(hh * 128 + key + 1) * 1024 + kcol0 + j * 32] = (u16)(pkv >> 16);
      }
}

DI void conv_table(const Params& p, bool isU, int part, int nparts, int seg = 0, int nseg = 1) {
  char* ws = p.ws;
  const float* src = isU ? p.peer_u : p.peer_v;
  char* dstb = ws + (isU ? W_UB : W_VB);
  const float scale = isU ? USCALE : VSCALE;
  const size_t i0 = (16384ull * 64 / nseg) * seg, i1 = i0 + 16384ull * 64 / nseg;
  for (size_t i = i0 + (size_t)part * 256 + threadIdx.x; i < i1; i += (size_t)nparts * 256) {
    const int e = (int)(i >> 6), c16 = (int)(i & 63);
    const float4* su = (const float4*)(src + (size_t)e * 1024 + c16 * 16);
    const float4* g2 = (const float4*)(p.ln2_g + c16 * 16);
    u32x4 ou;
#pragma unroll
    for (int q = 0; q < 4; ++q) {
      float4 a = su[q];
      if (isU) { const float4 g = g2[q]; a.x *= g.x; a.y *= g.y; a.z *= g.z; a.w *= g.w; }
      int pu = 0;
      pu = __builtin_amdgcn_cvt_pk_fp8_f32(a.x * scale, a.y * scale, pu, false);
      pu = __builtin_amdgcn_cvt_pk_fp8_f32(a.z * scale, a.w * scale, pu, true);
      ou[q] = (unsigned)pu;
    }
    const size_t off = ((size_t)((c16 >> 3) * 16384 + e)) * 128 + (c16 & 7) * 16;
    *(u32x4*)(dstb + off) = ou;
  }
}

DI void conv_table_queue(const Params& p, bool isU, unsigned* qhead) {
  __shared__ int q_chunk;
  for (;;) {
    __syncthreads();
    if (threadIdx.x == 0) q_chunk = (int)atomicAdd(qhead, 1u);
    __syncthreads();
    const int ch = q_chunk;
    if (ch >= 1024) break;
    conv_table(p, isU, 0, 1, ch, 1024);
  }
}

DI void phase0(const Params& p, char* smem) {
  const int nb = gridDim.x, bid = blockIdx.x, tid = otid();
  char* ws = p.ws;
  float* tile = (float*)smem;
  for (int it = bid; it < 448; it += nb) {
    int kt = it / 28, nt = it % 28;
    transpose_tile(p.w_in, 1792, (u16*)(ws + W_WTIN), 1024, kt * 64, nt * 64, p.ln1_g, tile);
  }
  {
    const int lane = tid & 63;
    const int gw = bid * 4 + (tid >> 6), nw = nb * 4;
    for (int m = gw; m < TT; m += nw) {
      const float* xr = (m < TP) ? (p.x_p + (size_t)m * 1024) : (p.x_s + (size_t)(m - TP) * 1024);
      const float4* xp = (const float4*)xr;
      float ss = 0.f;
      uint4* dst = (uint4*)(ws + ((m < TP) ? (W_XB + (size_t)m * 2048) : (W_XBS + (size_t)(m - TP) * 2048)));
#pragma unroll
      for (int q = 0; q < 2; ++q) {
        float4 a = xp[q * 128 + lane * 2], b = xp[q * 128 + lane * 2 + 1];
        ss += a.x * a.x + a.y * a.y + a.z * a.z + a.w * a.w + b.x * b.x + b.y * b.y + b.z * b.z + b.w * b.w;
        dst[q * 64 + lane] = make_uint4(pk2(a.x, a.y), pk2(a.z, a.w), pk2(b.x, b.y), pk2(b.z, b.w));
      }
#pragma unroll
      for (int s = 32; s >= 1; s >>= 1) ss += __shfl_xor(ss, s);
      if (lane == 0) ((float*)(ws + W_RS1))[m] = rsqrtf(ss * (1.0f / 1024.0f) + EPS);
    }
  }
}

DI void phase0b(const Params& p, char* smem) {
  const int nb = gridDim.x, bid = blockIdx.x, tid = otid();
  char* ws = p.ws;
  float* tile = (float*)smem;
  for (int it = nb - 1 - bid; it < 384; it += nb) {
    if (it < 256) {
      int kt = it >> 4, nt = it & 15;
      const float* gain = (kt < 8) ? p.g_lru : (p.g_attn - 512);
      transpose_tile(p.w_out, 1024, (u16*)(ws + W_WTOUT), 1024, kt * 64, nt * 64, gain, tile);
    } else {
      wf_tile(p, (it - 256) >> 3, (it - 256) & 7);
    }
  }
  const size_t gt = (size_t)bid * 256 + tid, gstride = (size_t)nb * 256;
  for (size_t i = gt; i < 8192; i += gstride) {
    const int mat = (int)(i >> 12), r = (int)(i & 4095);
    const int ln = r & 63, kk = (r >> 6) & 3, ii = (r >> 8) & 1, n = r >> 9;
    const float* src = (mat ? p.lru_wi : p.lru_wa) + n * 4096 + (kk * 16 + (ln >> 5) * 8) * 64 + ii * 32 + (ln & 31);
    u32x4 o;
    o[0] = pk2(src[0], src[64]); o[1] = pk2(src[128], src[192]); o[2] = pk2(src[256], src[320]); o[3] = pk2(src[384], src[448]);
    *(u32x4*)(ws + (mat ? W_WIT : W_WAT) + (size_t)r * 16) = o;
  }
  for (size_t i = gt; i < 512; i += gstride) {
    float l = p.lru_lambda[i];
    float sp = (l < -15.f) ? -l : log1pf(expf(-l));
    ((float*)(ws + W_C8))[i] = -8.0f * sp;
  }
  for (size_t i = gt; i < 16 * 128 * 16; i += gstride) {
    int b = (int)(i >> 11), rem = (int)(i & 2047);
    int t = rem >> 4, c8i = rem & 15;
    const float4* sk = (const float4*)(p.cache_k + ((size_t)(b * 128 + t) * 128 + c8i * 8));
    float4 a = sk[0], bb = sk[1];
    uint4 o = make_uint4(pk2(a.x, a.y), pk2(a.z, a.w), pk2(bb.x, bb.y), pk2(bb.z, bb.w));
    *(uint4*)(ws + W_KS + ((size_t)(b * 192 + t) * 128 + c8i * 8) * 2) = o;
    const float4* sv = (const float4*)(p.cache_v + ((size_t)(b * 128 + t) * 128 + c8i * 8));
    float4 va = sv[0], vb = sv[1];
    if (t >= 16) {
      float4* dk = (float4*)(p.out + O_KS + ((size_t)(b * 128 + t - 16) * 128 + c8i * 8));
      dk[0] = a; dk[1] = bb;
      float4* dv = (float4*)(p.out + O_VS + ((size_t)(b * 128 + t - 16) * 128 + c8i * 8));
      dv[0] = va; dv[1] = vb;
    }
    u16* vt = (u16*)(ws + W_VTS) + (size_t)b * 128 * 192;
    float vv[8] = {va.x, va.y, va.z, va.w, vb.x, vb.y, vb.z, vb.w};
#pragma unroll
    for (int q = 0; q < 8; ++q) vt[(size_t)(c8i * 8 + q) * 192 + t] = (u16)(pk2(vv[q], 0.f) & 0xffffu);
  }
  for (size_t i = gt; i < 16 * 48 * 128; i += gstride) {
    int b = (int)(i / (48 * 128)), rem = (int)(i % (48 * 128));
    ((u16*)(ws + W_KS))[(size_t)(b * 192 + 144) * 128 + rem] = 0;
    int ch = rem / 48, tt = rem % 48;
    ((u16*)(ws + W_VTS))[(size_t)(b * 128 + ch) * 192 + 144 + tt] = 0;
  }
}

DI unsigned f2ord(float f) { unsigned u = __float_as_uint(f); return u ^ ((unsigned)((int)u >> 31) | 0x80000000u); }
DI float ord2f(unsigned u) { return __uint_as_float((u & 0x80000000u) ? (u ^ 0x80000000u) : ~u); }
DI void cas_desc(unsigned& a, unsigned& b) { unsigned mx = a > b ? a : b, mn = a > b ? b : a; a = mx; b = mn; }
DI void sort16_desc(unsigned (&v)[16]) {
#define CS(a, b) cas_desc(v[a], v[b]);
  CS(0,13) CS(1,12) CS(2,15) CS(3,14) CS(4,8) CS(5,6) CS(7,11) CS(9,10)
  CS(0,5) CS(1,7) CS(2,9) CS(3,4) CS(6,13) CS(8,14) CS(10,15) CS(11,12)
  CS(0,1) CS(2,3) CS(4,5) CS(6,8) CS(7,9) CS(10,11) CS(12,13) CS(14,15)
  CS(0,2) CS(1,3) CS(4,10) CS(5,11) CS(6,7) CS(8,9) CS(12,14) CS(13,15)
  CS(1,2) CS(3,12) CS(4,6) CS(5,7) CS(8,10) CS(9,11) CS(13,14)
  CS(1,4) CS(2,6) CS(5,8) CS(7,10) CS(9,13) CS(11,14)
  CS(2,4) CS(3,6) CS(9,12) CS(11,13)
  CS(3,5) CS(6,8) CS(7,9) CS(10,12)
  CS(3,4) CS(5,6) CS(7,8) CS(9,10) CS(11,12)
  CS(6,7) CS(8,9)
#undef CS
}
DI void merge16_desc(unsigned (&v)[16]) {
#pragma unroll
  for (int j = 8; j > 0; j >>= 1)
#pragma unroll
    for (int i = 0; i < 16; ++i) {
      int l = i ^ j;
      if (l > i) cas_desc(v[i], v[l]);
    }
}
DI void merge_top16(unsigned (&a)[16], unsigned (&b)[16]) {
#pragma unroll
  for (int i = 0; i < 16; ++i) a[i] = a[i] > b[15 - i] ? a[i] : b[15 - i];
  merge16_desc(a);
}


template <int MODE>
DI void gemm_tile(const Params& p, int mt, int nt, char* smem) {
  constexpr int LROW = 144;
  char* ws = p.ws;
  const char* Wt = ws + (MODE == 1 ? W_WTIN : (MODE == 2 ? W_WTOUT : W_WTQ));
  const char* X = (MODE == 1) ? ((mt < 128) ? ws + W_XB : ws + W_XBS - (size_t)TP * 2048) : ws + (MODE == 2 ? W_CAT : W_HB);
  char* sW = smem;
  char* sX = smem + 128 * LROW;
  const int tid = otid(), lane = tid & 63, w = tid >> 6, wn = w & 1, wm = w >> 1;
  const int tl = lane & 31, h = lane >> 5;
  const char* gW = Wt + (size_t)(nt * 128) * 2048;
  const char* gX = X + (size_t)(mt * 128) * 2048;
  u32x4 rW[4], rX[4];
  f32x16 acc[2][2];
#pragma unroll
  for (int i = 0; i < 2; ++i)
#pragma unroll
    for (int j = 0; j < 2; ++j)
#pragma unroll
      for (int r = 0; r < 16; ++r) acc[i][j][r] = 0.f;

  const int m_lane[2] = {mt * 128 + wm * 64 + tl, mt * 128 + wm * 64 + 32 + tl};
  float ratio[2] = {1.f, 1.f}, fscale[2] = {1.f, 1.f};
  if (MODE == 2) {
#pragma unroll
    for (int j = 0; j < 2; ++j) {
      const float4 sl = *(const float4*)(ws + W_SSQL + (size_t)m_lane[j] * 16);
      const float4 sa0 = *(const float4*)(ws + W_SSQA + (size_t)m_lane[j] * 32);
      const float4 sa1 = *(const float4*)(ws + W_SSQA + (size_t)m_lane[j] * 32 + 16);
      float rsl = rsqrtf((sl.x + sl.y + sl.z + sl.w) * (1.0f / 512.0f) + EPS);
      float rsa = rsqrtf((sa0.x + sa0.y + sa0.z + sa0.w + sa1.x + sa1.y + sa1.z + sa1.w) * (1.0f / 512.0f) + EPS);
      ratio[j] = rsl / rsa;
      fscale[j] = rsa;
    }
  } else if (MODE == 1) {
#pragma unroll
    for (int j = 0; j < 2; ++j) fscale[j] = ((const float*)(ws + W_RS1))[m_lane[j]];
  } else {
#pragma unroll
    for (int j = 0; j < 2; ++j) {
      const float4* sp = (const float4*)(ws + W_SSQ2 + (size_t)m_lane[j] * 64);
      float4 a = sp[0], b = sp[1], c = sp[2], d = sp[3];
      float s = a.x + a.y + a.z + a.w + b.x + b.y + b.z + b.w + c.x + c.y + c.z + c.w + d.x + d.y + d.z + d.w;
      fscale[j] = rsqrtf(s * (1.0f / 1024.0f) + EPS);
    }
  }

  constexpr int BUF = 2 * 128 * LROW;
#pragma unroll
  for (int i = 0; i < 4; ++i) {
    int c = tid + 256 * i, row = c >> 3, kc = c & 7;
    rW[i] = *(const u32x4*)(gW + (unsigned)(row * 2048 + kc * 16));
    rX[i] = *(const u32x4*)(gX + (unsigned)(row * 2048 + kc * 16));
  }
  __syncthreads();
#pragma unroll
  for (int i = 0; i < 4; ++i) {
    int c = tid + 256 * i, row = c >> 3, kc = c & 7;
    *(u32x4*)(sW + row * LROW + kc * 16) = rW[i];
    *(u32x4*)(sX + row * LROW + kc * 16) = rX[i];
  }
#pragma unroll
  for (int i = 0; i < 4; ++i) {
    int c = tid + 256 * i, row = c >> 3, kc = c & 7;
    rW[i] = *(const u32x4*)(gW + (unsigned)(row * 2048 + 128 + kc * 16));
    rX[i] = *(const u32x4*)(gX + (unsigned)(row * 2048 + 128 + kc * 16));
  }
  __syncthreads();
  for (int ks = 0; ks < 16; ++ks) {
    const int cur = (ks & 1) * BUF, nxt = BUF - cur;
    if (MODE == 2 && ks == 8) {
#pragma unroll
      for (int i = 0; i < 2; ++i)
#pragma unroll
        for (int j = 0; j < 2; ++j)
#pragma unroll
          for (int r = 0; r < 16; ++r) acc[i][j][r] *= ratio[j];
    }
#pragma unroll
    for (int kh = 0; kh < 2; ++kh) {
      __builtin_amdgcn_s_setprio(2);
#pragma unroll
      for (int k2 = 0; k2 < 2; ++k2) {
        const int kk = kh * 2 + k2;
        bf16x8 a[2], b[2];
#pragma unroll
        for (int i = 0; i < 2; ++i) a[i] = *(const bf16x8*)(sW + cur + (wn * 64 + i * 32 + tl) * LROW + kk * 32 + h * 16);
#pragma unroll
        for (int j = 0; j < 2; ++j) b[j] = *(const bf16x8*)(sX + cur + (wm * 64 + j * 32 + tl) * LROW + kk * 32 + h * 16);
#pragma unroll
        for (int i = 0; i < 2; ++i)
#pragma unroll
          for (int j = 0; j < 2; ++j) acc[i][j] = MFMA32(a[i], b[j], acc[i][j]);
      }
      __builtin_amdgcn_s_setprio(0);
      if (kh == 0 && ks + 1 < 16) {
#pragma unroll
        for (int i = 0; i < 4; ++i) {
          int c = tid + 256 * i, row = c >> 3, kc = c & 7;
          *(u32x4*)(sW + nxt + row * LROW + kc * 16) = rW[i];
          *(u32x4*)(sX + nxt + row * LROW + kc * 16) = rX[i];
        }
        if (ks + 2 < 16) {
#pragma unroll
          for (int i = 0; i < 4; ++i) {
            int c = tid + 256 * i, row = c >> 3, kc = c & 7;
            rW[i] = *(const u32x4*)(gW + (unsigned)(row * 2048 + (ks + 2) * 128 + kc * 16));
            rX[i] = *(const u32x4*)(gX + (unsigned)(row * 2048 + (ks + 2) * 128 + kc * 16));
          }
        }
      }
    }
    if (ks + 1 < 16) __syncthreads();
  }

  const int ncol0 = nt * 128 + wn * 64;
  if (MODE == 1) {
    u16* Tb = (u16*)smem;
    const int tcol0 = wn * 64 + 4 * h;
    if (nt < 13) __syncthreads();
    if (ncol0 < 512) {
#pragma unroll
      for (int j = 0; j < 2; ++j) {
        const int m = m_lane[j];
        float* convdst = nullptr;
        if (m < TP) {
          int t = m & 2047;
          if (t >= 2045) convdst = p.out + O_CONVP + (size_t)((m >> 11) * 3 + (t - 2045)) * 512;
        } else {
          int ms = m - TP, t = ms & 15;
          if (t >= 13) convdst = p.out + O_CONVS + (size_t)((ms >> 4) * 3 + (t - 13)) * 512;
        }
        u16* ub = (u16*)(ws + W_U) + (size_t)m * 512;
#pragma unroll
        for (int i = 0; i < 2; ++i)
#pragma unroll
          for (int g = 0; g < 4; ++g) {
            int n = ncol0 + i * 32 + 8 * g + 4 * h;
            float v0 = acc[i][j][4 * g] * fscale[j], v1 = acc[i][j][4 * g + 1] * fscale[j],
                  v2 = acc[i][j][4 * g + 2] * fscale[j], v3 = acc[i][j][4 * g + 3] * fscale[j];
            *(uint2*)(Tb + (wm * 64 + j * 32 + tl) * 136 + tcol0 + i * 32 + 8 * g) = make_uint2(pk2(v0, v1), pk2(v2, v3));
            if (convdst) *(float4*)(convdst + n) = make_float4(v0, v1, v2, v3);
          }
      }
    } else if (ncol0 < 1024) {
#pragma unroll
      for (int j = 0; j < 2; ++j) {
        u16* gb = (u16*)(ws + W_GG) + (size_t)m_lane[j] * 512;
#pragma unroll
        for (int i = 0; i < 2; ++i)
#pragma unroll
          for (int g = 0; g < 4; ++g) {
            int n = ncol0 - 512 + i * 32 + 8 * g + 4 * h;
            float v0 = gelu_(acc[i][j][4 * g] * fscale[j]), v1 = gelu_(acc[i][j][4 * g + 1] * fscale[j]),
                  v2 = gelu_(acc[i][j][4 * g + 2] * fscale[j]), v3 = gelu_(acc[i][j][4 * g + 3] * fscale[j]);
            *(uint2*)(Tb + (wm * 64 + j * 32 + tl) * 136 + tcol0 + i * 32 + 8 * g) = make_uint2(pk2(v0, v1), pk2(v2, v3));
          }
      }
    } else if (ncol0 < 1664) {
      const bool isq = ncol0 < 1536;
      const float* gain = isq ? p.q_g : p.k_g;
      const float post = isq ? 0.125f : 1.0f;
#pragma unroll
      for (int j = 0; j < 2; ++j) {
        const int m = m_lane[j];
        float ss = 0.f;
#pragma unroll
        for (int i = 0; i < 2; ++i)
#pragma unroll
          for (int r = 0; r < 16; ++r) {
            float v = acc[i][j][r] * fscale[j];
            ss += v * v;
          }
        ss += __shfl_xor(ss, 32);
        const float sc = fscale[j] * rsqrtf(ss * (1.0f / 64.0f) + EPS) * post;
        u16* dst;
        float* fdst = nullptr;
        int nloc0;
        if (isq) {
          nloc0 = ncol0 - 1024;
          dst = (u16*)(ws + W_Q) + (size_t)m * 512 + nloc0;
        } else {
          nloc0 = ncol0 - 1536;
          if (m < TP) {
            dst = (u16*)(ws + W_KP) + (size_t)m * 128 + nloc0;
            int t = m & 2047;
            if (t >= 1920) fdst = p.out + O_KP + (size_t)((m >> 11) * 128 + (t - 1920)) * 128 + nloc0;
          } else {
            int ms = m - TP, b = ms >> 4, t = ms & 15;
            dst = (u16*)(ws + W_KS) + (size_t)(b * 192 + 128 + t) * 128 + nloc0;
            fdst = p.out + O_KS + (size_t)(b * 128 + 112 + t) * 128 + nloc0;
          }
        }
#pragma unroll
        for (int i = 0; i < 2; ++i)
#pragma unroll
          for (int g = 0; g < 4; ++g) {
            int d = i * 32 + 8 * g + 4 * h;
            const float4 gn = *(const float4*)(gain + d);
            float v0 = acc[i][j][4 * g] * sc * gn.x, v1 = acc[i][j][4 * g + 1] * sc * gn.y,
                  v2 = acc[i][j][4 * g + 2] * sc * gn.z, v3 = acc[i][j][4 * g + 3] * sc * gn.w;
            *(uint2*)(Tb + (wm * 64 + j * 32 + tl) * 136 + tcol0 + i * 32 + 8 * g) = make_uint2(pk2(v0, v1), pk2(v2, v3));
            if (fdst) *(float4*)(fdst + d) = make_float4(v0, v1, v2, v3);
          }
      }
    } else {
#pragma unroll
      for (int j = 0; j < 2; ++j) {
        const int m = m_lane[j];
        u16* vt;
        size_t vstride;
        float* fdst = nullptr;
        const int ch0 = ncol0 - 1664;
        if (m < TP) {
          int b = m >> 11, t = m & 2047;
          vt = (u16*)(ws + W_VTP) + (size_t)b * 128 * 2048 + t;
          vstride = 2048;
          if (t >= 1920) fdst = p.out + O_VP + (size_t)(b * 128 + (t - 1920)) * 128;
        } else {
          int ms = m - TP, b = ms >> 4, t = ms & 15;
          vt = (u16*)(ws + W_VTS) + (size_t)b * 128 * 192 + 128 + t;
          vstride = 192;
          fdst = p.out + O_VS + (size_t)(b * 128 + 112 + t) * 128;
        }
#pragma unroll
        for (int i = 0; i < 2; ++i)
#pragma unroll
          for (int g = 0; g < 4; ++g) {
            int ch = ch0 + i * 32 + 8 * g + 4 * h;
            float v0 = acc[i][j][4 * g] * fscale[j], v1 = acc[i][j][4 * g + 1] * fscale[j],
                  v2 = acc[i][j][4 * g + 2] * fscale[j], v3 = acc[i][j][4 * g + 3] * fscale[j];
            unsigned p01 = pk2(v0, v1), p23 = pk2(v2, v3);
            vt[(size_t)(ch + 0) * vstride] = (u16)(p01 & 0xffffu);
            vt[(size_t)(ch + 1) * vstride] = (u16)(p01 >> 16);
            vt[(size_t)(ch + 2) * vstride] = (u16)(p23 & 0xffffu);
            vt[(size_t)(ch + 3) * vstride] = (u16)(p23 >> 16);
            if (fdst) *(float4*)(fdst + ch) = make_float4(v0, v1, v2, v3);
          }
      }
    }
    if (nt < 13) {
      __syncthreads();
#pragma unroll
      for (int it = 0; it < 8; ++it) {
        const int c = tid + 256 * it, rl = c >> 4, cc = c & 15;
        const int m = mt * 128 + rl;
        const u32x4 vrow = *(const u32x4*)(Tb + rl * 136 + cc * 8);
        unsigned off;
        if (nt < 4) off = (unsigned)(W_U + (m * 512 + nt * 128 + cc * 8) * 2);
        else if (nt < 8) off = (unsigned)(W_GG + (m * 512 + (nt - 4) * 128 + cc * 8) * 2);
        else if (nt < 12) off = (unsigned)(W_Q + (m * 512 + (nt - 8) * 128 + cc * 8) * 2);
        else if (m < TP) off = (unsigned)(W_KP + (m * 128 + cc * 8) * 2);
        else { const int ms = m - TP; off = (unsigned)(W_KS + (((ms >> 4) * 192 + 128 + (ms & 15)) * 128 + cc * 8) * 2); }
        *(u32x4*)(ws + off) = vrow;
      }
    }
  } else if (MODE == 2) {
    float* T = (float*)smem;
    __syncthreads();
#pragma unroll
    for (int j = 0; j < 2; ++j) {
      const int rl = wm * 64 + j * 32 + tl;
#pragma unroll
      for (int i = 0; i < 2; ++i)
#pragma unroll
        for (int g = 0; g < 4; ++g) {
          const int col = wn * 64 + i * 32 + 8 * g + 4 * h;
          f32x4 v;
          v[0] = acc[i][j][4 * g] * fscale[j]; v[1] = acc[i][j][4 * g + 1] * fscale[j];
          v[2] = acc[i][j][4 * g + 2] * fscale[j]; v[3] = acc[i][j][4 * g + 3] * fscale[j];
          *(f32x4*)(T + rl * 132 + col) = v;
        }
    }
    __syncthreads();
    const char* xbb = (mt < 128) ? ws + W_XB : ws + W_XBS - (size_t)TP * 2048;
#pragma unroll 4
    for (int it = 0; it < 16; ++it) {
      const int c = tid + 256 * it, rl = c >> 5, cc = c & 31;
      const int m = mt * 128 + rl, n = nt * 128 + cc * 4;
      const f32x4 t = *(const f32x4*)(T + rl * 132 + cc * 4);
      const uint2 xq = *(const uint2*)(xbb + (unsigned)((m * 1024 + n) * 2));
      f32x4 y;
      y[0] = bf_lo(xq.x) + t[0]; y[1] = bf_hi(xq.x) + t[1]; y[2] = bf_lo(xq.y) + t[2]; y[3] = bf_hi(xq.y) + t[3];
      *(uint2*)(ws + (unsigned)(W_HB + (m * 1024 + n) * 2)) = make_uint2(pk2(y[0], y[1]), pk2(y[2], y[3]));
      float ss = y[0] * y[0] + y[1] * y[1] + y[2] * y[2] + y[3] * y[3];
      ss += __uint_as_float(__builtin_amdgcn_update_dpp(0u, __float_as_uint(ss), 0x111, 0xF, 0xF, false));
      ss += __uint_as_float(__builtin_amdgcn_update_dpp(0u, __float_as_uint(ss), 0x112, 0xF, 0xF, false));
      ss += __uint_as_float(__builtin_amdgcn_update_dpp(0u, __float_as_uint(ss), 0x114, 0xF, 0xF, false));
      ss += __uint_as_float(__builtin_amdgcn_update_dpp(0u, __float_as_uint(ss), 0x118, 0xF, 0xF, false));
      if ((lane & 15) == 15) *(float*)(ws + (unsigned)(W_SSQ2 + (m * 16 + nt * 2 + (cc >> 4)) * 4)) = ss;
    }
  } else {
    unsigned* Lx = (unsigned*)smem;
    __syncthreads();
#pragma unroll
    for (int j = 0; j < 2; ++j) {
      if (nt == 0 && wn == 0 && h == 0) ((float*)(ws + W_RS2))[m_lane[j]] = fscale[j];
      unsigned top[16], tmp[16];
#pragma unroll
      for (int r = 0; r < 16; ++r) top[r] = (f2ord(acc[0][j][r] * fscale[j]) & ~127u) | (unsigned)(127 - (wn * 64 + crow(r, h)));
      sort16_desc(top);
#pragma unroll
      for (int r = 0; r < 16; ++r) tmp[r] = (f2ord(acc[1][j][r] * fscale[j]) & ~127u) | (unsigned)(127 - (wn * 64 + 32 + crow(r, h)));
      sort16_desc(tmp);
      merge_top16(top, tmp);
      u32x4* d4 = (u32x4*)(Lx + (((wn * 2 + h) * 4 + wm * 2 + j) * 32 + tl) * 16);
#pragma unroll
      for (int q = 0; q < 4; ++q) { u32x4 v4; v4[0] = top[4 * q]; v4[1] = top[4 * q + 1]; v4[2] = top[4 * q + 2]; v4[3] = top[4 * q + 3]; d4[q] = v4; }
    }
    __syncthreads();
    if (tid < 128) {
      const int u = tid >> 5, t2 = tid & 31;
      unsigned top[16], tmp[16];
#pragma unroll
      for (int li = 0; li < 4; ++li) {
        const u32x4* s4 = (const u32x4*)(Lx + ((li * 4 + u) * 32 + t2) * 16);
#pragma unroll
        for (int q = 0; q < 4; ++q) {
          const u32x4 x0 = s4[q];
          if (li == 0) { top[4 * q] = x0[0]; top[4 * q + 1] = x0[1]; top[4 * q + 2] = x0[2]; top[4 * q + 3] = x0[3]; }
          else { tmp[4 * q] = x0[0]; tmp[4 * q + 1] = x0[1]; tmp[4 * q + 2] = x0[2]; tmp[4 * q + 3] = x0[3]; }
        }
        if (li > 0) merge_top16(top, tmp);
      }
      const int mrow = mt * 128 + u * 32 + t2;
      u32x4* g4 = (u32x4*)(ws + (unsigned)(W_TOPL + ((mrow * 16 + nt) * 16) * 4));
#pragma unroll
      for (int q = 0; q < 4; ++q) { u32x4 v4; v4[0] = top[4 * q]; v4[1] = top[4 * q + 1]; v4[2] = top[4 * q + 2]; v4[3] = top[4 * q + 3]; g4[q] = v4; }
    }
  }
}

#define SCAN_STEP(CTRL) { \
    const float Ap = __uint_as_float(__builtin_amdgcn_update_dpp(0x3f800000u, __float_as_uint(A), CTRL, 0xF, 0xF, false)); \
    const float Hp = __uint_as_float(__builtin_amdgcn_update_dpp(0u, __float_as_uint(H), CTRL, 0xF, 0xF, false)); \
    H = A * Hp + H; A = A * Ap; }
template <int FINAL>
DI void lru_item(const Params& p, int item, char* smem) {
  char* ws = p.ws;
  const bool samp = item >= 512;
  int b, c, m0, nvalid;
  if (!samp) { b = item >> 6; c = item & 63; m0 = b * 2048 + c * 32; nvalid = 32; }
  else { b = item - 512; c = 0; m0 = TP + b * 16; nvalid = 16; }
  const int tid = otid(), lane = tid & 63, w = tid >> 6, tl = lane & 31, h = lane >> 5;
  u16* XC = (u16*)smem;
  float* hin = (float*)(smem + 32 * 1040);
  __syncthreads();
  {
    const int ch = 2 * tid;
    const float2 w0 = *(const float2*)(p.conv_w + ch), w1 = *(const float2*)(p.conv_w + 512 + ch),
                 w2 = *(const float2*)(p.conv_w + 1024 + ch), w3 = *(const float2*)(p.conv_w + 1536 + ch),
                 cb = *(const float2*)(p.conv_b + ch);
    float2 r0 = {0.f, 0.f}, r1 = {0.f, 0.f}, r2 = {0.f, 0.f};
    const u16* ub = (const u16*)(ws + W_U);
    if (!samp) {
      if (c > 0) {
        unsigned a0 = *(const unsigned*)(ub + (size_t)(m0 - 3) * 512 + ch), a1 = *(const unsigned*)(ub + (size_t)(m0 - 2) * 512 + ch),
                 a2 = *(const unsigned*)(ub + (size_t)(m0 - 1) * 512 + ch);
        r0 = {bf_lo(a0), bf_hi(a0)}; r1 = {bf_lo(a1), bf_hi(a1)}; r2 = {bf_lo(a2), bf_hi(a2)};
      }
    } else {
      const float* sc = p.state_conv + (size_t)b * 3 * 512 + ch;
      r0 = *(const float2*)(sc); r1 = *(const float2*)(sc + 512); r2 = *(const float2*)(sc + 1024);
    }
    unsigned uraw[32];
#pragma unroll
    for (int t = 0; t < 32; ++t) uraw[t] = (t < nvalid) ? *(const unsigned*)(ub + (size_t)(m0 + t) * 512 + ch) : 0u;
#pragma unroll
    for (int t = 0; t < 32; ++t) {
      float2 cur = {bf_lo(uraw[t]), bf_hi(uraw[t])};
      float x0 = cb.x + w0.x * r0.x + w1.x * r1.x + w2.x * r2.x + w3.x * cur.x;
      float x1 = cb.y + w0.y * r0.y + w1.y * r1.y + w2.y * r2.y + w3.y * cur.y;
      *(unsigned*)(XC + t * 520 + ch) = pk2(x0, x1);
      r0 = r1; r1 = r2; r2 = cur;
    }
    if (FINAL) {
      u16* G = (u16*)(smem + 35328);
      u32x4 gr[8];
#pragma unroll
      for (int it = 0; it < 8; ++it) {
        const int cidx = tid + 256 * it, rl = cidx >> 6, cc = cidx & 63;
        if (rl < nvalid) gr[it] = *(const u32x4*)(ws + (unsigned)(W_GG + ((m0 + rl) * 512 + cc * 8) * 2));
      }
#pragma unroll
      for (int it = 0; it < 8; ++it) {
        const int cidx = tid + 256 * it, rl = cidx >> 6, cc = cidx & 63;
        if (rl < nvalid) *(u32x4*)(G + rl * 520 + cc * 8) = gr[it];
      }
    }
    if (FINAL) {
      float2 hh;
      if (samp) hh = *(const float2*)(p.state_lru + (size_t)b * 512 + ch);
      else {
        hh = {0.f, 0.f};
        const float* sA = (const float*)(ws + W_SUMA) + (size_t)(b * 64) * 512 + ch;
        const float* sH = (const float*)(ws + W_SUMH) + (size_t)(b * 64) * 512 + ch;
        int cc = 0;
        for (; cc + 16 <= c; cc += 16) {
          float2 Av[16], Hv[16];
#pragma unroll
          for (int u = 0; u < 16; ++u) { Av[u] = *(const float2*)(sA + (size_t)(cc + u) * 512); Hv[u] = *(const float2*)(sH + (size_t)(cc + u) * 512); }
#pragma unroll
          for (int u = 0; u < 16; ++u) { hh.x = Av[u].x * hh.x + Hv[u].x; hh.y = Av[u].y * hh.y + Hv[u].y; }
        }
        for (; cc + 4 <= c; cc += 4) {
          float2 Av[4], Hv[4];
#pragma unroll
          for (int u = 0; u < 4; ++u) { Av[u] = *(const float2*)(sA + (size_t)(cc + u) * 512); Hv[u] = *(const float2*)(sH + (size_t)(cc + u) * 512); }
#pragma unroll
          for (int u = 0; u < 4; ++u) { hh.x = Av[u].x * hh.x + Hv[u].x; hh.y = Av[u].y * hh.y + Hv[u].y; }
        }
        for (; cc < c; ++cc) {
          float2 A0 = *(const float2*)(sA + (size_t)cc * 512), H0 = *(const float2*)(sH + (size_t)cc * 512);
          hh.x = A0.x * hh.x + H0.x; hh.y = A0.y * hh.y + H0.y;
        }
      }
      hin[ch] = hh.x; hin[ch + 1] = hh.y;
    }
  }
  __syncthreads();
  const u16* WaT = (const u16*)(ws + W_WAT);
  const u16* WiT = (const u16*)(ws + W_WIT);
  const float* c8 = (const float*)(ws + W_C8);
  const int m = m0 + tl;
  const bool valid = tl < nvalid;
  float ssq = 0.f;
#pragma unroll 1
  for (int nbk = 0; nbk < 2; ++nbk) {
    const int n = 2 * w + nbk;
    f32x16 accA[2], accI[2];
#pragma unroll
    for (int i = 0; i < 2; ++i)
#pragma unroll
      for (int r = 0; r < 16; ++r) { accA[i][r] = 0.f; accI[i][r] = 0.f; }
#pragma unroll
    for (int kk = 0; kk < 4; ++kk) {
      const bf16x8 bx = *(const bf16x8*)((const char*)XC + tl * 1040 + (n * 64 + kk * 16 + h * 8) * 2);
#pragma unroll
      for (int i = 0; i < 2; ++i) {
        const bf16x8 aa = *(const bf16x8*)(WaT + (unsigned)((((n * 2 + i) * 4 + kk) * 64 + lane) * 8));
        const bf16x8 ai = *(const bf16x8*)(WiT + (unsigned)((((n * 2 + i) * 4 + kk) * 64 + lane) * 8));
        accA[i] = MFMA32(aa, bx, accA[i]);
        accI[i] = MFMA32(ai, bx, accI[i]);
      }
    }
#pragma unroll
    for (int i = 0; i < 2; ++i)
#pragma unroll
      for (int g = 0; g < 4; ++g) {
        const int ch = n * 64 + i * 32 + 8 * g + 4 * h;
        const float4 ba4 = *(const float4*)(p.lru_ba + ch), bi4 = *(const float4*)(p.lru_bi + ch), c84 = *(const float4*)(c8 + ch);
        const float bav[4] = {ba4.x, ba4.y, ba4.z, ba4.w}, biv[4] = {bi4.x, bi4.y, bi4.z, bi4.w}, c8v[4] = {c84.x, c84.y, c84.z, c84.w};
        const uint2 xcp = *(const uint2*)(XC + tl * 520 + ch);
        const float xcv[4] = {bf_lo(xcp.x), bf_hi(xcp.x), bf_lo(xcp.y), bf_hi(xcp.y)};
        float hv[4];
        float A4[4], H4[4];
#pragma unroll
        for (int q = 0; q < 4; ++q) {
          const int r = 4 * g + q;
          float rr = sigmoidf_(accA[i][r] + bav[q]);
          float ii = sigmoidf_(accI[i][r] + biv[q]);
          float la = c8v[q] * rr;
          A4[q] = __expf(la);
          float x2 = 2.0f * la;
          float em = -x2 * (1.0f + x2 * (0.5f + x2 * (0.16666667f + x2 * (0.041666668f + x2 * (0.0083333333f + x2 * 0.0013888889f)))));
          H4[q] = __builtin_amdgcn_sqrtf(fmaxf(em, 0.f)) * ii * xcv[q];
        }
#define SCAN4(CTRL) \
        asm volatile("s_nop 1\n\t" \
            "v_fmac_f32_dpp %0, %0, %4 " CTRL "\n\tv_mul_f32_dpp %4, %4, %4 " CTRL "\n\t" \
            "v_fmac_f32_dpp %1, %1, %5 " CTRL "\n\tv_mul_f32_dpp %5, %5, %5 " CTRL "\n\t" \
            "v_fmac_f32_dpp %2, %2, %6 " CTRL "\n\tv_mul_f32_dpp %6, %6, %6 " CTRL "\n\t" \
            "v_fmac_f32_dpp %3, %3, %7 " CTRL "\n\tv_mul_f32_dpp %7, %7, %7 " CTRL "\n\t" \
            : "+v"(H4[0]), "+v"(H4[1]), "+v"(H4[2]), "+v"(H4[3]), "+v"(A4[0]), "+v"(A4[1]), "+v"(A4[2]), "+v"(A4[3]));
        SCAN4("row_shr:1 row_mask:0xf bank_mask:0xf")
        SCAN4("row_shr:2 row_mask:0xf bank_mask:0xf")
        SCAN4("row_shr:4 row_mask:0xf bank_mask:0xf")
        SCAN4("row_shr:8 row_mask:0xf bank_mask:0xf")
        SCAN4("row_bcast:15 row_mask:0xa bank_mask:0xf")
        asm volatile("s_nop 1" ::: "memory");
#pragma unroll
        for (int q = 0; q < 4; ++q) {
          const float A = A4[q], H = H4[q];
          if (!FINAL) {
            if (tl == 31) { ((float*)(smem + 35328))[ch + q] = A; ((float*)(smem + 35328))[512 + ch + q] = H; }
          } else {
            hv[q] = H + A * hin[ch + q];
          }
        }
        if (FINAL) {
          if (tl == nvalid - 1 && (samp || c == 63)) {
            float* dst = p.out + (samp ? O_LRUS : O_LRUP) + (size_t)b * 512 + ch;
            *(float4*)dst = make_float4(hv[0], hv[1], hv[2], hv[3]);
          }
          if (valid) {
            u16* G = (u16*)(smem + 35328);
            const uint2 gp = *(const uint2*)(G + tl * 520 + ch);
            float o0 = hv[0] * bf_lo(gp.x), o1 = hv[1] * bf_hi(gp.x), o2 = hv[2] * bf_lo(gp.y), o3 = hv[3] * bf_hi(gp.y);
            ssq += o0 * o0 + o1 * o1 + o2 * o2 + o3 * o3;
            *(uint2*)(G + tl * 520 + ch) = make_uint2(pk2(o0, o1), pk2(o2, o3));
          }
        }
      }
  }
  if (!FINAL) {
    __syncthreads();
    const float* S = (const float*)(smem + 35328);
    *(float2*)((float*)(ws + W_SUMA) + (size_t)(b * 64 + c) * 512 + 2 * tid) = *(const float2*)(S + 2 * tid);
    *(float2*)((float*)(ws + W_SUMH) + (size_t)(b * 64 + c) * 512 + 2 * tid) = *(const float2*)(S + 512 + 2 * tid);
  }
  if (FINAL) {
    ssq += __shfl_xor(ssq, 32);
    if (valid && h == 0) ((float*)(ws + W_SSQL))[(size_t)m * 4 + w] = ssq;
    __syncthreads();
    const u16* G = (const u16*)(smem + 35328);
#pragma unroll
    for (int it = 0; it < 8; ++it) {
      const int cidx = tid + 256 * it, rl = cidx >> 6, cc = cidx & 63;
      if (rl < nvalid) *(u32x4*)(ws + (unsigned)(W_CAT + ((m0 + rl) * 1024 + cc * 8) * 2)) = *(const u32x4*)(G + rl * 520 + cc * 8);
    }
  }
}

DI void attn_item(const Params& p, int item, char* smem) {
  char* ws = p.ws;
  const int tid = otid(), lane = tid & 63, w = tid >> 6, tl = lane & 31, h = lane >> 5;
  const bool samp = item >= 512;
  int b, c, g;
  const u16* Kb; const u16* Vt; int vstride, kc_lo, kc_hi, nkeys, mq0; bool qvalid;
  if (!samp) {
    b = item >> 6; c = (item >> 1) & 31; g = item & 1;
    Kb = (const u16*)(ws + W_KP) + (size_t)b * 2048 * 128;
    Vt = (const u16*)(ws + W_VTP) + (size_t)b * 128 * 2048;
    vstride = 2048; kc_lo = (c >= 2) ? c - 2 : 0; kc_hi = c; nkeys = 1 << 30;
    mq0 = b * 2048 + c * 64 + tl; qvalid = true;
  } else {
    int it = item - 512; b = it >> 1; g = it & 1; c = 0;
    Kb = (const u16*)(ws + W_KS) + (size_t)b * 192 * 128;
    Vt = (const u16*)(ws + W_VTS) + (size_t)b * 128 * 192;
    vstride = 192; kc_lo = 0; kc_hi = 2; nkeys = 144;
    mq0 = TP + b * 16 + (tl & 15); qvalid = tl < 16;
  }
  const int hq = g * 4 + w;
  const float sink = p.sinks[hq];
  char* sK = smem;
  char* sV = smem + 192 * 144;
  const int nch = kc_hi - kc_lo + 1;
  const int nj = samp ? 1 : 2;
  bf16x8 bq[2][4];
#pragma unroll
  for (int j = 0; j < 2; ++j)
#pragma unroll
    for (int kk = 0; kk < 4; ++kk)
      bq[j][kk] = *(const bf16x8*)((const u16*)(ws + W_Q) + (size_t)(mq0 + (samp ? 0 : j * 32)) * 512 + hq * 64 + kk * 16 + h * 8);
  __syncthreads();
  {
    u32x4 kr[6], vr[6];
#pragma unroll
    for (int i = 0; i < 6; ++i) {
      const int idx = tid + 256 * i;
      const int key = idx >> 3, part = idx & 7;
      if (key < nch * 64) kr[i] = *(const u32x4*)(Kb + (size_t)(kc_lo * 64 + key) * 128 + g * 64 + part * 8);
      const int d = idx / 24, pv = idx % 24;
      if (pv < nch * 8) vr[i] = *(const u32x4*)(Vt + (size_t)(g * 64 + d) * vstride + kc_lo * 64 + pv * 8);
    }
#pragma unroll
    for (int i = 0; i < 6; ++i) {
      const int idx = tid + 256 * i;
      const int key = idx >> 3, part = idx & 7;
      if (key < nch * 64) *(u32x4*)(sK + key * 144 + part * 16) = kr[i];
      const int d = idx / 24, pv = idx % 24;
      if (pv < nch * 8) *(u32x4*)(sV + d * 400 + pv * 16) = vr[i];
    }
  }
  __syncthreads();
#pragma unroll
  for (int j = 0; j < 2; ++j) {
    if (j < nj) {
    const int mqj = mq0 + j * 32;
    float mrun = sink, lrun = 1.f;
    f32x16 O[2];
#pragma unroll
    for (int i = 0; i < 2; ++i)
#pragma unroll
      for (int r = 0; r < 16; ++r) O[i][r] = 0.f;
#pragma unroll 1
    for (int kc = 0; kc < nch; ++kc) {
      f32x16 S[2];
#pragma unroll
      for (int i = 0; i < 2; ++i)
#pragma unroll
        for (int r = 0; r < 16; ++r) S[i][r] = 0.f;
#pragma unroll
      for (int kk = 0; kk < 4; ++kk)
#pragma unroll
        for (int kt = 0; kt < 2; ++kt) {
          const bf16x8 ak = *(const bf16x8*)(sK + (kc * 64 + kt * 32 + tl) * 144 + kk * 32 + h * 16);
          S[kt] = MFMA32(ak, bq[j][kk], S[kt]);
        }
      if (samp) {
#pragma unroll
        for (int kt = 0; kt < 2; ++kt)
#pragma unroll
          for (int r = 0; r < 16; ++r) {
            int key = kc * 64 + kt * 32 + crow(r, h);
            if (key >= nkeys) S[kt][r] = -INFINITY;
          }
      }
      {
        float mx = -INFINITY;
#pragma unroll
        for (int kt = 0; kt < 2; ++kt)
#pragma unroll
          for (int r = 0; r < 16; ++r) mx = fmaxf(mx, S[kt][r]);
        mx = fmaxf(mx, __shfl_xor(mx, 32));
        const float mnew = fmaxf(mrun, mx);
        const float alpha = __expf(mrun - mnew);
        float ps = 0.f;
#pragma unroll
        for (int kt = 0; kt < 2; ++kt)
#pragma unroll
          for (int r = 0; r < 16; ++r) {
            float pv = __expf(S[kt][r] - mnew);
            S[kt][r] = pv;
            ps += pv;
          }
        ps += __shfl_xor(ps, 32);
        lrun = lrun * alpha + ps;
        mrun = mnew;
#pragma unroll
        for (int dt = 0; dt < 2; ++dt)
#pragma unroll
          for (int r = 0; r < 16; ++r) O[dt][r] *= alpha;
      }
#pragma unroll
      for (int kt = 0; kt < 2; ++kt)
#pragma unroll
        for (int s2 = 0; s2 < 2; ++s2) {
          u32x4 pp;
          pp[0] = pk2(S[kt][8 * s2 + 0], S[kt][8 * s2 + 1]);
          pp[1] = pk2(S[kt][8 * s2 + 2], S[kt][8 * s2 + 3]);
          pp[2] = pk2(S[kt][8 * s2 + 4], S[kt][8 * s2 + 5]);
          pp[3] = pk2(S[kt][8 * s2 + 6], S[kt][8 * s2 + 7]);
          const bf16x8 bp = __builtin_bit_cast(bf16x8, pp);
#pragma unroll
          for (int dt = 0; dt < 2; ++dt) {
            const int d = dt * 32 + tl;
            const uint2 lo = *(const uint2*)(sV + d * 400 + (kc * 64 + kt * 32 + 16 * s2 + 4 * h) * 2);
            const uint2 hi = *(const uint2*)(sV + d * 400 + (kc * 64 + kt * 32 + 16 * s2 + 8 + 4 * h) * 2);
            u32x4 av4;
            av4[0] = lo.x; av4[1] = lo.y; av4[2] = hi.x; av4[3] = hi.y;
            O[dt] = MFMA32(__builtin_bit_cast(bf16x8, av4), bp, O[dt]);
          }
        }
    }
    const float inv = 1.0f / lrun;
    float ss = 0.f;
    u16* To = (u16*)(smem + 53248);
#pragma unroll
    for (int dt = 0; dt < 2; ++dt)
#pragma unroll
      for (int g4 = 0; g4 < 4; ++g4) {
        int d = dt * 32 + 8 * g4 + 4 * h;
        float v0 = O[dt][4 * g4] * inv, v1 = O[dt][4 * g4 + 1] * inv, v2 = O[dt][4 * g4 + 2] * inv, v3 = O[dt][4 * g4 + 3] * inv;
        ss += v0 * v0 + v1 * v1 + v2 * v2 + v3 * v3;
        *(uint2*)(To + tl * 264 + w * 64 + d) = make_uint2(pk2(v0, v1), pk2(v2, v3));
      }
    ss += __shfl_xor(ss, 32);
    if (qvalid && h == 0) ((float*)(ws + W_SSQA))[(size_t)mqj * 8 + hq] = ss;
    __syncthreads();
    {
      const int mrow0 = samp ? (TP + b * 16) : (b * 2048 + c * 64 + j * 32);
#pragma unroll
      for (int it = 0; it < 4; ++it) {
        const int cidx = tid + 256 * it, rl = cidx >> 5, cc = cidx & 31;
        if (!samp || rl < 16)
          *(u32x4*)(ws + (unsigned)(W_CAT + ((mrow0 + rl) * 1024 + 512 + g * 256 + cc * 8) * 2)) = *(const u32x4*)(To + rl * 264 + cc * 8);
      }
    }
    __syncthreads();
    }
  }
}

struct CandTab { int i[64]; int j[64]; int n; };
constexpr CandTab make_tab() {
  CandTab t{};
  int n = 0;
  for (int i = 0; i < 16; ++i)
    for (int j = 0; j < 16; ++j)
      if ((i + 1) * (j + 1) <= 16) { t.i[n] = i; t.j[n] = j; ++n; }
  t.n = n;
  return t;
}

DI void route2(const Params& p, char* smem) {
  char* ws = p.ws;
  constexpr CandTab CT = make_tab();
  const int tid = otid();
  unsigned* Lp = (unsigned*)smem + tid * 33;
  for (int base = blockIdx.x * 256; base < TT * 8; base += gridDim.x * 256) {
    const int it = base + tid;
    const int mm = it >> 3, hd = it & 7;
    unsigned l1[16], l2[16];
    {
      const u32x4* s1 = (const u32x4*)((const unsigned*)(ws + W_TOPL) + ((size_t)mm * 16 + hd * 2) * 16);
#pragma unroll
      for (int q = 0; q < 4; ++q) {
        const u32x4 a = s1[q], b = s1[4 + q];
        l1[4 * q] = a[0]; l1[4 * q + 1] = a[1]; l1[4 * q + 2] = a[2]; l1[4 * q + 3] = a[3];
        l2[4 * q] = b[0]; l2[4 * q + 1] = b[1]; l2[4 * q + 2] = b[2]; l2[4 * q + 3] = b[3];
      }
    }
#pragma unroll
    for (int i = 0; i < 16; ++i) { Lp[i] = l1[i]; Lp[16 + i] = l2[i]; }
    float f1[16], f2[16];
#pragma unroll
    for (int i = 0; i < 16; ++i) { f1[i] = ord2f(l1[i] & ~127u); f2[i] = ord2f(l2[i] & ~127u); }
    unsigned top[16], tmp[16];
#pragma unroll
    for (int grp = 0; grp < 4; ++grp) {
#pragma unroll
      for (int q = 0; q < 16; ++q) {
        const int cidx = grp * 16 + q;
        unsigned key = 0;
        if (cidx < CT.n) {
          const int ci = CT.i[cidx], cj = CT.j[cidx];
          key = (f2ord(f1[ci] + f2[cj]) & ~255u) | (unsigned)(255 - (ci * 16 + cj));
        }
        if (grp == 0) top[q] = key; else tmp[q] = key;
      }
      if (grp == 0) sort16_desc(top);
      else { sort16_desc(tmp); merge_top16(top, tmp); }
    }
    float sv[16]; int ex[16];
    float smax = -INFINITY;
#pragma unroll
    for (int q = 0; q < 16; ++q) {
      const int code = 255 - (int)(top[q] & 255u);
      const int ci = code >> 4, cj = code & 15;
      const unsigned a = Lp[ci], bb = Lp[16 + cj];
      const int i1 = 127 - (int)(a & 127u), i2 = 127 - (int)(bb & 127u);
      sv[q] = ord2f(a & ~127u) + ord2f(bb & ~127u);
      ex[q] = i1 * 128 + i2;
      smax = fmaxf(smax, sv[q]);
    }
    float sum = 0.f;
#pragma unroll
    for (int q = 0; q < 16; ++q) { sv[q] = __expf(sv[q] - smax); sum += sv[q]; }
    const float inv = 1.0f / sum;
    int4* di = (int4*)((int*)(ws + W_SIDX) + (size_t)mm * 128 + hd * 16);
    float4* dg = (float4*)((float*)(ws + W_SGATE) + (size_t)mm * 128 + hd * 16);
#pragma unroll
    for (int q = 0; q < 4; ++q) {
      di[q] = make_int4(ex[4 * q], ex[4 * q + 1], ex[4 * q + 2], ex[4 * q + 3]);
      dg[q] = make_float4(sv[4 * q] * inv, sv[4 * q + 1] * inv, sv[4 * q + 2] * inv, sv[4 * q + 3] * inv);
    }
  }
}

DI void peer_u_phase(const Params& p) {
  char* ws = p.ws;
  const int tid_ = otid(); const int lane = tid_ & 63, w = tid_ >> 6, g = lane >> 3, li = lane & 7;
  const int v = blockIdx.x & 7, bx = blockIdx.x >> 3, nbx = (gridDim.x - v + 7) >> 3;
  const int gwx = bx * 4 + w, nwx = nbx * 4;
  const char* Us = ws + W_UB + (size_t)v * 16384 * 128;
  const unsigned loff = li * 16;
  const int* sidx = (const int*)(ws + W_SIDX) + g * 16;
  int4 ix[4];
  u32x4 hq0, hq1;
  int m = gwx;
  if (m < TT) {
#pragma unroll
    for (int q = 0; q < 4; ++q) ix[q] = ((const int4*)(sidx + (size_t)m * 128))[q];
    const u32x4* hp = (const u32x4*)(ws + W_HB + (size_t)m * 2048 + v * 256 + li * 32);
    hq0 = hp[0]; hq1 = hp[1];
  }
  for (; m < TT; m += nwx) {
    const int idx[16] = {ix[0].x, ix[0].y, ix[0].z, ix[0].w, ix[1].x, ix[1].y, ix[1].z, ix[1].w,
                         ix[2].x, ix[2].y, ix[2].z, ix[2].w, ix[3].x, ix[3].y, ix[3].z, ix[3].w};
    u32x4 rows[16];
#pragma unroll
    for (int s2 = 0; s2 < 16; ++s2) rows[s2] = *(const u32x4*)(Us + (((unsigned)idx[s2] << 7) + loff));
    fl2_t hv[8];
    hv[0] = {bf_lo(hq0[0]), bf_hi(hq0[0])}; hv[1] = {bf_lo(hq0[1]), bf_hi(hq0[1])};
    hv[2] = {bf_lo(hq0[2]), bf_hi(hq0[2])}; hv[3] = {bf_lo(hq0[3]), bf_hi(hq0[3])};
    hv[4] = {bf_lo(hq1[0]), bf_hi(hq1[0])}; hv[5] = {bf_lo(hq1[1]), bf_hi(hq1[1])};
    hv[6] = {bf_lo(hq1[2]), bf_hi(hq1[2])}; hv[7] = {bf_lo(hq1[3]), bf_hi(hq1[3])};
    const int mn = (m + nwx < TT) ? m + nwx : TT - 1;
    {
#pragma unroll
      for (int q = 0; q < 4; ++q) ix[q] = ((const int4*)(sidx + (size_t)mn * 128))[q];
      const u32x4* hp = (const u32x4*)(ws + W_HB + (size_t)mn * 2048 + v * 256 + li * 32);
      hq0 = hp[0]; hq1 = hp[1];
    }
    float ps[16];
#pragma unroll
    for (int s2 = 0; s2 < 16; ++s2) {
      fl2_t acc = {0.f, 0.f};
#pragma unroll
      for (int d = 0; d < 4; ++d) {
        const fl2_t lo = __builtin_amdgcn_cvt_pk_f32_fp8((int)rows[s2][d], false);
        const fl2_t hi = __builtin_amdgcn_cvt_pk_f32_fp8((int)rows[s2][d], true);
        acc = __builtin_elementwise_fma(lo, hv[2 * d], acc);
        acc = __builtin_elementwise_fma(hi, hv[2 * d + 1], acc);
      }
      ps[s2] = acc.x + acc.y;
    }
#pragma unroll
    for (int st = 0; st < 3; ++st) {
      const int bit = 4 >> st, half = 8 >> st;
      const bool upper = (li & bit) != 0;
#pragma unroll
      for (int i = 0; i < half; ++i) {
        const float send = upper ? ps[i] : ps[i + half];
        const float keep = upper ? ps[i + half] : ps[i];
        ps[i] = keep + __shfl_xor(send, bit);
      }
    }
    const int sl = ((li >> 2) & 1) * 8 + ((li >> 1) & 1) * 4 + (li & 1) * 2;
    *(unsigned*)((u16*)(ws + W_PART) + ((size_t)m * 8 + v) * 128 + g * 16 + sl) = pk2(ps[0], ps[1]);
  }
}

DI void peer_combine(const Params& p) {
  char* ws = p.ws;
  const size_t gt = (size_t)blockIdx.x * 256 + otid(), gstride = (size_t)gridDim.x * 256;
  for (size_t i = gt; i < (size_t)TT * 16; i += gstride) {
    const size_t m = i >> 4, s8 = (i & 15) * 8;
    const u16* pp = (const u16*)(ws + W_PART) + m * 1024 + s8;
    float d[8] = {0.f, 0.f, 0.f, 0.f, 0.f, 0.f, 0.f, 0.f};
#pragma unroll
    for (int v = 0; v < 8; ++v) {
      const u32x4 q = *(const u32x4*)(pp + v * 128);
#pragma unroll
      for (int k = 0; k < 4; ++k) { d[2 * k] += bf_lo(q[k]); d[2 * k + 1] += bf_hi(q[k]); }
    }
    const float sc = ((const float*)(ws + W_RS2))[m] * (1.0f / USCALE);
    const f32x4* gp = (const f32x4*)((const float*)(ws + W_SGATE) + m * 128 + s8);
    const f32x4 g0 = gp[0], g1 = gp[1];
    f32x4 o0, o1;
#pragma unroll
    for (int k = 0; k < 4; ++k) {
      o0[k] = gelu_(d[k] * sc) * g0[k] * (1.0f / VSCALE);
      o1[k] = gelu_(d[4 + k] * sc) * g1[k] * (1.0f / VSCALE);
    }
    f32x4* op = (f32x4*)((float*)(ws + W_WTS) + m * 128 + s8);
    op[0] = o0; op[1] = o1;
  }
}

DI void peer_v_phase(const Params& p) {
  char* ws = p.ws;
  const int tid_ = otid(); const int lane = tid_ & 63, w = tid_ >> 6, g = lane >> 3, li = lane & 7;
  const int v = blockIdx.x & 7, bx = blockIdx.x >> 3, nbx = (gridDim.x - v + 7) >> 3;
  const int gwx = bx * 4 + w, nwx = nbx * 4;
  const char* Vs = ws + W_VB + (size_t)v * 16384 * 128;
  const unsigned loff = li * 16;
  const int* sidx = (const int*)(ws + W_SIDX) + g * 16;
  const float* wts = (const float*)(ws + W_WTS) + g * 16;
  int4 ix[4];
  float4 wx[4];
  int m = gwx;
  if (m < TT) {
#pragma unroll
    for (int q = 0; q < 4; ++q) { ix[q] = ((const int4*)(sidx + (size_t)m * 128))[q]; wx[q] = ((const float4*)(wts + (size_t)m * 128))[q]; }
  }
  for (; m < TT; m += nwx) {
    const int idx[16] = {ix[0].x, ix[0].y, ix[0].z, ix[0].w, ix[1].x, ix[1].y, ix[1].z, ix[1].w,
                         ix[2].x, ix[2].y, ix[2].z, ix[2].w, ix[3].x, ix[3].y, ix[3].z, ix[3].w};
    const float wt[16] = {wx[0].x, wx[0].y, wx[0].z, wx[0].w, wx[1].x, wx[1].y, wx[1].z, wx[1].w,
                          wx[2].x, wx[2].y, wx[2].z, wx[2].w, wx[3].x, wx[3].y, wx[3].z, wx[3].w};
    u32x4 rows[16];
#pragma unroll
    for (int s2 = 0; s2 < 16; ++s2) rows[s2] = *(const u32x4*)(Vs + (((unsigned)idx[s2] << 7) + loff));
    const int mn = (m + nwx < TT) ? m + nwx : TT - 1;
    {
#pragma unroll
      for (int q = 0; q < 4; ++q) { ix[q] = ((const int4*)(sidx + (size_t)mn * 128))[q]; wx[q] = ((const float4*)(wts + (size_t)mn * 128))[q]; }
    }
    fl2_t acc[8];
#pragma unroll
    for (int q = 0; q < 8; ++q) acc[q] = {0.f, 0.f};
#pragma unroll
    for (int s2 = 0; s2 < 16; ++s2) {
      const fl2_t ww = {wt[s2], wt[s2]};
#pragma unroll
      for (int d = 0; d < 4; ++d) {
        const fl2_t lo = __builtin_amdgcn_cvt_pk_f32_fp8((int)rows[s2][d], false);
        const fl2_t hi = __builtin_amdgcn_cvt_pk_f32_fp8((int)rows[s2][d], true);
        acc[2 * d] = __builtin_elementwise_fma(lo, ww, acc[2 * d]);
        acc[2 * d + 1] = __builtin_elementwise_fma(hi, ww, acc[2 * d + 1]);
      }
    }
    float ps[16];
#pragma unroll
    for (int q = 0; q < 8; ++q) { ps[2 * q] = acc[q].x; ps[2 * q + 1] = acc[q].y; }
#pragma unroll
    for (int st = 0; st < 3; ++st) {
      const int bit = 32 >> st, half = 8 >> st;
      const bool upper = (lane & bit) != 0;
#pragma unroll
      for (int i = 0; i < half; ++i) {
        const float send = upper ? ps[i] : ps[i + half];
        const float keep = upper ? ps[i + half] : ps[i];
        ps[i] = keep + __shfl_xor(send, bit);
      }
    }
    const int cl = ((g >> 2) & 1) * 8 + ((g >> 1) & 1) * 4 + (g & 1) * 2;
    const size_t yo = (size_t)m * 1024 + v * 128 + li * 16 + cl;
    const unsigned hb2 = *(const unsigned*)((const u16*)(ws + W_HB) + yo);
    *(float2*)(p.out + O_Y + yo) = make_float2(bf_lo(hb2) + ps[0], bf_hi(hb2) + ps[1]);
  }
}

#define XB_TMO      128
#define XB_XCNT(j)  (256  + 64 * (j))
#define XB_XSUB(j)  (1280 + 64 * (j))
#define XB_XGEN(j)  (2304 + 64 * (j))
#define XB_TOP      3328
#define XB_TOPGEN   3392
#define XCD_BAR_WORDS 3456
#define XB_SPIN_CAP (1u << 18)
#define LAS __attribute__((address_space(3)))
DI unsigned xb_ld(unsigned* p) { return __hip_atomic_load(p, __ATOMIC_RELAXED, __HIP_MEMORY_SCOPE_AGENT); }
DI unsigned xb_add(unsigned* p, unsigned v) { return __hip_atomic_fetch_add(p, v, __ATOMIC_RELAXED, __HIP_MEMORY_SCOPE_AGENT); }
DI unsigned xb_xcc_id() { return (unsigned)__builtin_amdgcn_s_getreg((3 << 11) | 20) & 0xFu; }
#define XB_SPIN(cond, bar) do { unsigned _sp = 0; while (cond) { __builtin_amdgcn_s_sleep(1); \
    if ((++_sp & 255u) == 0u) { if (xb_ld(&(bar)[XB_TMO])) break; if (_sp > XB_SPIN_CAP) { atomicAdd(&(bar)[XB_TMO], 1u); break; } } } } while (0)
struct XcdBarrier { unsigned* bar; unsigned x; volatile LAS unsigned* st; };
DI XcdBarrier xcd_barrier_post(unsigned* bar, volatile LAS unsigned* st) {
  XcdBarrier b; b.bar = bar; b.x = xb_xcc_id(); b.st = st;
  if (threadIdx.x == 0) (void)xb_add(&bar[XB_XCNT(b.x)], 1u);
  return b;
}
DI void xcd_barrier_complete(unsigned* bar, unsigned x, unsigned& nloc, unsigned& nx) {
  const unsigned G = gridDim.x * gridDim.y * gridDim.z;
  unsigned sum, cnt, mine, sp = 0u;
  for (;;) {
    sum = 0u; cnt = 0u; mine = 0u;
#pragma unroll
    for (unsigned j = 0; j < 16; ++j) { const unsigned c = xb_ld(&bar[XB_XCNT(j)]); sum += c; cnt += (c > 0u) ? 1u : 0u; mine = (j == x) ? c : mine; }
    if (sum == G) break;
    __builtin_amdgcn_s_sleep(1);
    if ((++sp & 255u) == 0u) { if (xb_ld(&bar[XB_TMO])) break; if (sp > XB_SPIN_CAP) { atomicAdd(&bar[XB_TMO], 1u); break; } }
  }
  nloc = mine > 0u ? mine : 1u; nx = cnt > 0u ? cnt : 1u;
}
DI void xcd_barrier(const XcdBarrier& b) {
  asm volatile("s_waitcnt vmcnt(0)" ::: "memory");
  __syncthreads();
  if (threadIdx.x == 0) {
    unsigned* bar = b.bar;
    __builtin_amdgcn_s_waitcnt(0);
    unsigned nloc = b.st[0], nx = b.st[1];
    if (nloc == 0u) { xcd_barrier_complete(bar, b.x, nloc, nx); b.st[0] = nloc; b.st[1] = nx; }
    const unsigned old = xb_add(&bar[XB_XSUB(b.x)], 1u);
    const unsigned gen = old / nloc;
    if (old + 1u == (gen + 1u) * nloc) {
      __builtin_amdgcn_fence(__ATOMIC_RELEASE, "agent");
      asm volatile("s_waitcnt vmcnt(0)" ::: "memory");
      const unsigned og = xb_add(&bar[XB_TOP], 1u);
      const unsigned tg = og / nx;
      if (og + 1u == (tg + 1u) * nx) xb_add(&bar[XB_TOPGEN], 1u);
      else XB_SPIN(xb_ld(&bar[XB_TOPGEN]) == tg, bar);
      __builtin_amdgcn_fence(__ATOMIC_ACQUIRE, "agent");
      xb_add(&bar[XB_XGEN(b.x)], 1u);
      asm volatile("s_waitcnt vmcnt(0)" ::: "memory");
    } else {
      XB_SPIN(xb_ld(&bar[XB_XGEN(b.x)]) == gen, bar);
      __builtin_amdgcn_fence(__ATOMIC_ACQUIRE, "agent");
      asm volatile("s_waitcnt vmcnt(0)" ::: "memory");
    }
  }
  __syncthreads();
}

__global__ void __launch_bounds__(256, 2) hymba_mega(Params p) {
  __shared__ __attribute__((aligned(16))) char smem[73728];
  __shared__ uint4 xb_words;
  cg::grid_group grid = cg::this_grid();
  const int nb = gridDim.x, bid = blockIdx.x;
  const bool xcd_ok = (nb & 7) == 0 && nb >= 8;
  const int vx = bid & 7, bxx = bid >> 3, nbx = nb >> 3;
  if (threadIdx.x == 0) xb_words = make_uint4(0u, 0u, 0u, 0u);
  __syncthreads();
  XcdBarrier xb = xcd_barrier_post((unsigned*)(p.ws + W_BAR), (volatile LAS unsigned*)&xb_words);
  if (p.out == nullptr) grid.sync();
  phase0(p, smem);
  xcd_barrier(xb);
  {
    const int cnt = xcd_ok ? ((130 - vx + 7) >> 3) * 14 : 130 * 14;
    for (int u = xcd_ok ? bxx : bid; u < cnt; u += xcd_ok ? nbx : nb) {
      const int mt = xcd_ok ? vx + 8 * (u / 14) : u / 14;
      gemm_tile<1>(p, mt, u % 14, smem);
    }
    __syncthreads();
    phase0b(p, smem);
  }
  xcd_barrier(xb);
  for (int it = bid; it < 512; it += nb) lru_item<0>(p, it, smem);
  xcd_barrier(xb);
  {
    __shared__ int q_item;
    unsigned* qhead = (unsigned*)(p.ws + W_QW);
    int it = bid;
    while (it < 528 + 544) {
      if (it < 528) lru_item<1>(p, it, smem);
      else attn_item(p, it - 528, smem);
      __syncthreads();
      if (threadIdx.x == 0) q_item = nb + (int)atomicAdd(qhead, 1u);
      __syncthreads();
      it = q_item;
    }
  }
  xcd_barrier(xb);
  {
    const int cnt = xcd_ok ? 130 : 130 * 8, st = xcd_ok ? bxx : bid, sd = xcd_ok ? nbx : nb;
    for (int u = st; u < cnt; u += sd) gemm_tile<2>(p, xcd_ok ? u : (u >> 3), xcd_ok ? vx : (u & 7), smem);
    const int extra = cnt % sd;
    (void)extra;
    conv_table_queue(p, true, (unsigned*)(p.ws + W_QW + 64));
  }
  xcd_barrier(xb);
  {
    const int cnt = xcd_ok ? 260 : 130 * 16, st = xcd_ok ? bxx : bid, sd = xcd_ok ? nbx : nb;
    for (int u = st; u < cnt; u += sd) gemm_tile<3>(p, xcd_ok ? (u >> 1) : (u >> 4), xcd_ok ? (vx * 2 + (u & 1)) : (u & 15), smem);
    const int extra = cnt % sd;
    (void)extra;
    conv_table_queue(p, false, (unsigned*)(p.ws + W_QW + 128));
  }
  xcd_barrier(xb);
  __syncthreads();
  route2(p, smem);
  xcd_barrier(xb);
  peer_u_phase(p);
  xcd_barrier(xb);
  peer_combine(p);
  xcd_barrier(xb);
  peer_v_phase(p);
}

extern "C" void kernel_launch(void* const* d_in, const int* in_sizes, int n_in, void* d_out, int out_size, void* d_ws,
                              size_t ws_size, hipStream_t stream) {
  static int grid_blocks = 0;
  if (!grid_blocks) {
    int dev = 0, cus = 0, per_cu = 0;
    (void)hipGetDevice(&dev);
    (void)hipDeviceGetAttribute(&cus, hipDeviceAttributeMultiprocessorCount, dev);
    (void)hipOccupancyMaxActiveBlocksPerMultiprocessor(&per_cu, hymba_mega, 256, 0);
    if (per_cu > 2) per_cu = 2;
    if (per_cu < 1) per_cu = 1;
    grid_blocks = cus * per_cu;
  }
  if (ws_size < W_END) fprintf(stderr, "workspace too small: %zu < %zu\n", ws_size, (size_t)W_END);
  Params p{};
  const float** pp = (const float**)&p;
  for (int i = 0; i < 27; ++i) pp[i] = (const float*)d_in[i];
  p.out = (float*)d_out;
  p.ws = (char*)d_ws;
  (void)hipMemsetAsync((char*)d_ws + W_BAR, 0, al(XCD_BAR_WORDS * 4) + 256, stream);
  void* args[] = {&p};
  hipError_t e = hipLaunchCooperativeKernel((void*)hymba_mega, dim3(grid_blocks), dim3(256), args, 0, stream);
  if (e != hipSuccess) fprintf(stderr, "cooperative launch failed: %s (grid %d)\n", hipGetErrorString(e), grid_blocks);
}
```
